# Optimizing an MI355X kernel written in HIP

```python
import jax, jax.numpy as jnp
from jax import lax
import numpy as np

D_MODEL = 1024
BATCH = 16
SEQ = 2048
DEPTH = 4

PLE_DIM = 256
N_MIXERS = 2
EPS = 1e-6

GLA_HEADS = 4
GLA_KEY_DIM = D_MODEL // 2
GLA_VAL_DIM = D_MODEL
GLA_DK = GLA_KEY_DIM // GLA_HEADS
GLA_DV = GLA_VAL_DIM // GLA_HEADS
GLA_GATE_RANK = 16
GLA_GATE_NORMALIZER = 16.0
GLA_CHUNK = 64
GLA_IN = 2 * GLA_KEY_DIM + 2 * GLA_VAL_DIM + GLA_GATE_RANK

FOX_HEADS = 16
FOX_WIDTH = D_MODEL
FOX_HD = FOX_WIDTH // FOX_HEADS
FOX_BLOCK = 128
FOX_IN = 4 * FOX_WIDTH + FOX_HEADS

N_GLA = (DEPTH + 1) // 2
N_FOX = DEPTH // 2

kernel_name = "gla_fox_interleaved_hybrid"


def rms_norm(x, g):
    xf = x.astype(jnp.float32)
    y = xf * lax.rsqrt(jnp.mean(xf * xf, axis=-1, keepdims=True) + EPS)
    return (y * g.astype(jnp.float32)).astype(x.dtype)


def to_heads(t, n_heads):
    b, s, w = t.shape
    return t.reshape(b, s, n_heads, w // n_heads).transpose(0, 2, 1, 3)


def gla_chunked(q, k, v, log_a):
    b_, h_, s_, dk = q.shape
    dv = v.shape[-1]
    n = s_ // GLA_CHUNK
    q = q.reshape(b_, h_, n, GLA_CHUNK, dk)
    k = k.reshape(b_, h_, n, GLA_CHUNK, dk)
    v = v.reshape(b_, h_, n, GLA_CHUNK, dv)
    cum = jnp.cumsum(log_a.reshape(b_, h_, n, GLA_CHUNK, dk), axis=3)
    q_in = q * jnp.exp(cum)
    k_in = k * jnp.exp(-cum)
    causal = jnp.tril(jnp.ones((GLA_CHUNK, GLA_CHUNK), dtype=bool))
    attn = jnp.where(causal, jnp.einsum('bhncd,bhnjd->bhncj', q_in, k_in), 0.0)
    o_intra = jnp.einsum('bhncj,bhnjv->bhncv', attn, v)
    cum_last = cum[:, :, :, -1:, :]
    k_dec = k * jnp.exp(cum_last - cum)
    decay_chunk = jnp.exp(cum_last[:, :, :, 0, :])

    def step(state, inp):
        k_n, v_n, d_n = inp
        new_state = state * d_n[..., None] + jnp.einsum('bhcd,bhcv->bhdv', k_n, v_n)
        return new_state, state

    xs = (jnp.moveaxis(k_dec, 2, 0), jnp.moveaxis(v, 2, 0), jnp.moveaxis(decay_chunk, 2, 0))
    init = jnp.zeros((b_, h_, dk, dv), jnp.float32)
    _, states = lax.scan(step, init, xs)
    o_inter = jnp.einsum('bhncd,nbhdv->bhncv', q_in, states)
    return (o_intra + o_inter).reshape(b_, h_, s_, dv)


def gla_mixer(h, w_in, w_a2, b_a, o_gain, w_out):
    b_, s_, _ = h.shape
    proj = h @ w_in
    q, k, v, g, a_lr = jnp.split(
        proj, [GLA_KEY_DIM, 2 * GLA_KEY_DIM, 2 * GLA_KEY_DIM + GLA_VAL_DIM, 2 * GLA_KEY_DIM + 2 * GLA_VAL_DIM], axis=-1)
    log_a = jax.nn.log_sigmoid((a_lr @ w_a2).astype(jnp.float32) + b_a.astype(jnp.float32)) / GLA_GATE_NORMALIZER
    qh = to_heads(q, GLA_HEADS).astype(jnp.float32) * (GLA_DK ** -0.5)
    kh = to_heads(k, GLA_HEADS).astype(jnp.float32)
    vh = to_heads(v, GLA_HEADS).astype(jnp.float32)
    ah = to_heads(log_a, GLA_HEADS)
    o = gla_chunked(qh, kh, vh, ah).astype(h.dtype)
    o = rms_norm(o.transpose(0, 2, 1, 3), o_gain).reshape(b_, s_, GLA_VAL_DIM)
    return (o * jax.nn.silu(g)) @ w_out


def fox_attention(q, k, v, log_f):
    b_, h_, s_, d = q.shape
    nq = s_ // FOX_BLOCK
    c = jnp.cumsum(log_f, axis=-1)
    q_blocks = jnp.moveaxis(q.reshape(b_, h_, nq, FOX_BLOCK, d), 2, 0)
    c_blocks = jnp.moveaxis(c.reshape(b_, h_, nq, FOX_BLOCK), 2, 0)
    starts = jnp.arange(nq, dtype=jnp.int32) * FOX_BLOCK
    key_pos = jnp.arange(s_, dtype=jnp.int32)
    scale = FOX_HD ** -0.5

    def block(args):
        qb, cb, start = args
        q_pos = start + jnp.arange(FOX_BLOCK, dtype=jnp.int32)
        logits = (jnp.einsum('bhqd,bhkd->bhqk', qb, k).astype(jnp.float32) * scale
                  + cb[..., :, None] - c[..., None, :])
        mask = key_pos[None, :] <= q_pos[:, None]
        probs = jax.nn.softmax(jnp.where(mask, logits, -jnp.inf), axis=-1)
        return jnp.einsum('bhqk,bhkd->bhqd', probs.astype(v.dtype), v)

    out = lax.map(block, (q_blocks, c_blocks, starts))
    return jnp.moveaxis(out, 0, 2).reshape(b_, h_, s_, d)


def fox_mixer(h, w_in, b_f, q_gain, k_gain, w_out):
    b_, s_, _ = h.shape
    proj = h @ w_in
    q, k, v, g, f_logit = jnp.split(proj, [FOX_WIDTH, 2 * FOX_WIDTH, 3 * FOX_WIDTH, 4 * FOX_WIDTH], axis=-1)
    log_f = jax.nn.log_sigmoid(f_logit.astype(jnp.float32) + b_f.astype(jnp.float32))
    qh = rms_norm(to_heads(q, FOX_HEADS), q_gain)
    kh = rms_norm(to_heads(k, FOX_HEADS), k_gain)
    vh = to_heads(v, FOX_HEADS)
    o = fox_attention(qh, kh, vh, log_f.transpose(0, 2, 1))
    o = o.transpose(0, 2, 1, 3).reshape(b_, s_, FOX_WIDTH)
    return (o * jax.nn.silu(g)) @ w_out


def setup_inputs(seed: int = 0) -> dict:
    key = jax.random.key(seed)
    ks = jax.random.split(key, 20)
    f32 = jnp.float32
    nrm = lambda k, shape, fan_in: jax.random.normal(k, shape, f32) * (fan_in ** -0.5)
    gain = lambda k, shape: 1.0 + 0.02 * jax.random.normal(k, shape, f32)
    return {
        "x": jax.random.normal(ks[0], (BATCH, SEQ, D_MODEL), f32),
        "p": jax.random.normal(ks[1], (DEPTH, BATCH, SEQ, PLE_DIM), f32),
        "norm_mixer": gain(ks[2], (DEPTH, D_MODEL)),
        "gla_w_in": nrm(ks[3], (N_GLA, D_MODEL, GLA_IN), D_MODEL),
        "gla_w_a2": nrm(ks[4], (N_GLA, GLA_GATE_RANK, GLA_KEY_DIM), GLA_GATE_RANK),
        "gla_b_a": 0.1 * jax.random.normal(ks[5], (N_GLA, GLA_KEY_DIM), f32),
        "gla_o_norm": gain(ks[6], (N_GLA, GLA_DV)),
        "gla_w_out": nrm(ks[7], (N_GLA, GLA_VAL_DIM, D_MODEL), GLA_VAL_DIM),
        "fox_w_in": nrm(ks[8], (N_FOX, D_MODEL, FOX_IN), D_MODEL),
        "fox_b_f": 2.0 + 0.5 * jax.random.normal(ks[9], (N_FOX, FOX_HEADS), f32),
        "fox_q_norm": gain(ks[10], (N_FOX, FOX_HD)),
        "fox_k_norm": gain(ks[11], (N_FOX, FOX_HD)),
        "fox_w_out": nrm(ks[12], (N_FOX, FOX_WIDTH, D_MODEL), FOX_WIDTH),
        "ple_proj": nrm(ks[13], (DEPTH, PLE_DIM, D_MODEL), PLE_DIM),
        "ple_gate": nrm(ks[14], (DEPTH, D_MODEL, D_MODEL), D_MODEL),
        "ple_norm": gain(ks[15], (DEPTH, D_MODEL)),
        "final_norm": gain(ks[16], (D_MODEL,)),
    }


def reference(x, p, norm_mixer, gla_w_in, gla_w_a2, gla_b_a, gla_o_norm, gla_w_out,
              fox_w_in, fox_b_f, fox_q_norm, fox_k_norm, fox_w_out,
              ple_proj, ple_gate, ple_norm, final_norm):
    h = x
    for i in range(DEPTH):
        hn = rms_norm(h, norm_mixer[i])
        j = i // N_MIXERS
        if i % N_MIXERS == 0:
            h = h + gla_mixer(hn, gla_w_in[j], gla_w_a2[j], gla_b_a[j], gla_o_norm[j], gla_w_out[j])
        else:
            h = h + fox_mixer(hn, fox_w_in[j], fox_b_f[j], fox_q_norm[j], fox_k_norm[j], fox_w_out[j])
        h = h + (p[i] @ ple_proj[i]) * jax.nn.sigmoid(rms_norm(h, ple_norm[i]) @ ple_gate[i])
    return rms_norm(h, final_norm)
```

```cpp
#include <hip/hip_runtime.h>
#include <stdint.h>
#include <cstdio>

namespace {
constexpr int DM = 1024, BATCH = 16, SEQ = 2048, DEPTH = 4, M = BATCH * SEQ;
constexpr int PLE = 256;
constexpr int GLA_H = 4, GLA_DK = 128, GLA_DV = 256, GLA_RANK = 16;
constexpr int GLA_IN = 3088, GLA_NP = 3328;
constexpr int FOX_H = 16, FOX_HD = 64, FOX_IN = 4112, FOX_NP = 4352;
constexpr float EPS = 1e-6f;
constexpr float LOG2E = 1.4426950408889634f;
constexpr float C2 = 0.125f * LOG2E;

typedef unsigned short bf16_t;
typedef short bf16x8 __attribute__((ext_vector_type(8)));
typedef float f32x4 __attribute__((ext_vector_type(4)));

constexpr size_t MiB = 1u << 20;
constexpr size_t WS_CTL = 0;
constexpr size_t WS_WGIN = 1 * MiB;
constexpr size_t WS_WFIN = 14 * MiB;
constexpr size_t WS_WOUT = 31 * MiB;
constexpr size_t WS_WGATE = 39 * MiB;
constexpr size_t WS_WPROJ = 47 * MiB;
constexpr size_t WS_SSQA = 49 * MiB;
constexpr size_t WS_SSQB = 51 * MiB;
constexpr size_t WS_AUX = 53 * MiB;
constexpr size_t WS_CUM = 55 * MiB;
constexpr size_t WS_PB = 57 * MiB;
constexpr size_t WS_HB = 73 * MiB;
constexpr size_t WS_OG = 137 * MiB;
constexpr size_t WS_PROJ = 201 * MiB;
constexpr size_t WS_SG = WS_PROJ;
constexpr size_t WS_END = 473 * MiB;

__device__ __forceinline__ unsigned f2bf(float f) { unsigned u = __float_as_uint(f); return (u + 0x7fffu + ((u >> 16) & 1u)) >> 16; }
__device__ __forceinline__ float bf2f(bf16_t b) { return __uint_as_float((unsigned)b << 16); }
__device__ __forceinline__ float sigmoidf_(float x) { return 1.f / (1.f + __expf(-x)); }
__device__ __forceinline__ float logsigmoidf_(float x) { return fminf(x, 0.f) - log1pf(__expf(-fabsf(x))); }
__device__ __forceinline__ float row_rstd(const float* ssq, int row) {
    float s = 0.f;
#pragma unroll
    for (int i = 0; i < 16; ++i) s += ssq[(size_t)row * 16 + i];
    return rsqrtf(s * (1.f / DM) + EPS);
}

__global__ void k_prep_w(const float* __restrict__ src, int K, int N, int NP, bf16_t* __restrict__ dst, const float* __restrict__ rs, int nscale, float cs) {
    size_t idx = (size_t)blockIdx.x * blockDim.x + threadIdx.x;
    if (idx >= (size_t)NP * K) return;
    int n = (int)(idx % NP), k = (int)(idx / NP);
    float v = 0.f;
    if (n < N) { v = src[(size_t)k * N + n]; if (rs) v *= rs[k]; if (n < nscale) v *= cs; }
    dst[(size_t)n * K + k] = (bf16_t)f2bf(v);
}
__global__ void k_row_stats(const float* __restrict__ x, bf16_t* __restrict__ hb, float* __restrict__ ssq) {
    int row = blockIdx.x * 4 + (threadIdx.x >> 6), lane = threadIdx.x & 63;
    float s = 0.f;
    for (int c = lane; c < DM; c += 64) { float v = x[(size_t)row * DM + c]; s += v * v; if (hb) hb[(size_t)row * DM + c] = (bf16_t)f2bf(v); }
    for (int o = 32; o > 0; o >>= 1) s += __shfl_xor(s, o);
    if (lane < 16) ssq[(size_t)row * 16 + lane] = (lane == 0) ? s : 0.f;
}
__global__ void k_cvt(const float* __restrict__ src, bf16_t* __restrict__ dst, size_t n) {
    size_t i = (size_t)blockIdx.x * blockDim.x + threadIdx.x;
    if (i < n) dst[i] = (bf16_t)f2bf(src[i]);
}

template <class Epi>
__global__ void __launch_bounds__(256) k_gemm(const bf16_t* __restrict__ A, int lda, const bf16_t* __restrict__ Bt, int ldb, int K, Epi epi) {
    const int wave = threadIdx.x >> 6, lane = threadIdx.x & 63, fr = lane & 15, fq = lane >> 4;
    const int m0 = blockIdx.y * 64 + (wave >> 1) * 32, n0 = blockIdx.x * 64 + (wave & 1) * 32;
    f32x4 acc[2][2];
#pragma unroll
    for (int i = 0; i < 2; ++i)
#pragma unroll
        for (int j = 0; j < 2; ++j) acc[i][j] = (f32x4){0.f, 0.f, 0.f, 0.f};
    const bf16_t* ap = A + (size_t)(m0 + fr) * lda + 8 * fq;
    const bf16_t* bp = Bt + (size_t)(n0 + fr) * ldb + 8 * fq;
    for (int k = 0; k < K; k += 32) {
        bf16x8 a[2], b[2];
#pragma unroll
        for (int i = 0; i < 2; ++i) { a[i] = *(const bf16x8*)(ap + (size_t)i * 16 * lda + k); b[i] = *(const bf16x8*)(bp + (size_t)i * 16 * ldb + k); }
#pragma unroll
        for (int i = 0; i < 2; ++i)
#pragma unroll
            for (int j = 0; j < 2; ++j) acc[i][j] = __builtin_amdgcn_mfma_f32_16x16x32_bf16(b[j], a[i], acc[i][j], 0, 0, 0);
    }
#pragma unroll
    for (int i = 0; i < 2; ++i)
#pragma unroll
        for (int j = 0; j < 2; ++j)
#pragma unroll
            for (int r = 0; r < 4; ++r) epi(m0 + 16 * i + fr, n0 + 16 * j + 4 * fq + r, acc[i][j][r]);
}

struct EpiGlaIn { const float* ssq; bf16_t* proj; float* aux;
    __device__ void operator()(int row, int col, float acc) const {
        if (col >= GLA_IN) return;
        float v = acc * row_rstd(ssq, row);
        if (col < 3072) proj[(size_t)row * GLA_NP + col] = (bf16_t)f2bf(v); else aux[(size_t)row * 16 + (col - 3072)] = v; } };
struct EpiFoxIn { const float* ssq; bf16_t* proj; float* aux; const float* bf;
    __device__ void operator()(int row, int col, float acc) const {
        if (col >= FOX_IN) return;
        float v = acc * row_rstd(ssq, row);
        if (col < 4096) proj[(size_t)row * FOX_NP + col] = (bf16_t)f2bf(v); else aux[(size_t)row * 16 + (col - 4096)] = logsigmoidf_(v + bf[col - 4096]); } };
struct EpiOut { const float* hres; float* h; bf16_t* hb;
    __device__ void operator()(int row, int col, float acc) const {
        size_t o = (size_t)row * DM + col; float v = hres[o] + acc; h[o] = v; hb[o] = (bf16_t)f2bf(v); } };
struct EpiGate { const float* ssq; bf16_t* sg;
    __device__ void operator()(int row, int col, float acc) const { sg[(size_t)row * DM + col] = (bf16_t)f2bf(sigmoidf_(acc * row_rstd(ssq, row))); } };
struct EpiProj { float* h; bf16_t* hb; const bf16_t* sg;
    __device__ void operator()(int row, int col, float acc) const {
        size_t o = (size_t)row * DM + col; float v = h[o] + acc * bf2f(sg[o]); h[o] = v; hb[o] = (bf16_t)f2bf(v); } };

__global__ void __launch_bounds__(256) k_gla(const bf16_t* __restrict__ proj, const float* __restrict__ alr, const float* __restrict__ wa2, const float* __restrict__ ba,
                                             const float* __restrict__ ogain, bf16_t* __restrict__ og) {
    __shared__ float qs[128], ks[128], as_[128], red[4];
    const int b = blockIdx.x / GLA_H, h = blockIdx.x % GLA_H, j = threadIdx.x, lane = j & 63, wave = j >> 6;
    float S[128];
#pragma unroll
    for (int d = 0; d < 128; ++d) S[d] = 0.f;
    float w2[16]; float bav = 0.f;
    if (j < 128) {
#pragma unroll
        for (int r = 0; r < 16; ++r) w2[r] = wa2[(size_t)r * 512 + h * 128 + j];
        bav = ba[h * 128 + j];
    } else {
#pragma unroll
        for (int r = 0; r < 16; ++r) w2[r] = 0.f;
    }
    const float gain = ogain[j];
    for (int t = 0; t < SEQ; ++t) {
        const size_t row = (size_t)b * SEQ + t;
        const bf16_t* pr = proj + row * GLA_NP;
        if (j < 128) {
            qs[j] = bf2f(pr[h * 128 + j]);
            ks[j] = bf2f(pr[512 + h * 128 + j]);
            float s = bav;
#pragma unroll
            for (int r = 0; r < 16; ++r) s += alr[row * 16 + r] * w2[r];
            as_[j] = __expf(logsigmoidf_(s) * (1.f / 16.f));
        }
        __syncthreads();
        const float v = bf2f(pr[1024 + h * 256 + j]);
        float o = 0.f;
#pragma unroll
        for (int d = 0; d < 128; ++d) { S[d] = as_[d] * S[d] + ks[d] * v; o += qs[d] * S[d]; }
        float sq = o * o;
        for (int off = 32; off > 0; off >>= 1) sq += __shfl_xor(sq, off);
        if (lane == 0) red[wave] = sq;
        __syncthreads();
        const float tot = red[0] + red[1] + red[2] + red[3];
        const float rstd = rsqrtf(tot * (1.f / 256.f) + EPS);
        const float g = bf2f(pr[2048 + h * 256 + j]);
        og[row * DM + h * 256 + j] = (bf16_t)f2bf(o * rstd * gain * (g * sigmoidf_(g)));
    }
}

__global__ void k_fox_headnorm(bf16_t* __restrict__ proj, const float* __restrict__ qg, const float* __restrict__ kg) {
    const int gw = blockIdx.x * 4 + (threadIdx.x >> 6), lane = threadIdx.x & 63;
    const int row = gw / 32, hh = gw % 32;
    bf16_t* p = proj + (size_t)row * FOX_NP + hh * 64 + lane;
    float v = bf2f(*p), s = v * v;
    for (int o = 32; o > 0; o >>= 1) s += __shfl_xor(s, o);
    const float r = rsqrtf(s * (1.f / 64.f) + EPS);
    const float g = (hh < 16) ? qg[lane] * C2 : kg[lane];
    *p = (bf16_t)f2bf(v * r * g);
}
__global__ void k_fox_cumsum(const float* __restrict__ flog, float* __restrict__ cum) {
    const int bh = blockIdx.x * blockDim.x + threadIdx.x; if (bh >= BATCH * FOX_H) return;
    const int b = bh / FOX_H, h = bh % FOX_H; double s = 0.0;
    for (int t = 0; t < SEQ; ++t) { s += (double)flog[((size_t)b * SEQ + t) * 16 + h]; cum[(size_t)bh * SEQ + t] = (float)s; }
}
__global__ void __launch_bounds__(256) k_fox_attn(const bf16_t* __restrict__ proj, const float* __restrict__ cum, bf16_t* __restrict__ og) {
    __shared__ float Ks[64][65], Vs[64][65], Cs[64];
    const int qb = blockIdx.x % 8, bh = blockIdx.x / 8, b = bh / FOX_H, h = bh % FOX_H, tid = threadIdx.x;
    const int t = qb * 256 + tid; const size_t row = (size_t)b * SEQ + t;
    float q[64], o[64];
#pragma unroll
    for (int d = 0; d < 64; ++d) { q[d] = bf2f(proj[row * FOX_NP + h * 64 + d]); o[d] = 0.f; }
    const float cq = cum[(size_t)bh * SEQ + t] * LOG2E;
    float m = -INFINITY, l = 0.f;
    const int ntile = (qb + 1) * 4;
    for (int kt = 0; kt < ntile; ++kt) {
        __syncthreads();
        for (int e = tid; e < 64 * 64; e += 256) { const int r = e >> 6, c = e & 63; const size_t kr = (size_t)b * SEQ + kt * 64 + r;
            Ks[r][c] = bf2f(proj[kr * FOX_NP + 1024 + h * 64 + c]); Vs[r][c] = bf2f(proj[kr * FOX_NP + 2048 + h * 64 + c]); }
        if (tid < 64) Cs[tid] = cum[(size_t)bh * SEQ + kt * 64 + tid] * LOG2E;
        __syncthreads();
        for (int r = 0; r < 64; ++r) {
            const int s = kt * 64 + r;
            if (s > t) break;
            float x = cq - Cs[r];
#pragma unroll
            for (int d = 0; d < 64; ++d) x += q[d] * Ks[r][d];
            const float mn = fmaxf(m, x), f = exp2f(m - mn), p = exp2f(x - mn);
            l = l * f + p;
#pragma unroll
            for (int d = 0; d < 64; ++d) o[d] = o[d] * f + p * Vs[r][d];
            m = mn;
        }
    }
    const float il = 1.f / l;
#pragma unroll
    for (int d = 0; d < 64; ++d) { const float g = bf2f(proj[row * FOX_NP + 3072 + h * 64 + d]); og[row * DM + h * 64 + d] = (bf16_t)f2bf(o[d] * il * (g * sigmoidf_(g))); }
}

__global__ void k_final(float* __restrict__ h, const float* __restrict__ ssq, const float* __restrict__ gain) {
    size_t i = (size_t)blockIdx.x * blockDim.x + threadIdx.x; if (i >= (size_t)M * DM) return;
    const int row = (int)(i / DM), col = (int)(i % DM);
    h[i] = h[i] * row_rstd(ssq, row) * gain[col];
}
}

extern "C" void kernel_launch(void* const* d_in, const int* in_sizes, int n_in, void* d_out, int out_size, void* d_ws, size_t ws_size, hipStream_t stream) {
    if (ws_size < WS_END) { fprintf(stderr, "kernel_launch: ws too small: %zu < %zu\n", ws_size, (size_t)WS_END); return; }
    const float* x = (const float*)d_in[0]; const float* p = (const float*)d_in[1]; const float* norm_mixer = (const float*)d_in[2];
    const float* gla_w_in = (const float*)d_in[3]; const float* gla_w_a2 = (const float*)d_in[4]; const float* gla_b_a = (const float*)d_in[5];
    const float* gla_o_norm = (const float*)d_in[6]; const float* gla_w_out = (const float*)d_in[7];
    const float* fox_w_in = (const float*)d_in[8]; const float* fox_b_f = (const float*)d_in[9]; const float* fox_q_norm = (const float*)d_in[10];
    const float* fox_k_norm = (const float*)d_in[11]; const float* fox_w_out = (const float*)d_in[12];
    const float* ple_proj = (const float*)d_in[13]; const float* ple_gate = (const float*)d_in[14]; const float* ple_norm = (const float*)d_in[15];
    const float* final_norm = (const float*)d_in[16];
    float* H = (float*)d_out; char* ws = (char*)d_ws;
    bf16_t* WGIN = (bf16_t*)(ws + WS_WGIN); bf16_t* WFIN = (bf16_t*)(ws + WS_WFIN); bf16_t* WOUT = (bf16_t*)(ws + WS_WOUT);
    bf16_t* WGATE = (bf16_t*)(ws + WS_WGATE); bf16_t* WPROJ = (bf16_t*)(ws + WS_WPROJ);
    float* SSQA = (float*)(ws + WS_SSQA); float* SSQB = (float*)(ws + WS_SSQB); float* AUX = (float*)(ws + WS_AUX); float* CUM = (float*)(ws + WS_CUM);
    bf16_t* PB = (bf16_t*)(ws + WS_PB); bf16_t* HB = (bf16_t*)(ws + WS_HB); bf16_t* OG = (bf16_t*)(ws + WS_OG); bf16_t* PROJ = (bf16_t*)(ws + WS_PROJ); bf16_t* SG = (bf16_t*)(ws + WS_SG);

    auto prep = [&](const float* src, int K, int N, int NP, bf16_t* dst, const float* rs, int nscale, float cs) {
        size_t n = (size_t)NP * K; k_prep_w<<<(unsigned)((n + 255) / 256), 256, 0, stream>>>(src, K, N, NP, dst, rs, nscale, cs); };
    for (int j = 0; j < 2; ++j) {
        prep(gla_w_in + (size_t)j * DM * GLA_IN, DM, GLA_IN, GLA_NP, WGIN + (size_t)j * GLA_NP * DM, norm_mixer + (size_t)(2 * j) * DM, 512, 0.08838834764831845f);
        prep(fox_w_in + (size_t)j * DM * FOX_IN, DM, FOX_IN, FOX_NP, WFIN + (size_t)j * FOX_NP * DM, norm_mixer + (size_t)(2 * j + 1) * DM, 0, 1.f);
        prep(gla_w_out + (size_t)j * DM * DM, DM, DM, DM, WOUT + (size_t)(2 * j) * DM * DM, nullptr, 0, 1.f);
        prep(fox_w_out + (size_t)j * DM * DM, DM, DM, DM, WOUT + (size_t)(2 * j + 1) * DM * DM, nullptr, 0, 1.f);
    }
    for (int i = 0; i < DEPTH; ++i) {
        prep(ple_gate + (size_t)i * DM * DM, DM, DM, DM, WGATE + (size_t)i * DM * DM, ple_norm + (size_t)i * DM, 0, 1.f);
        prep(ple_proj + (size_t)i * PLE * DM, PLE, DM, DM, WPROJ + (size_t)i * DM * PLE, nullptr, 0, 1.f);
    }
    k_row_stats<<<M / 4, 256, 0, stream>>>(x, HB, SSQA);
    for (int i = 0; i < DEPTH; ++i) {
        const int j = i / 2; const float* hres = (i == 0) ? x : H;
        if ((i & 1) == 0) {
            k_gemm<EpiGlaIn><<<dim3(GLA_NP / 64, M / 64), 256, 0, stream>>>(HB, DM, WGIN + (size_t)j * GLA_NP * DM, DM, DM, EpiGlaIn{SSQA, PROJ, AUX});
            k_gla<<<BATCH * GLA_H, 256, 0, stream>>>(PROJ, AUX, gla_w_a2 + (size_t)j * GLA_RANK * 512, gla_b_a + (size_t)j * 512, gla_o_norm + (size_t)j * GLA_DV, OG);
        } else {
            k_gemm<EpiFoxIn><<<dim3(FOX_NP / 64, M / 64), 256, 0, stream>>>(HB, DM, WFIN + (size_t)j * FOX_NP * DM, DM, DM, EpiFoxIn{SSQA, PROJ, AUX, fox_b_f + (size_t)j * FOX_H});
            k_fox_headnorm<<<M * 32 / 4, 256, 0, stream>>>(PROJ, fox_q_norm + (size_t)j * FOX_HD, fox_k_norm + (size_t)j * FOX_HD);
            k_fox_cumsum<<<1, 256, 0, stream>>>(AUX, CUM);
            k_fox_attn<<<BATCH * FOX_H * 8, 256, 0, stream>>>(PROJ, CUM, OG);
        }
        k_gemm<EpiOut><<<dim3(DM / 64, M / 64), 256, 0, stream>>>(OG, DM, WOUT + (size_t)i * DM * DM, DM, DM, EpiOut{hres, H, HB});
        k_row_stats<<<M / 4, 256, 0, stream>>>(H, nullptr, SSQB);
        k_gemm<EpiGate><<<dim3(DM / 64, M / 64), 256, 0, stream>>>(HB, DM, WGATE + (size_t)i * DM * DM, DM, DM, EpiGate{SSQB, SG});
        { size_t n = (size_t)M * PLE; k_cvt<<<(unsigned)((n + 255) / 256), 256, 0, stream>>>(p + (size_t)i * M * PLE, PB, n); }
        k_gemm<EpiProj><<<dim3(DM / 64, M / 64), 256, 0, stream>>>(PB, PLE, WPROJ + (size_t)i * DM * PLE, PLE, PLE, EpiProj{H, HB, SG});
        k_row_stats<<<M / 4, 256, 0, stream>>>(H, nullptr, SSQA);
    }
    { size_t n = (size_t)M * DM; k_final<<<(unsigned)((n + 255) / 256), 256, 0, stream>>>(H, SSQA, final_norm); }
}
```

```cpp
#include <hip/hip_runtime.h>
#include <stdint.h>
#include <cstdio>
#include <cmath>
constexpr int DM = 1024, BATCH = 16, SEQ = 2048, DEPTH = 4, M = BATCH * SEQ;
constexpr int PLE = 256;
constexpr int GLA_H = 4, GLA_RANK = 16;
constexpr int GLA_IN = 3088, GLA_NP = 3328;
constexpr int FOX_H = 16, FOX_IN = 4112, FOX_NP = 4352;
constexpr float EPS = 1e-6f;
constexpr float LOG2E = 1.4426950408889634f;
constexpr float C2 = 0.125f * LOG2E;
constexpr int NWAVES = 8;

constexpr size_t MiB = 1u << 20;
constexpr size_t WS_CTL = 0, CTL_ZERO_BYTES = 64 * 1024;
constexpr size_t WS_WGIN = 1 * MiB;
constexpr size_t WS_WFIN = 14 * MiB;
constexpr size_t WS_WOUT = 31 * MiB;
constexpr size_t WS_WGATE = 39 * MiB;
constexpr size_t WS_WPROJ = 47 * MiB;
constexpr size_t WS_SSQA = 49 * MiB;
constexpr size_t WS_SSQB = 51 * MiB;
constexpr size_t WS_AUX = 53 * MiB;
constexpr size_t WS_PB = 57 * MiB;
constexpr size_t WS_HB = 73 * MiB;
constexpr size_t WS_OG = 137 * MiB;
constexpr size_t WS_PROJ = 201 * MiB;
constexpr size_t WS_SG = WS_PROJ;
constexpr size_t WS_DCH = 55 * MiB;
constexpr size_t WS_SSQG = 474 * MiB;
constexpr size_t WS_AF = 482 * MiB;
constexpr size_t WS_GRAN = 498 * MiB, GRAN_BYTES = 4 * MiB;
constexpr size_t WS_END = 502 * MiB;
constexpr int CW_BAR = 1024;

constexpr int RING_OFF = 0, RING_BYTES = 131072;
constexpr int LDSCTL_OFF = RING_BYTES, MISC_OFF = LDSCTL_OFF + 320;
constexpr int RSTD_OFF = RING_BYTES + 512;
constexpr int LDS_BYTES = 163840;
#ifndef ATTN_THRL
#define ATTN_THRL 64
#endif
#ifndef DUP_INPROJ
#define DUP_INPROJ 0
#endif
#ifndef DUP_GLA
#define DUP_GLA 0
#endif
#ifndef DUP_ATTN
#define DUP_ATTN 0
#endif
#ifndef DUP_GATE
#define DUP_GATE 0
#endif
#ifndef DUP_P0
#define DUP_P0 0
#endif
#ifndef DUP_BAR
#define DUP_BAR 0
#endif
#ifndef DUP_OUT0
#define DUP_OUT0 0
#endif
#ifndef DUP_GLAPRE
#define DUP_GLAPRE 0
#endif
#ifndef TPROBE
#define TPROBE 0
#endif
#ifndef PROBE_A
#define PROBE_A 1
#endif
#ifndef PROBE_B
#define PROBE_B 1
#endif
#ifndef DUP_SKINNY
#define DUP_SKINNY 0
#endif
#ifndef ATTN_XCDMAP
#define ATTN_XCDMAP 0
#endif
#ifndef ATTN_SKIP
#define ATTN_SKIP 0
#endif
#ifndef PROJ_NT
#define PROJ_NT 1
#endif
#ifndef ATTN_SM_MAX
#define ATTN_SM_MAX 40.0f
#endif
namespace pg8 {
#define PG8_LAS __attribute__((address_space(3)))
typedef unsigned short bf16_t;
typedef short bf16x8 __attribute__((ext_vector_type(8)));
typedef float f32x4 __attribute__((ext_vector_type(4)));
typedef unsigned u32x4 __attribute__((ext_vector_type(4)));
constexpr int BM = 256, BK = 64, HALF = 128, HTB = HALF * BK * 2  , STAGE_BYTES = 8 * HTB, NXCD = 8, WGM = 4;

__host__ __device__ __forceinline__ int lds_byte(int r, int c) { const int st = (r >> 4) * 2 + (c >> 5), rr = r & 15, cc = c & 31, ob = rr * 64 + cc * 2; return st * 1024 + (ob ^ (((ob >> 9) & 1) << 5)); }
__host__ __device__ __forceinline__ void stage_rc(int b, int& R, int& C) { const int st = b / 1024, sb = b % 1024, swz = sb ^ (((sb >> 9) & 1) << 5); R = (st >> 1) * 16 + swz / 64; C = (st & 1) * 32 + (swz % 64) / 2; }
__host__ __device__ __forceinline__ int perm32(int rho) { const int n = rho >> 4, i = rho & 15; return 8 * (i >> 2) + 4 * n + (i & 3); }

struct Unit { int pm, pn, idx; };
struct Gemm { const bf16_t* A; const bf16_t* Bt; int M, N, K; };

struct StaticOrder {
    int nM, nN, nwg, G, c;
    __host__ __device__ void init(int M, int N, int G_, int c_) { nM = M / BM; nN = N / BM; nwg = nM * nN; G = G_; c = c_; }
    __host__ __device__ bool next(int i, Unit& u) const {
        const long L = (long)i * G + c; if (L >= nwg) return false;
        int wgid = (int)L; { const int q = nwg / NXCD, r = nwg % NXCD, xcd = wgid % NXCD, off = wgid / NXCD; wgid = (xcd < r ? xcd * (q + 1) : r * (q + 1) + (xcd - r) * q) + off; }
        if (nN == 12 && nM == 128 && G == 256) { const int xcd = (int)(L % NXCD), off = (int)(L / NXCD);
            if (off < 128) { const int w = off & 31; u.pm = xcd * 16 + (off >> 5) * 4 + (w & 3); u.pn = w >> 2; }
            else { const int o2 = off - 128, w = o2 & 31; u.pm = xcd * 16 + (o2 >> 5) * 8 + (w & 7); u.pn = 8 + (w >> 3); }
            u.idx = i; return true; }
        const int nig = WGM * nN, gid = wgid / nig, fm = gid * WGM, gsz = (nM - fm) < WGM ? (nM - fm) : WGM;
        u.pm = fm + ((wgid % nig) % gsz); u.pn = (wgid % nig) / gsz; u.idx = i; return true;
    }
    __device__ __forceinline__ void a_ready(const Unit&) const {}
    __device__ __forceinline__ void done(const Unit&) const {}
};
typedef float f32x2c_t __attribute__((ext_vector_type(2))); typedef __bf16 bf16x2c_t __attribute__((ext_vector_type(2)));
__device__ __forceinline__ unsigned cvt_pk_bf16(float lo, float hi) { f32x2c_t v = {lo, hi}; bf16x2c_t b = __builtin_convertvector(v, bf16x2c_t); return __builtin_bit_cast(unsigned, b); }
typedef float f32x2 __attribute__((ext_vector_type(2)));
typedef unsigned u32x2 __attribute__((ext_vector_type(2)));
__device__ __forceinline__ float sigmoid_f(float x) { return __builtin_amdgcn_rcpf(1.f + __builtin_amdgcn_exp2f(-1.4426950408889634f * x)); }
__device__ __forceinline__ float logsigmoid_f(float x) { return fminf(x, 0.f) - log1pf(__expf(-fabsf(x))); }
__device__ __forceinline__ void lane_rstd(const float* ssq, int row0, int fq, float (&rs)[2][4]) {
#pragma unroll
    for (int ai = 0; ai < 2; ++ai)
#pragma unroll
        for (int m = 0; m < 4; ++m) {
            const f32x4 v = *(const f32x4*)(ssq + (size_t)(row0 + ai * HALF + m * 16) * 16 + 4 * fq);
            float s = (v[0] + v[1]) + (v[2] + v[3]); s += __shfl_xor(s, 16); s += __shfl_xor(s, 32);
            rs[ai][m] = rsqrtf(s * (1.0f / 1024.0f) + 1e-6f);
        }
}
__device__ __forceinline__ void lane_rstd_lds(const PG8_LAS float* rt, int idx, int rloc, float (&rs)[2][4]) {
#pragma unroll
    for (int ai = 0; ai < 2; ++ai)
#pragma unroll
        for (int m = 0; m < 4; ++m) rs[ai][m] = rt[idx * 256 + rloc + ai * HALF + m * 16];
}
__device__ __forceinline__ u32x4 pack8(const f32x4 a, const f32x4 b) { u32x4 w; w.x = cvt_pk_bf16(a[0], a[1]); w.y = cvt_pk_bf16(a[2], a[3]); w.z = cvt_pk_bf16(b[0], b[1]); w.w = cvt_pk_bf16(b[2], b[3]); return w; }

__device__ __forceinline__ float rows4_sum(float q) {
    { auto rr = __builtin_amdgcn_permlane16_swap(__float_as_uint(q), __float_as_uint(q), false, false); q = __uint_as_float(rr[0]) + __uint_as_float(rr[1]); }
    { auto rr = __builtin_amdgcn_permlane32_swap(__float_as_uint(q), __float_as_uint(q), false, false); q = __uint_as_float(rr[0]) + __uint_as_float(rr[1]); }
    return q; }
__device__ __forceinline__ void swap8(const u32x4 a, const u32x4 b, u32x4& xa, u32x4& xb) {
#pragma unroll
    for (int e = 0; e < 4; ++e) {
        xb[e] = (unsigned)__builtin_amdgcn_update_dpp((int)b[e], (int)a[e], 0x128, 0xf, 0x3, false);
        xa[e] = (unsigned)__builtin_amdgcn_update_dpp((int)a[e], (int)b[e], 0x128, 0xf, 0xC, false); } }
__device__ __forceinline__ u32x4 ror8(const u32x4 v) { u32x4 r;
#pragma unroll
    for (int d = 0; d < 4; ++d) r[d] = (unsigned)__builtin_amdgcn_update_dpp(0, (int)v[d], 0x128, 0xf, 0xf, true);
    return r; }
template <bool NT = false>
__device__ __forceinline__ void store_pair(bf16_t* base, int pitch, int rowb, int colw, int fr, const u32x4 p0, const u32x4 p1) {
    const bool hi8 = (fr & 8) != 0; u32x4 dA, dB; swap8(p0, p1, dA, dB);
    bf16_t* pa = base + (size_t)(rowb + (fr & 7)) * pitch + colw + (hi8 ? 32 : 0);
    if constexpr (NT) { __builtin_nontemporal_store(dA, (u32x4*)pa); __builtin_nontemporal_store(dB, (u32x4*)(pa + (size_t)8 * pitch)); }
    else { *(u32x4*)pa = dA; *(u32x4*)(pa + (size_t)8 * pitch) = dB; } }
__device__ __forceinline__ void load_raw(const bf16_t* base, int pitch, int rowb, int colw, int fr, u32x4& LA, u32x4& LB) {
    const bool hi8 = (fr & 8) != 0; const bf16_t* pa = base + (size_t)(rowb + (fr & 7)) * pitch + colw + (hi8 ? 32 : 0);
    LA = *(const u32x4*)pa; LB = *(const u32x4*)(pa + (size_t)8 * pitch); }
__device__ __forceinline__ void unswap(int fr, const u32x4 LA, const u32x4 LB, u32x4& p0, u32x4& p1) {
    (void)fr; swap8(LA, LB, p0, p1); }

struct EpiGlaIn {
    static constexpr bool PERM = true, AFTER_DRAIN = false;
    const PG8_LAS float* rt; bf16_t* proj; float* aux;
    __device__ __forceinline__ void operator()(const f32x4 (&acc)[2][2][4][2], const Unit& u, int wr, int wc, int fr, int fq) const {
        asm volatile("" : "+v"(fr), "+v"(fq));
        const int rowb0 = u.pm * BM + wr * 64, colw = u.pn * BM + 64 * wc + 8 * fq; float rs[2][4]; lane_rstd_lds(rt, u.idx, wr * 64 + fr, rs);
#pragma unroll
        for (int ai = 0; ai < 2; ++ai)
#pragma unroll
            for (int m = 0; m < 4; ++m) { const float s = rs[ai][m];
                store_pair<PROJ_NT != 0>(proj, 3328, rowb0 + ai * HALF + m * 16, colw, fr, pack8(acc[ai][0][m][0] * s, acc[ai][0][m][1] * s), pack8(acc[ai][1][m][0] * s, acc[ai][1][m][1] * s)); }
    }
};
struct EpiFoxIn {
    static constexpr bool PERM = true, AFTER_DRAIN = false;
    const PG8_LAS float* rt; bf16_t* proj; float* aux; const float* bf; const float* qg; const float* kg;
    __device__ __forceinline__ void operator()(const f32x4 (&acc)[2][2][4][2], const Unit& u, int wr, int wc, int fr, int fq) const {
        asm volatile("" : "+v"(fr), "+v"(fq));
        const int rowb0 = u.pm * BM + wr * 64, colw = u.pn * BM + 64 * wc + 8 * fq; float rs[2][4]; lane_rstd_lds(rt, u.idx, wr * 64 + fr, rs);
        if (u.pn < 8) {
            const bool isq = u.pn < 4; const float* gsrc = isq ? qg : kg; const float gmul = isq ? (0.125f * 1.4426950408889634f) : 1.0f;
            f32x4 gv[2][2];
#pragma unroll
            for (int bj = 0; bj < 2; ++bj)
#pragma unroll
                for (int n = 0; n < 2; ++n) gv[bj][n] = *(const f32x4*)(gsrc + 32 * bj + 8 * fq + 4 * n) * gmul;
#pragma unroll
            for (int ai = 0; ai < 2; ++ai)
#pragma unroll
                for (int m = 0; m < 4; ++m) { const float s = rs[ai][m]; f32x4 v[2][2]; float q = 0.f;
#pragma unroll
                    for (int bj = 0; bj < 2; ++bj)
#pragma unroll
                        for (int n = 0; n < 2; ++n) { v[bj][n] = acc[ai][bj][m][n] * s; q += (v[bj][n][0] * v[bj][n][0] + v[bj][n][1] * v[bj][n][1]) + (v[bj][n][2] * v[bj][n][2] + v[bj][n][3] * v[bj][n][3]); }
                    q = rows4_sum(q);
                    const float hr = rsqrtf(q * (1.0f / 64.0f) + 1e-6f);
                    store_pair<PROJ_NT != 0>(proj, 4352, rowb0 + ai * HALF + m * 16, colw, fr, pack8(v[0][0] * hr * gv[0][0], v[0][1] * hr * gv[0][1]), pack8(v[1][0] * hr * gv[1][0], v[1][1] * hr * gv[1][1])); }
        } else {
#pragma unroll
            for (int ai = 0; ai < 2; ++ai)
#pragma unroll
                for (int m = 0; m < 4; ++m) { const float s = rs[ai][m];
                    store_pair<PROJ_NT != 0>(proj, 4352, rowb0 + ai * HALF + m * 16, colw, fr, pack8(acc[ai][0][m][0] * s, acc[ai][0][m][1] * s), pack8(acc[ai][1][m][0] * s, acc[ai][1][m][1] * s)); }
        }
    }
};
__device__ __forceinline__ void unpack8(const u32x4 g, f32x4& g0, f32x4& g1) {
    g0[0] = __uint_as_float(g.x << 16); g0[1] = __uint_as_float(g.x & 0xffff0000u); g0[2] = __uint_as_float(g.y << 16); g0[3] = __uint_as_float(g.y & 0xffff0000u);
    g1[0] = __uint_as_float(g.z << 16); g1[1] = __uint_as_float(g.z & 0xffff0000u); g1[2] = __uint_as_float(g.w << 16); g1[3] = __uint_as_float(g.w & 0xffff0000u);
}
__device__ __forceinline__ void store_h_rows(bf16_t* hb, float* ssq, int rowb, int colw, int slot, int fr, int fq, const f32x4 (&v)[2][2]) {
    float q = 0.f;
#pragma unroll
    for (int bj = 0; bj < 2; ++bj)
#pragma unroll
        for (int n = 0; n < 2; ++n) q += (v[bj][n][0] * v[bj][n][0] + v[bj][n][1] * v[bj][n][1]) + (v[bj][n][2] * v[bj][n][2] + v[bj][n][3] * v[bj][n][3]);
    store_pair(hb, 1024, rowb, colw, fr, pack8(v[0][0], v[0][1]), pack8(v[1][0], v[1][1]));
    q = rows4_sum(q);
    if (fq == 0) ssq[(size_t)(rowb + fr) * 16 + slot] = q;
}
template <bool X32> struct EpiOut {
    static constexpr bool PERM = true, AFTER_DRAIN = false;
    const float* x; bf16_t* hb; float* ssq;
    __device__ __forceinline__ void operator()(const f32x4 (&acc)[2][2][4][2], const Unit& u, int wr, int wc, int fr, int fq) const {
        asm volatile("" : "+v"(fr), "+v"(fq));
        const int rowb0 = u.pm * BM + wr * 64, colw = u.pn * BM + 64 * wc + 8 * fq, slot = u.pn * 4 + wc;
#pragma unroll
        for (int ai = 0; ai < 2; ++ai) {
            if constexpr (X32) {
                f32x4 pre[4][2][2];
#pragma unroll
                for (int m = 0; m < 4; ++m)
#pragma unroll
                    for (int bj = 0; bj < 2; ++bj) { const size_t o = (size_t)(rowb0 + ai * HALF + m * 16 + fr) * 1024 + colw + 32 * bj; pre[m][bj][0] = *(const f32x4*)(x + o); pre[m][bj][1] = *(const f32x4*)(x + o + 4); }
#pragma unroll
                for (int m = 0; m < 4; ++m) { f32x4 v[2][2];
#pragma unroll
                    for (int bj = 0; bj < 2; ++bj) { v[bj][0] = pre[m][bj][0] + acc[ai][bj][m][0]; v[bj][1] = pre[m][bj][1] + acc[ai][bj][m][1]; }
                    store_h_rows(hb, ssq, rowb0 + ai * HALF + m * 16, colw, slot, fr, fq, v); }
            } else {
                u32x4 la[4], lb[4];
#pragma unroll
                for (int m = 0; m < 4; ++m) load_raw(hb, 1024, rowb0 + ai * HALF + m * 16, colw, fr, la[m], lb[m]);
#pragma unroll
                for (int m = 0; m < 4; ++m) { u32x4 q0, q1; unswap(fr, la[m], lb[m], q0, q1); f32x4 v[2][2], h0, h1;
                    unpack8(q0, h0, h1); v[0][0] = h0 + acc[ai][0][m][0]; v[0][1] = h1 + acc[ai][0][m][1];
                    unpack8(q1, h0, h1); v[1][0] = h0 + acc[ai][1][m][0]; v[1][1] = h1 + acc[ai][1][m][1];
                    store_h_rows(hb, ssq, rowb0 + ai * HALF + m * 16, colw, slot, fr, fq, v); }
            }
            asm volatile("" ::: "memory");
        }
    }
};
struct EpiP {
    static constexpr bool PERM = true, AFTER_DRAIN = false;
    bf16_t* pp;
    __device__ __forceinline__ void operator()(const f32x4 (&acc)[2][2][4][2], const Unit& u, int wr, int wc, int fr, int fq) const {
        asm volatile("" : "+v"(fr), "+v"(fq));
        const int rowb0 = u.pm * BM + wr * 64, colw = u.pn * BM + 64 * wc + 8 * fq;
#pragma unroll
        for (int ai = 0; ai < 2; ++ai)
#pragma unroll
            for (int m = 0; m < 4; ++m) store_pair(pp, 1024, rowb0 + ai * HALF + m * 16, colw, fr, pack8(acc[ai][0][m][0], acc[ai][0][m][1]), pack8(acc[ai][1][m][0], acc[ai][1][m][1]));
    }
};
struct EpiGateFinal {
    static constexpr bool PERM = true, AFTER_DRAIN = false;
    unsigned char* ws; const bf16_t* hin; bf16_t* hout; const PG8_LAS float* rt; size_t off_pp, off_ssq_out;
    __device__ __forceinline__ void operator()(const f32x4 (&acc)[2][2][4][2], const Unit& u, int wr, int wc, int fr, int fq) const {
        asm volatile("" : "+v"(fr), "+v"(fq));
        const bf16_t* pp = (const bf16_t*)(ws + off_pp); float* ssq_out = (float*)(ws + off_ssq_out);
        const int rowb0 = u.pm * BM + wr * 64, colw = u.pn * BM + 64 * wc + 8 * fq, slot = u.pn * 4 + wc; float rs[2][4]; lane_rstd_lds(rt, u.idx, wr * 64 + fr, rs);
#pragma unroll
        for (int ai = 0; ai < 2; ++ai)
#pragma unroll
            for (int mh = 0; mh < 2; ++mh) {
                u32x4 ha[2], hb_[2], ga[2], gb[2];
#pragma unroll
                for (int mm = 0; mm < 2; ++mm) { const int rowb = rowb0 + ai * HALF + (2 * mh + mm) * 16; load_raw(hin, 1024, rowb, colw, fr, ha[mm], hb_[mm]); load_raw(pp, 1024, rowb, colw, fr, ga[mm], gb[mm]); }
#pragma unroll
                for (int mm = 0; mm < 2; ++mm) { const int m = 2 * mh + mm; const float s = rs[ai][m] * -1.4426950408889634f; f32x4 v[2][2]; u32x4 hq[2], pq[2];
                    unswap(fr, ha[mm], hb_[mm], hq[0], hq[1]); unswap(fr, ga[mm], gb[mm], pq[0], pq[1]);
#pragma unroll
                    for (int bj = 0; bj < 2; ++bj) { f32x4 h0, h1, p0, p1; unpack8(hq[bj], h0, h1); unpack8(pq[bj], p0, p1);
                        f32x4 a = acc[ai][bj][m][0] * s, b = acc[ai][bj][m][1] * s;
#pragma unroll
                        for (int i = 0; i < 4; ++i) { a[i] = __builtin_amdgcn_rcpf(1.f + __builtin_amdgcn_exp2f(a[i])); b[i] = __builtin_amdgcn_rcpf(1.f + __builtin_amdgcn_exp2f(b[i])); }
                        v[bj][0] = h0 + p0 * a; v[bj][1] = h1 + p1 * b; }
                    store_h_rows(hout, ssq_out, rowb0 + ai * HALF + m * 16, colw, slot, fr, fq, v); }
                asm volatile("" ::: "memory");
            }
    }
};
template <class Epi, class Sched, bool ALIGN_EPI = false, bool SP2 = false>
__device__ __forceinline__ void gemm_phase(PG8_LAS unsigned char* lds, const Gemm g, const Sched& S, const Epi& E, const int wid  ) {
    int lane_; asm volatile("v_mbcnt_lo_u32_b32 %0, -1, 0\n\tv_mbcnt_hi_u32_b32 %0, -1, %0" : "=v"(lane_));
    const int lane = lane_, tid = wid * 64 + lane, wr = wid >> 2, wc = wid & 3, fr = lane & 15, fq = lane >> 4;
    const int K = g.K, nt = K / BK;
    unsigned voffA[2], voffB[2];
#pragma unroll
    for (int i = 0; i < 2; ++i) { int R, C; stage_rc(tid * 16 + i * 8192, R, C); const int Rb = Epi::PERM ? ((R & ~31) + perm32(R & 31)) : R;
        voffA[i] = (unsigned)(R * K + C) * 2u; voffB[i] = (unsigned)(Rb * K + C) * 2u; }
    const size_t kstep = (size_t)(BK * 2);
    const size_t hstep = (size_t)HALF * K * 2;
    const size_t tstep = 2 * hstep;
    const unsigned ldsw = (unsigned)wid * 1024u;
    const int aoff = lds_byte(wr * 64 + fr, fq * 8), boff = lds_byte(wc * 32 + fr, fq * 8);
#define PG8_SA(b, h) (((b) * 2 + (h)) * HTB)
#define PG8_SB(b, h) ((4 + (b) * 2 + (h)) * HTB)
#define PG8_STAGE(bufoff, gbase, voff) do { _Pragma("unroll") for (int _i = 0; _i < 2; ++_i) \
        __builtin_amdgcn_global_load_lds((const unsigned*)((const char*)(gbase) + (voff)[_i]), (PG8_LAS unsigned*)(lds + (bufoff) + ldsw + _i * 8192), 16, 0, 0); } while (0)
#define PG8_LDA(dst, b, h) do { _Pragma("unroll") for (int m = 0; m < 4; ++m) _Pragma("unroll") for (int k = 0; k < 2; ++k) dst[m][k] = *(const PG8_LAS bf16x8*)(lds + PG8_SA(b, h) + aoff + m * 2048 + k * 1024); } while (0)
#define PG8_LDB(dst, b, h) do { _Pragma("unroll") for (int n = 0; n < 2; ++n) _Pragma("unroll") for (int k = 0; k < 2; ++k) dst[n][k] = *(const PG8_LAS bf16x8*)(lds + PG8_SB(b, h) + boff + n * 2048 + k * 1024); } while (0)
#define PG8_MMA(ai, bj, At, Bt) do { __builtin_amdgcn_s_setprio(1); _Pragma("unroll") for (int m = 0; m < 4; ++m) _Pragma("unroll") for (int n = 0; n < 2; ++n) _Pragma("unroll") for (int k = 0; k < 2; ++k) \
        acc[ai][bj][m][n] = __builtin_amdgcn_mfma_f32_16x16x32_bf16(Bt[n][k], At[m][k], acc[ai][bj][m][n], 0, 0, 0); __builtin_amdgcn_s_setprio(0); } while (0)
#define PG8_WAIT_V(n) asm volatile("s_waitcnt vmcnt(" #n ")" ::: "memory")
#define PG8_WAIT_L(n) asm volatile("s_waitcnt lgkmcnt(" #n ")" ::: "memory")
#define PG8_BAR __builtin_amdgcn_s_barrier()
#define PG8_SCHED __builtin_amdgcn_sched_barrier(0)
    Unit cur, nxt; int ui = 0;
    if (!S.next(0, cur)) return;
    f32x4 acc[2][2][4][2];
#pragma unroll
    for (int a = 0; a < 2; ++a)
#pragma unroll
        for (int b = 0; b < 2; ++b)
#pragma unroll
            for (int m = 0; m < 4; ++m)
#pragma unroll
                for (int n = 0; n < 2; ++n) acc[a][b][m][n] = (f32x4){0.f, 0.f, 0.f, 0.f};
    bf16x8 At[4][2], B0[2][2], B1[2][2];
    const char* cA = (const char*)g.A + (size_t)cur.pm * tstep; const char* cB = (const char*)g.Bt + (size_t)cur.pn * tstep;
    S.a_ready(cur);
    if constexpr (SP2) {
        PG8_STAGE(PG8_SB(0, 0), cB, voffB); PG8_STAGE(PG8_SB(0, 1), cB + hstep, voffB); PG8_STAGE(PG8_SA(0, 0), cA, voffA); PG8_STAGE(PG8_SA(0, 1), cA + hstep, voffA);
        if (wr == 1) PG8_BAR;
        PG8_WAIT_V(2); PG8_BAR;
        PG8_STAGE(PG8_SB(1, 0), cB + kstep, voffB); PG8_STAGE(PG8_SA(1, 0), cA + kstep, voffA); PG8_STAGE(PG8_SB(1, 1), cB + hstep + kstep, voffB);
        PG8_WAIT_V(6); PG8_BAR;
    } else {
        PG8_STAGE(PG8_SB(0, 0), cB, voffB); PG8_STAGE(PG8_SA(0, 0), cA, voffA); PG8_STAGE(PG8_SB(0, 1), cB + hstep, voffB); PG8_STAGE(PG8_SA(0, 1), cA + hstep, voffA);
        if (wr == 1) PG8_BAR;
        PG8_WAIT_V(4); PG8_BAR;
        PG8_STAGE(PG8_SB(1, 0), cB + kstep, voffB); PG8_STAGE(PG8_SA(1, 0), cA + kstep, voffA); PG8_STAGE(PG8_SB(1, 1), cB + hstep + kstep, voffB);
        PG8_WAIT_V(6); PG8_BAR;
    }
    for (;;) {
        const bool has_next = S.next(ui + 1, nxt);
        const char* nA = has_next ? (const char*)g.A + (size_t)nxt.pm * tstep : cA; const char* nB = has_next ? (const char*)g.Bt + (size_t)nxt.pn * tstep : cB;
        for (int t = 0; t < nt; t += 2) {
            const bool last = (t == nt - 2);
            const char* a1 = cA + (size_t)(t + 1) * kstep;
            const char* a2 = last ? nA : cA + (size_t)(t + 2) * kstep; const char* b2 = last ? nB : cB + (size_t)(t + 2) * kstep;
            const char* a3 = a2 + kstep; const char* b3 = b2 + kstep;
            if (last && has_next) S.a_ready(nxt);
            if constexpr (SP2) {
            PG8_LDB(B0, 0, 0); PG8_LDB(B1, 0, 1); PG8_SCHED; PG8_LDA(At, 0, 0); PG8_STAGE(PG8_SA(1, 1), a1 + hstep, voffA);
            PG8_WAIT_V(8); PG8_WAIT_L(0); PG8_BAR; PG8_MMA(0, 0, At, B0); PG8_MMA(0, 1, At, B1); PG8_BAR; PG8_SCHED;
            PG8_LDA(At, 0, 1); PG8_STAGE(PG8_SB(0, 0), b2, voffB); PG8_STAGE(PG8_SB(0, 1), b2 + hstep, voffB); PG8_STAGE(PG8_SA(0, 0), a2, voffA);
            PG8_WAIT_V(8); PG8_WAIT_L(0); PG8_BAR; PG8_MMA(1, 0, At, B0); PG8_MMA(1, 1, At, B1); PG8_BAR; PG8_SCHED;
            PG8_LDB(B0, 1, 0); PG8_LDB(B1, 1, 1); PG8_SCHED; PG8_LDA(At, 1, 0); PG8_STAGE(PG8_SA(0, 1), a2 + hstep, voffA);
            PG8_WAIT_V(8); PG8_WAIT_L(0); PG8_BAR; PG8_MMA(0, 0, At, B0); PG8_MMA(0, 1, At, B1); PG8_BAR; PG8_SCHED;
            PG8_LDA(At, 1, 1); PG8_STAGE(PG8_SB(1, 0), b3, voffB); PG8_STAGE(PG8_SB(1, 1), b3 + hstep, voffB); PG8_STAGE(PG8_SA(1, 0), a3, voffA);
            PG8_WAIT_V(8); PG8_WAIT_L(0); PG8_BAR; PG8_MMA(1, 0, At, B0); PG8_MMA(1, 1, At, B1); PG8_BAR; PG8_SCHED;
            } else {
            PG8_LDB(B0, 0, 0); PG8_SCHED; PG8_LDA(At, 0, 0); PG8_STAGE(PG8_SA(1, 1), a1 + hstep, voffA);
            PG8_WAIT_L(8); PG8_BAR; PG8_WAIT_L(0); PG8_MMA(0, 0, At, B0); PG8_BAR; PG8_SCHED;
            PG8_LDB(B1, 0, 1); PG8_STAGE(PG8_SB(0, 0), b2, voffB);
            PG8_BAR; PG8_WAIT_L(0); PG8_MMA(0, 1, At, B1); PG8_BAR;
            PG8_LDA(At, 0, 1); PG8_STAGE(PG8_SA(0, 0), a2, voffA);
            PG8_BAR; PG8_WAIT_L(0); PG8_MMA(1, 0, At, B0); PG8_BAR; PG8_SCHED;
            PG8_STAGE(PG8_SB(0, 1), b2 + hstep, voffB);
            PG8_WAIT_V(6); PG8_BAR; PG8_MMA(1, 1, At, B1); PG8_BAR;
            PG8_LDB(B0, 1, 0); PG8_SCHED; PG8_LDA(At, 1, 0); PG8_STAGE(PG8_SA(0, 1), a2 + hstep, voffA);
            PG8_WAIT_L(8); PG8_BAR; PG8_WAIT_L(0); PG8_MMA(0, 0, At, B0); PG8_BAR; PG8_SCHED;
            PG8_LDB(B1, 1, 1); PG8_STAGE(PG8_SB(1, 0), b3, voffB);
            PG8_BAR; PG8_WAIT_L(0); PG8_MMA(0, 1, At, B1); PG8_BAR;
            PG8_LDA(At, 1, 1); PG8_STAGE(PG8_SA(1, 0), a3, voffA);
            PG8_BAR; PG8_WAIT_L(0); PG8_MMA(1, 0, At, B0); PG8_BAR; PG8_SCHED;
            PG8_STAGE(PG8_SB(1, 1), b3 + hstep, voffB);
            PG8_WAIT_V(6); PG8_BAR; PG8_MMA(1, 1, At, B1); PG8_BAR;
            }
        }
        if constexpr (ALIGN_EPI) { if (wr == 0) PG8_BAR; }
        if constexpr (!Epi::AFTER_DRAIN) { E(acc, cur, wr, wc, fr, fq); S.done(cur); }
        if (!has_next) break;
#pragma unroll
        for (int a = 0; a < 2; ++a)
#pragma unroll
            for (int b = 0; b < 2; ++b)
#pragma unroll
                for (int m = 0; m < 4; ++m)
#pragma unroll
                    for (int n = 0; n < 2; ++n) acc[a][b][m][n] = (f32x4){0.f, 0.f, 0.f, 0.f};
        cur = nxt; cA = nA; cB = nB; ++ui;
        if constexpr (ALIGN_EPI) { if (wr == 1) PG8_BAR; }
    }
    PG8_WAIT_V(0);
    if constexpr (!ALIGN_EPI) { if (wr == 0) PG8_BAR; }
    PG8_BAR;
    if constexpr (Epi::AFTER_DRAIN) { E.fused(acc, cur, wr, wc, fr, fq, lds, wid, lane); S.done(cur); }
#undef PG8_SA
#undef PG8_SB
#undef PG8_STAGE
#undef PG8_LDA
#undef PG8_LDB
#undef PG8_MMA
#undef PG8_WAIT_V
#undef PG8_WAIT_L
#undef PG8_BAR
#undef PG8_SCHED
}
}
#define GAS __attribute__((address_space(1)))
#define LAS __attribute__((address_space(3)))
typedef unsigned short bf16;
typedef unsigned v4u __attribute__((ext_vector_type(4)));
typedef float f32x4 __attribute__((ext_vector_type(4)));
typedef short bf16x8 __attribute__((ext_vector_type(8)));
typedef GAS unsigned gu32;
typedef GAS unsigned long long gu64;
#define RLX_AGENT __ATOMIC_RELAXED, __HIP_MEMORY_SCOPE_AGENT
#define LDS_WAIT() asm volatile("s_waitcnt lgkmcnt(0)" ::: "memory")
#define VM_WAIT() asm volatile("s_waitcnt vmcnt(0)" ::: "memory")
__device__ __forceinline__ unsigned long long rt() { return __builtin_amdgcn_s_memrealtime(); }
__device__ __forceinline__ unsigned f2bf(float f) { unsigned u = __builtin_bit_cast(unsigned, f); return (u + 0x7fffu + ((u >> 16) & 1u)) >> 16; }
__device__ __forceinline__ unsigned pk2(float lo, float hi) { return f2bf(lo) | (f2bf(hi) << 16); }
#define XB_TMO      128
#define XB_XCNT(j)  (256  + 64 * (j))
#define XB_XSUB(j)  (1280 + 64 * (j))
#define XB_XGEN(j)  (2304 + 64 * (j))
#define XB_TOP      3328
#define XB_TOPGEN   3392
#define XCD_BAR_WORDS 3456
#define XB_SPIN_CAP (1u << 18)

__device__ __forceinline__ unsigned xb_ld(unsigned* p)              { return __hip_atomic_load(p, __ATOMIC_RELAXED, __HIP_MEMORY_SCOPE_AGENT); }
__device__ __forceinline__ unsigned xb_add(unsigned* p, unsigned v) { return __hip_atomic_fetch_add(p, v, __ATOMIC_RELAXED, __HIP_MEMORY_SCOPE_AGENT); }
__device__ __forceinline__ unsigned xb_xcc_id() { return (unsigned)__builtin_amdgcn_s_getreg((3 << 11) | 20) & 0xFu; }
#define XB_SPIN(cond, bar) do { unsigned _sp = 0; while (cond) { __builtin_amdgcn_s_sleep(1); \
    if ((++_sp & 255u) == 0u) { if (xb_ld(&(bar)[XB_TMO])) break; if (_sp > XB_SPIN_CAP) { atomicAdd(&(bar)[XB_TMO], 1u); break; } } } } while (0)

struct XcdBarrier {
    unsigned* bar; unsigned x;
    volatile LAS unsigned* st;
};

__device__ __forceinline__ XcdBarrier xcd_barrier_post(unsigned* bar, volatile LAS unsigned* st) {
    XcdBarrier b; b.bar = bar; b.x = xb_xcc_id(); b.st = st;
    if (threadIdx.x == 0) (void)xb_add(&bar[XB_XCNT(b.x)], 1u);
    return b;
}
__device__ __forceinline__ void xcd_barrier_complete(unsigned* bar, unsigned x, unsigned& nloc, unsigned& nx) {
    const unsigned G = gridDim.x * gridDim.y * gridDim.z;
    unsigned sum, cnt, mine, sp = 0u;
    for (;;) {
        sum = 0u; cnt = 0u; mine = 0u;
#pragma unroll
        for (unsigned j = 0; j < 16; ++j) { const unsigned c = xb_ld(&bar[XB_XCNT(j)]); sum += c; cnt += (c > 0u) ? 1u : 0u; mine = (j == x) ? c : mine; }
        if (sum == G) break;
        __builtin_amdgcn_s_sleep(1);
        if ((++sp & 255u) == 0u) { if (xb_ld(&bar[XB_TMO])) break; if (sp > XB_SPIN_CAP) { atomicAdd(&bar[XB_TMO], 1u); break; } }
    }
    nloc = mine > 0u ? mine : 1u; nx = cnt > 0u ? cnt : 1u;
}

__device__ __forceinline__ void xcd_barrier(const XcdBarrier& b, const int wave_) {
    asm volatile("s_waitcnt vmcnt(0)" ::: "memory");
    __syncthreads();
    int l0_; asm volatile("v_mbcnt_lo_u32_b32 %0, -1, 0\n\tv_mbcnt_hi_u32_b32 %0, -1, %0" : "=v"(l0_));
    if (wave_ == 0 && l0_ == 0) {
        unsigned* bar = b.bar;
        __builtin_amdgcn_s_waitcnt(0);
        unsigned nloc = b.st[0], nx = b.st[1];
        if (nloc == 0u) { xcd_barrier_complete(bar, b.x, nloc, nx); b.st[0] = nloc; b.st[1] = nx; }
        const unsigned old = xb_add(&bar[XB_XSUB(b.x)], 1u);
        const unsigned gen = old / nloc;
        if (old + 1u == (gen + 1u) * nloc) {
            __builtin_amdgcn_fence(__ATOMIC_RELEASE, "agent");
            asm volatile("s_waitcnt vmcnt(0)" ::: "memory");
            const unsigned og = xb_add(&bar[XB_TOP], 1u);
            const unsigned tg = og / nx;
            if (og + 1u == (tg + 1u) * nx) xb_add(&bar[XB_TOPGEN], 1u);
            else XB_SPIN(xb_ld(&bar[XB_TOPGEN]) == tg, bar);
            __builtin_amdgcn_fence(__ATOMIC_ACQUIRE, "agent");
            xb_add(&bar[XB_XGEN(b.x)], 1u);
            asm volatile("s_waitcnt vmcnt(0)" ::: "memory");
        } else {
            XB_SPIN(xb_ld(&bar[XB_XGEN(b.x)]) == gen, bar);
            __builtin_amdgcn_fence(__ATOMIC_ACQUIRE, "agent");
            asm volatile("s_waitcnt vmcnt(0)" ::: "memory");
        }
    }
    __syncthreads();
}
#include <hip/hip_bf16.h>
#include <cmath>
namespace attn_body {
using bf16=__hip_bfloat16;
using bf16x8=__attribute__((ext_vector_type(8)))short;
using s16x4=__attribute__((ext_vector_type(4)))short;
using f32x16=__attribute__((ext_vector_type(16)))float;
using u32x4=__attribute__((ext_vector_type(4)))unsigned;
using u32x2_t=__attribute__((ext_vector_type(2)))unsigned;
constexpr int BATCH=16,NHEAD=16,SEQ=2048,D=64,DM=4352,PO=1024;
constexpr int NW=8,QBLK=32,QB=QBLK*NW,KVBLK=64,NQB=SEQ/QB;
constexpr int ATTN_PITCH=DM, ATTN_UNIT_ROWS=QB;
typedef __attribute__((address_space(3))) const float* lds_fptr; typedef float f32x4a __attribute__((ext_vector_type(4)));
__device__ __forceinline__ int crow(int r,int hi){return (r&3)+8*(r>>2)+4*hi;}
__device__ __forceinline__ int fresh_lane(){ int l; asm volatile("v_mbcnt_lo_u32_b32 %0, -1, 0\n\tv_mbcnt_hi_u32_b32 %0, -1, %0" : "=v"(l)); return l; }
#define SBAR() __builtin_amdgcn_sched_barrier(0)
__device__ __forceinline__ void cmask(f32x16&p0,f32x16&p1,int jb,int qrel,int hi){
  const float NEG=-INFINITY; int kb=64*jb+4*hi;
  #pragma unroll
  for(int r=0;r<16;++r){int kv=kb+(r&3)+8*(r>>2); if(kv>qrel)p0[r]=NEG; if(kv+32>qrel)p1[r]=NEG;}
}

constexpr int NSLOT=3, SLOTB=8192;
constexpr int LDS_K=0, LDS_V=NSLOT*SLOTB, QST_HI=131584  , RING_SET=2*NSLOT*SLOTB  , LDS_WS=2*RING_SET, LDS_BYTES=LDS_WS+NW*64*4+SEQ*4+SEQ*8+4096;
constexpr int SEAM_C2F=LDS_WS+NW*64*4  , SEAM_C2S=SEAM_C2F+SEQ*4  , QST_W7=SEAM_C2S+SEQ*8;
constexpr float C2=0.125f*1.4426950408889634f;
__device__ __forceinline__ void glds16(const void*gsrc,unsigned lds_dst){unsigned keep;
  asm volatile("s_mov_b32 %0, m0\n\ts_mov_b32 m0, %2\n\ts_nop 0\n\tglobal_load_lds_dwordx4 %1, off\n\ts_mov_b32 m0, %0":"=&s"(keep):"v"(gsrc),"s"(lds_dst):"memory");}
__device__ __forceinline__ float max3f(float a,float b,float c){float r;asm("v_max3_f32 %0, %1, %2, %3":"=v"(r):"v"(a),"v"(b),"v"(c));return r;}
__device__ __forceinline__ float max2f(float a,float b){float r;asm("v_max_f32_e32 %0, %1, %2":"=v"(r):"v"(a),"v"(b));return r;}
__device__ __forceinline__ float fadd_s(float a,float b){float r;asm("v_add_f32_e32 %0, %1, %2":"=v"(r):"v"(a),"v"(b));return r;}
__device__ __forceinline__ float fsub_s(float a,float b){float r;asm("v_sub_f32_e32 %0, %1, %2":"=v"(r):"v"(a),"v"(b));return r;}
typedef float f32x2_t __attribute__((ext_vector_type(2))); typedef __bf16 bf16x2_t __attribute__((ext_vector_type(2)));
__device__ __forceinline__ unsigned cvtpk_s(float lo,float hi){f32x2_t v={lo,hi};bf16x2_t b=__builtin_convertvector(v,bf16x2_t);return __builtin_bit_cast(unsigned,b);}
#define WAIT_BAR(N) asm volatile("s_waitcnt vmcnt(" #N ") lgkmcnt(0)\n\ts_barrier":::"memory")

__device__ __forceinline__ void qkt(f32x16&p0,f32x16&p1,const char*Kslot,const bf16x8*qr,const f32x16&negm0,const f32x16&negm1,int r32,int hi){
  const char*kb=Kslot+hi*1024+r32*16;
  #pragma unroll
  for(int d0=0;d0<4;++d0){
    const bf16x8 b0=*reinterpret_cast<const bf16x8*>(kb+d0*2048);
    const bf16x8 b1=*reinterpret_cast<const bf16x8*>(kb+d0*2048+512);
    if(d0==0){p0=__builtin_amdgcn_mfma_f32_32x32x16_bf16(b0,qr[0],negm0,0,0,0);p1=__builtin_amdgcn_mfma_f32_32x32x16_bf16(b1,qr[0],negm1,0,0,0);}
    else{p0=__builtin_amdgcn_mfma_f32_32x32x16_bf16(b0,qr[d0],p0,0,0,0);p1=__builtin_amdgcn_mfma_f32_32x32x16_bf16(b1,qr[d0],p1,0,0,0);}}
}
typedef __attribute__((address_space(3))) const char* lds_cptr;
typedef short v4i16_t __attribute__((ext_vector_type(4)));
__device__ __forceinline__ void kload8(bf16x8*kf,lds_cptr kp){
  kf[0]=*(const __attribute__((address_space(3))) bf16x8*)(kp);      kf[1]=*(const __attribute__((address_space(3))) bf16x8*)(kp+512);
  kf[2]=*(const __attribute__((address_space(3))) bf16x8*)(kp+2048); kf[3]=*(const __attribute__((address_space(3))) bf16x8*)(kp+2560);
  kf[4]=*(const __attribute__((address_space(3))) bf16x8*)(kp+4096); kf[5]=*(const __attribute__((address_space(3))) bf16x8*)(kp+4608);
  kf[6]=*(const __attribute__((address_space(3))) bf16x8*)(kp+6144); kf[7]=*(const __attribute__((address_space(3))) bf16x8*)(kp+6656);
}
__device__ __forceinline__ void kload2(bf16x8*kf,lds_cptr kp,int j){ kf[2*j]=*(const __attribute__((address_space(3))) bf16x8*)(kp+j*2048); kf[2*j+1]=*(const __attribute__((address_space(3))) bf16x8*)(kp+j*2048+512); }
__device__ __forceinline__ s16x4 vtr(lds_cptr p){ return __builtin_bit_cast(s16x4,__builtin_amdgcn_ds_read_tr16_b64_v4i16((__attribute__((address_space(3))) v4i16_t*)p)); }
__device__ __forceinline__ float rowmax(const f32x16&p0,const f32x16&p1){
  float a=max3f(p0[0],p0[1],p1[0]),b=max3f(p0[2],p0[3],p1[1]);a=max3f(a,p1[2],p1[3]);
  #pragma unroll
  for(int r=4;r<16;r+=4){a=max3f(a,p0[r],p0[r+1]);b=max3f(b,p0[r+2],p0[r+3]);a=max3f(a,p1[r],p1[r+1]);b=max3f(b,p1[r+2],p1[r+3]);}
  const float m=max2f(a,b);
  auto rr=__builtin_amdgcn_permlane32_swap(__float_as_uint(m),__float_as_uint(m),false,false);
  return max2f(__uint_as_float(rr[0]),__uint_as_float(rr[1]));
}
__device__ __forceinline__ void pv(f32x16*o,int vb,bf16x8 pa0,bf16x8 pa1,bf16x8 pa2,bf16x8 pa3){
  #pragma unroll
  for(int d0=0;d0<2;++d0){s16x4 lo[4],hi[4];
    #pragma unroll
    for(int ks=0;ks<4;++ks){
      asm volatile("ds_read_b64_tr_b16 %0,%1 offset:%c2":"=&v"(lo[ks]):"v"(vb),"i"(d0*4096+ks*1024):"memory");
      asm volatile("ds_read_b64_tr_b16 %0,%1 offset:%c2":"=&v"(hi[ks]):"v"(vb),"i"(d0*4096+ks*1024+512):"memory");}
    asm volatile("s_waitcnt lgkmcnt(0)":::"memory");SBAR();
    #define PK(k) (bf16x8){lo[k][0],lo[k][1],lo[k][2],lo[k][3],hi[k][0],hi[k][1],hi[k][2],hi[k][3]}
    o[d0]=__builtin_amdgcn_mfma_f32_32x32x16_bf16(pa0,PK(0),o[d0],0,0,0);
    o[d0]=__builtin_amdgcn_mfma_f32_32x32x16_bf16(pa1,PK(1),o[d0],0,0,0);
    o[d0]=__builtin_amdgcn_mfma_f32_32x32x16_bf16(pa2,PK(2),o[d0],0,0,0);
    o[d0]=__builtin_amdgcn_mfma_f32_32x32x16_bf16(pa3,PK(3),o[d0],0,0,0);
    #undef PK
  }
}

#ifndef ATTN_STORE16
#define ATTN_STORE16(p,v) (*(u32x4*)(p)=(v))
#endif
template<int THRL,bool SM> __device__ __forceinline__ void attn_unit(int b,int h,int qb,const bf16*PR,bf16*O,char*shm,const lds_fptr c2l,const int wid,const float tskip,const int rb,const bool pre,const int nb,const int nh,const int nqb,const float*cumn,const unsigned c2n_lds){
  const int qst_off=(wid<7)?(QST_HI+wid*4096):QST_W7;
  char*shmr=shm+rb;
  const bf16*Q=PR; const bf16*K=PR+1024; const bf16*V=PR+2048; const bf16*Gt=PR+3072;
  int lane_; asm volatile("v_mbcnt_lo_u32_b32 %0, -1, 0\n\tv_mbcnt_hi_u32_b32 %0, -1, %0" : "=v"(lane_)); const int lane=lane_,r32=lane&31,hi=lane>>5;
  const long rowbase=(long)b*SEQ; const int q0=qb*QB;
  const bf16*Qw=Q+(rowbase+q0+wid*QBLK)*DM+h*D;
  const bf16*Kh=K+rowbase*DM+h*D,*Vh=V+rowbase*DM+h*D;
  const unsigned lds0=(unsigned)(uintptr_t)shmr;
  float*wsf=(float*)(shm+LDS_WS)+wid*64;
  const bf16*ksrc=Kh+(long)lane*DM+wid*8;
  const bf16*vsrc=Vh+(long)(16*(wid&3)+(lane>>2))*DM+(wid>>2)*32+(lane&3)*8;
  const unsigned kdst=lds0+LDS_K+wid*1024, vdst=lds0+LDS_V+wid*1024;
  #define DMA_K(t,slot) glds16(ksrc+(long)(t)*KVBLK*DM,(unsigned)__builtin_amdgcn_readfirstlane(kdst+(slot)))
  #define DMA_V(t,slot) glds16(vsrc+(long)(t)*KVBLK*DM,(unsigned)__builtin_amdgcn_readfirstlane(vdst+(slot)))
  const char*Kbase=shmr+LDS_K; bf16x8 kf[8];
  const lds_cptr shm3=(lds_cptr)shmr; const lds_cptr kp0=shm3+LDS_K+hi*1024+r32*16; const lds_cptr vp0=shm3+LDS_V+((lane>>4)&1)*32+(lane&3)*8+(4*hi+((lane&15)>>2))*64;
  const int NT=(q0+QB)/KVBLK;
#if ATTN_SKIP
  int t0; { const float cq0_=c2l[q0]; const float ce_=(lane<NT)?c2l[KVBLK*lane+KVBLK-1]:0.f; const unsigned long long m_=__ballot((lane<NT)&&((lane>=NT-4)||(cq0_-ce_>=-tskip)));
    t0=(int)__builtin_ctzll(m_|(1ull<<(NT-4))); t0&=~1; t0=__builtin_amdgcn_readfirstlane(t0); }
#else
  const int t0=0; (void)tskip;
#endif
  if(!pre){DMA_K(t0,0);DMA_V(t0,0);DMA_K(t0+1,SLOTB);}
  bf16x8 qr[4];
  if(!pre){
  #pragma unroll
  for(int d0=0;d0<4;++d0)qr[d0]=*reinterpret_cast<const bf16x8*>(&Qw[(long)r32*DM+d0*16+hi*8]); }
  typedef __attribute__((address_space(3))) const u32x2_t* lds_u2ptr;
  const lds_u2ptr cbl=(lds_u2ptr)((lds_cptr)shm+SEAM_C2S)+r32;
  const bf16x8 bneg=(hi==0)?(bf16x8){(short)0xBF80,(short)0xBF80,(short)0xBF80,0,0,0,0,0}:(bf16x8){0,0,0,0,0,0,0,0};
  #define BIASOP(a) __builtin_bit_cast(bf16x8,(u32x4){(a)[0],(a)[1],0u,0u})
  #define BIASM(t,half) __builtin_amdgcn_mfma_f32_32x32x16_bf16(BIASOP(cbl[(t)*KVBLK+32*(half)]),bneg,negm,0,0,0)
  #define CMASK(P0,P1,t) do{int jb_=(t)-(NT-4); if(jb_>=0){ const int L2_=fresh_lane(); cmask(P0,P1,jb_,wid*QBLK+(L2_&31),L2_>>5);} }while(0)
  bool resc=false;
  #define START(P0,P1) do{ resc=false; if constexpr(!SM){ const float rm=rowmax(P0,P1); \
    { const float dl=rm; mhat=fadd_s(mhat,dl); \
      _Pragma("unroll") for(int r=0;r<16;++r){P0[r]=fsub_s(P0[r],dl);P1[r]=fsub_s(P1[r],dl);} \
      _Pragma("unroll") for(int r=0;r<16;++r)negm[r]=-mhat; asm volatile("":"+v"(negm)); } } \
    _Pragma("unroll") for(int r=0;r<16;++r)P0[r]=__builtin_amdgcn_exp2f(P0[r]); }while(0)
  #define RESC() do{ if(resc){ asm volatile("s_waitcnt lgkmcnt(0)":::"memory"); \
      const int h3_=fresh_lane()>>5; _Pragma("unroll") for(int d_=0;d_<2;++d_) _Pragma("unroll") for(int r=0;r<16;++r)o[d_][r]*=wsf[crow(r,h3_)]; } }while(0)
  f32x16 pA0,pA1,pB0,pB1;
  int sl_prev=0,sl_cur=0,sl_next=SLOTB;
  #define ROT() do{sl_prev=sl_cur;sl_cur=sl_next;sl_next=(sl_next==(NSLOT-1)*SLOTB)?0:sl_next+SLOTB;}while(0)
  if(!pre){ DMA_K(t0+2,2*SLOTB);
    WAIT_BAR(3); }
  else { WAIT_BAR(4);
    const lds_cptr qs_=(lds_cptr)shm+qst_off+r32*128+hi*16;
    #pragma unroll
    for(int d0=0;d0<4;++d0)qr[d0]=*(const __attribute__((address_space(3))) bf16x8*)(qs_+d0*32); }
  {
    const int T5_=fresh_lane()+64*wid; const f32x4a c4_=*(const __attribute__((address_space(3))) f32x4a*)((lds_cptr)shm+SEAM_C2F+16*T5_); u32x4 s0_,s1_;
    #pragma unroll
    for(int e_=0;e_<4;++e_){ const float c_=c4_[e_]; const unsigned h_=cvtpk_s(c_,0.f)&0xffffu; const float r1_=c_-__uint_as_float(h_<<16);
      const unsigned m_=cvtpk_s(r1_,0.f)&0xffffu; const float r2_=r1_-__uint_as_float(m_<<16); const unsigned l_=cvtpk_s(r2_,0.f)&0xffffu;
      if(e_<2){s0_[2*e_]=h_|(m_<<16);s0_[2*e_+1]=l_;}else{s1_[2*(e_-2)]=h_|(m_<<16);s1_[2*(e_-2)+1]=l_;} }
    __attribute__((address_space(3))) u32x4*sp_=(__attribute__((address_space(3))) u32x4*)((lds_cptr)shm+SEAM_C2S+32*T5_); sp_[0]=s0_; sp_[1]=s1_;
    asm volatile("s_waitcnt lgkmcnt(0)\n\ts_barrier":::"memory"); }
  const float cq2=c2l[q0+wid*QBLK+r32];
  float mhat=-cq2,l_reg=0.f;f32x16 o[2];o[0]=f32x16{};o[1]=f32x16{};f32x16 negm;
  const float bnd=(tskip-40.f)*0.505f+0.25f;
  _Pragma("unroll") for(int r=0;r<16;++r)negm[r]=SM?(cq2-bnd):cq2; asm volatile("":"+v"(negm));
  { const f32x16 n0_=BIASM(t0,0),n1_=BIASM(t0,1); qkt(pA0,pA1,Kbase,qr,n0_,n1_,r32,hi); } asm volatile("s_nop 15\n\ts_nop 7":"+v"(pA0),"+v"(pA1));CMASK(pA0,pA1,t0);
  START(pA0,pA1);
  _Pragma("unroll") for(int r=0;r<16;++r)pA1[r]=__builtin_amdgcn_exp2f(pA1[r]);
  WAIT_BAR(0);
  DMA_K(t0+3,0);DMA_V(t0+1,SLOTB);
  ROT();
  kload8(kf,kp0+sl_cur);
  WAIT_BAR(2);
  s16x4 vlo[8],vhi[8]; u32x4 pw0,pw1,pw2,pw3;
  #define PKW(P,B) cvtpk_s(P[B],P[B+1])
  #define PAF(k) __builtin_bit_cast(bf16x8,pw##k)
  #define VFR(i) (bf16x8){vlo[i][0],vlo[i][1],vlo[i][2],vlo[i][3],vhi[i][0],vhi[i][1],vhi[i][2],vhi[i][3]}
  #define PIN(x) asm volatile("":"+v"(x))
  #define MX3(a,b,c) __builtin_fmaxf(__builtin_fmaxf((a),(b)),(c))
  #define GAPA(MF,A0,A1,A2,A3,W0,W1,PW) do{ MF; sacc+=A0; sacc+=A1; sacc+=A2; sacc+=A3; PIN(sacc); W0; W1; PIN(PW); SBAR(); }while(0)
  #define EX(v) __builtin_amdgcn_exp2f(v)
  #define GAPB(MF,X,B) do{ MF; X[B]=EX(X[B]); X[B+1]=EX(X[B+1]); X[B+2]=EX(X[B+2]); X[B+3]=EX(X[B+3]); PIN(X); SBAR(); }while(0)
  #define VRD(i) do{ vlo[i]=vtr(vp_+(((i)>>2)*4096+((i)&3)*1024)); vhi[i]=vtr(vp_+(((i)>>2)*4096+((i)&3)*1024+512)); }while(0)
  #define KRD(G,j) do{ if(G){ kload2(kf,kp0+sl_next,j); SBAR(); } }while(0)
  #define STEP(C0,C1,P0,P1,t,GK,GV,GL) do{ SBAR(); \
    const lds_cptr vp_=vp0+sl_prev; \
    VRD(0); SBAR(); float sacc=(P0[0]+P0[1]); \
    C0=__builtin_amdgcn_mfma_f32_32x32x16_bf16(BIASOP(cbA),bneg,negm,0,0,0); C1=__builtin_amdgcn_mfma_f32_32x32x16_bf16(BIASOP(cbB),bneg,negm,0,0,0); cbA=cbl[((t)+1)*KVBLK]; cbB=cbl[((t)+1)*KVBLK+32]; SBAR(); \
    GAPA(C0=__builtin_amdgcn_mfma_f32_32x32x16_bf16(kf[0],qr[0],C0,0,0,0), P0[2],P0[3],P0[4],P0[5],     pw0[0]=PKW(P0,0), pw0[1]=PKW(P0,2), pw0); \
    VRD(4); SBAR(); GAPA(C1=__builtin_amdgcn_mfma_f32_32x32x16_bf16(kf[1],qr[0],C1,0,0,0), P0[6],P0[7],P0[8],P0[9],     pw0[2]=PKW(P0,4), pw0[3]=PKW(P0,6), pw0); \
    VRD(1); SBAR(); GAPA(C0=__builtin_amdgcn_mfma_f32_32x32x16_bf16(kf[2],qr[1],C0,0,0,0),   P0[10],P0[11],P0[12],P0[13], pw1[0]=PKW(P0,8), pw1[1]=PKW(P0,10), pw1); \
    VRD(5); SBAR(); GAPA(C1=__builtin_amdgcn_mfma_f32_32x32x16_bf16(kf[3],qr[1],C1,0,0,0),   P0[14],P0[15],P1[0],P1[1],   pw1[2]=PKW(P0,12),pw1[3]=PKW(P0,14), pw1); \
    VRD(2); SBAR(); GAPA(C0=__builtin_amdgcn_mfma_f32_32x32x16_bf16(kf[4],qr[2],C0,0,0,0),   P1[2],P1[3],P1[4],P1[5],     pw2[0]=PKW(P1,0), pw2[1]=PKW(P1,2), pw2); \
    VRD(6); SBAR(); GAPA(C1=__builtin_amdgcn_mfma_f32_32x32x16_bf16(kf[5],qr[2],C1,0,0,0),   P1[6],P1[7],P1[8],P1[9],     pw2[2]=PKW(P1,4), pw2[3]=PKW(P1,6), pw2); \
    VRD(3); SBAR(); GAPA(C0=__builtin_amdgcn_mfma_f32_32x32x16_bf16(kf[6],qr[3],C0,0,0,0),   P1[10],P1[11],P1[12],P1[13], pw3[0]=PKW(P1,8), pw3[1]=PKW(P1,10), pw3); \
    VRD(7); SBAR(); GAPA(C1=__builtin_amdgcn_mfma_f32_32x32x16_bf16(kf[7],qr[3],C1,0,0,0),   P1[14],P1[15],0.f,0.f,       pw3[2]=PKW(P1,12),pw3[3]=PKW(P1,14), pw3); \
    l_reg+=sacc; \
    if(GK){DMA_K((t)+3,sl_cur);} if(GV){DMA_V((t)+1,sl_next);} \
    CMASK(C0,C1,t); \
    if constexpr(!SM){ float a=MX3(C0[0],C0[1],C1[0]),b=MX3(C0[2],C0[3],C1[1]); a=MX3(a,C1[2],C1[3]); \
      _Pragma("unroll") for(int r=4;r<16;r+=4){a=MX3(a,C0[r],C0[r+1]);b=MX3(b,C0[r+2],C0[r+3]);a=MX3(a,C1[r],C1[r+1]);b=MX3(b,C1[r+2],C1[r+3]);} \
      float rm=__builtin_fmaxf(a,b); { auto rr=__builtin_amdgcn_permlane32_swap(__float_as_uint(rm),__float_as_uint(rm),false,false); rm=__builtin_fmaxf(__uint_as_float(rr[0]),__uint_as_float(rr[1])); } \
      resc=false; \
      if(__builtin_expect(__any(rm>(float)THRL),0)){ const float dl=__builtin_fmaxf(rm,0.f); mhat+=dl; \
        _Pragma("unroll") for(int r=0;r<16;++r){C0[r]-=dl;C1[r]-=dl;} \
        _Pragma("unroll") for(int r=0;r<16;++r)negm[r]=-mhat; asm volatile("":"+v"(negm)); \
        const float f=__builtin_amdgcn_exp2f(-dl); l_reg*=f; { const int L3_=fresh_lane(); if((L3_>>5)==0)wsf[L3_&31]=f; } resc=true; } } \
    SBAR(); \
    GAPB(o[0]=__builtin_amdgcn_mfma_f32_32x32x16_bf16(PAF(0),VFR(0),o[0],0,0,0), C0,0); \
    GAPB(o[1]=__builtin_amdgcn_mfma_f32_32x32x16_bf16(PAF(0),VFR(4),o[1],0,0,0), C0,4); \
    KRD(GL,0); GAPB(o[0]=__builtin_amdgcn_mfma_f32_32x32x16_bf16(PAF(1),VFR(1),o[0],0,0,0), C0,8); \
    KRD(GL,1); GAPB(o[1]=__builtin_amdgcn_mfma_f32_32x32x16_bf16(PAF(1),VFR(5),o[1],0,0,0), C0,12); \
    KRD(GL,2); GAPB(o[0]=__builtin_amdgcn_mfma_f32_32x32x16_bf16(PAF(2),VFR(2),o[0],0,0,0), C1,0); \
    KRD(GL,3); GAPB(o[1]=__builtin_amdgcn_mfma_f32_32x32x16_bf16(PAF(2),VFR(6),o[1],0,0,0), C1,4); \
    GAPB(o[0]=__builtin_amdgcn_mfma_f32_32x32x16_bf16(PAF(3),VFR(3),o[0],0,0,0), C1,8); \
    GAPB(o[1]=__builtin_amdgcn_mfma_f32_32x32x16_bf16(PAF(3),VFR(7),o[1],0,0,0), C1,12); \
    }while(0)
  u32x2_t cbA=cbl[(t0+1)*KVBLK],cbB=cbl[(t0+1)*KVBLK+32];
  int t=t0+1;
  #undef CMASK
  #define CMASK(P0,P1,t) do{}while(0)
  for(;t+5<NT;t+=2){
    STEP(pB0,pB1,pA0,pA1,t,true,true,true);     WAIT_BAR(2); RESC(); ROT();
    STEP(pA0,pA1,pB0,pB1,t+1,true,true,true);   WAIT_BAR(2); RESC(); ROT();
  }
  #undef CMASK
  #define CMASK(P0,P1,t) do{int jb_=(t)-(NT-4); if(jb_>=0){ const int L2_=fresh_lane(); cmask(P0,P1,jb_,wid*QBLK+(L2_&31),L2_>>5);} }while(0)
  #define ENDW(tt) do{ if((tt)+3<NT){WAIT_BAR(2);} else if((tt)+2<NT){WAIT_BAR(1);} else {WAIT_BAR(0);} }while(0)
  for(;t+1<NT;t+=2){
    STEP(pB0,pB1,pA0,pA1,t,(t+3<NT),(t+1<NT),(t+1<NT));       ENDW(t);   RESC(); ROT();
    STEP(pA0,pA1,pB0,pB1,t+1,(t+4<NT),(t+2<NT),(t+2<NT));     ENDW(t+1); RESC(); ROT();
  }
  if(nb>=0){ const int L5_=fresh_lane();
    const bf16*ksn=K+((long)nb*SEQ+L5_)*DM+nh*D+wid*8; const bf16*vsn=V+((long)nb*SEQ+16*(wid&3)+(L5_>>2))*DM+nh*D+(wid>>2)*32+(L5_&3)*8;
    const unsigned l0n=(unsigned)(uintptr_t)(shm+(RING_SET-rb)), kdn=l0n+LDS_K+wid*1024, vdn=l0n+LDS_V+wid*1024;
    glds16(ksn,(unsigned)__builtin_amdgcn_readfirstlane(kdn)); glds16(vsn,(unsigned)__builtin_amdgcn_readfirstlane(vdn));
    glds16(ksn+(long)KVBLK*DM,(unsigned)__builtin_amdgcn_readfirstlane(kdn+SLOTB)); glds16(ksn+2L*KVBLK*DM,(unsigned)__builtin_amdgcn_readfirstlane(kdn+2*SLOTB));
    glds16(cumn+4*(wid*64+L5_),(unsigned)__builtin_amdgcn_readfirstlane(c2n_lds+wid*1024));
    const bf16*qsn=Q+((long)nb*SEQ+nqb*QB+wid*QBLK+(L5_>>3))*DM+nh*D+(L5_&7)*8; const unsigned qdn=(unsigned)(uintptr_t)(shm+qst_off);
    #pragma unroll
    for(int j=0;j<4;++j)glds16(qsn+(long)(8*j)*DM,(unsigned)__builtin_amdgcn_readfirstlane(qdn+j*1024)); }
  STEP(pB0,pB1,pA0,pA1,NT-1,false,false,false); RESC();
  { float sacc=pB0[0]+pB0[1]; _Pragma("unroll") for(int r=2;r<16;++r)sacc+=pB0[r]; _Pragma("unroll") for(int r=0;r<16;++r)sacc+=pB1[r]; l_reg+=sacc;
    pw0=(u32x4){PKW(pB0,0),PKW(pB0,2),PKW(pB0,4),PKW(pB0,6)};pw1=(u32x4){PKW(pB0,8),PKW(pB0,10),PKW(pB0,12),PKW(pB0,14)};pw2=(u32x4){PKW(pB1,0),PKW(pB1,2),PKW(pB1,4),PKW(pB1,6)};pw3=(u32x4){PKW(pB1,8),PKW(pB1,10),PKW(pB1,12),PKW(pB1,14)};
    SBAR(); { const int L4_=fresh_lane(); const int vb1_=(int)(lds0+LDS_V)+((L4_>>4)&1)*32+(L4_&3)*8+(4*(L4_>>5)+((L4_&15)>>2))*64; pv(o,vb1_+sl_cur,PAF(0),PAF(1),PAF(2),PAF(3)); } }
  #undef PKW
  #undef PAF
  #undef VFR
  #undef PIN
  #undef MX3
  #undef GAPA
  #undef GAPB
  #undef EX
  #undef VRD
  #undef KRD
  #undef STEP
  #undef ENDW
  int eL; asm volatile("v_mbcnt_lo_u32_b32 %0, -1, 0\n\tv_mbcnt_hi_u32_b32 %0, -1, %0" : "=v"(eL)); const int eR=eL&31,eH=eL>>5;
  const bf16*Gw=Gt+(rowbase+q0+wid*QBLK)*DM+h*D; u32x4 ggv[4];
  #pragma unroll
  for(int i=0;i<4;++i)ggv[i]=*(const u32x4*)(Gw+(long)(i*8+(eL>>3))*DM+(eL&7)*8);
  {auto rr=__builtin_amdgcn_permlane32_swap(__float_as_uint(l_reg),__float_as_uint(l_reg),false,false);l_reg=__uint_as_float(rr[0])+__uint_as_float(rr[1]);}
  if(eH==0)wsf[32+eR]=l_reg;asm volatile("s_waitcnt lgkmcnt(0)":::"memory");
  float rli[16];
  #pragma unroll
  for(int r=0;r<16;++r)rli[r]=__builtin_amdgcn_rcpf(wsf[32+crow(r,eH)]);
  bf16*Ow=O+(rowbase+q0+wid*QBLK)*PO+h*D;
  asm volatile("s_waitcnt lgkmcnt(0)\n\ts_barrier":::"memory");
  { bf16*stg=(bf16*)(shmr)+wid*2048;
    #pragma unroll
    for(int r=0;r<16;++r){const int orow=crow(r,eH);
      #pragma unroll
      for(int d0=0;d0<2;++d0)stg[orow*64+d0*32+eR]=__float2bfloat16(o[d0][r]*rli[r]);}
    asm volatile("s_waitcnt lgkmcnt(0)":::"memory");
    #pragma unroll
    for(int i=0;i<4;++i){const int row=i*8+(eL>>3),ch=eL&7; const u32x4 v=*(const u32x4*)(stg+row*64+ch*8); const u32x4 gg=ggv[i]; u32x4 w;
      #pragma unroll
      for(int e=0;e<4;++e){ const float o0=__uint_as_float(v[e]<<16),o1=__uint_as_float(v[e]&0xffff0000u),g0=__uint_as_float(gg[e]<<16),g1=__uint_as_float(gg[e]&0xffff0000u);
        const float s0=g0*__builtin_amdgcn_rcpf(1.f+__builtin_amdgcn_exp2f(-1.4426950408889634f*g0)),s1=g1*__builtin_amdgcn_rcpf(1.f+__builtin_amdgcn_exp2f(-1.4426950408889634f*g1)); w[e]=cvtpk_s(o0*s0,o1*s1);}
      ATTN_STORE16(Ow+(long)row*PO+ch*8,w);} }
  asm volatile("s_waitcnt lgkmcnt(0)\n\ts_barrier":::"memory");
  #undef DMA_K
  #undef DMA_V
  #undef CMASK
  #undef START
  #undef RESC
  #undef ROT
  #undef BIASM
  #undef BIASOP
}
constexpr int ATTN_LDS_BYTES=LDS_BYTES;
struct AttnTensors { const bf16* PR; bf16* O; const float* cum; const float* tsk; };
struct AttnUnit { int bh; int qb; };
constexpr int C2_OFF=2048, SCAN_OFF=0;
constexpr int ATTN_LDS_TOTAL=LDS_BYTES;
__device__ __forceinline__ void build_c2(const float*logf,int b,int h,char*shm,int wid){
  int lane_; asm volatile("v_mbcnt_lo_u32_b32 %0, -1, 0\n\tv_mbcnt_hi_u32_b32 %0, -1, %0" : "=v"(lane_)); const int lane=lane_,tid=wid*64+lane;
  float*tot=(float*)(shm+SCAN_OFF); float*c2=(float*)(shm+C2_OFF);
  float l4[4]; { float run=0.f;
    #pragma unroll
    for(int i=0;i<4;++i){ run+=logf[((long)b*SEQ+4*tid+i)*16+h]; l4[i]=run; } tot[tid]=run; }
  __syncthreads();
  if(wid==0){ float run=0.f; float e[8];
    #pragma unroll
    for(int i=0;i<8;++i){ e[i]=run; run+=tot[8*lane+i]; }
    float inc=run;
    #pragma unroll
    for(int o=1;o<64;o<<=1){ const float y=__builtin_bit_cast(float,__builtin_amdgcn_ds_bpermute((lane-o)<<2,__builtin_bit_cast(int,inc))); if(lane>=o)inc+=y; }
    const float excl=inc-run;
    #pragma unroll
    for(int i=0;i<8;++i)tot[8*lane+i]=excl+e[i]; }
  __syncthreads();
  { const float off=tot[tid];
    #pragma unroll
    for(int i=0;i<4;++i)c2[4*tid+i]=(off+l4[i])*1.4426950408889634f; }
  __syncthreads();
}
__device__ __forceinline__ void c2_phase(const float*logf,const float*qg,const float*kg,float*cum,float*tsk,char*lds,int G,int c,int wid){
  int lane_; asm volatile("v_mbcnt_lo_u32_b32 %0, -1, 0\n\tv_mbcnt_hi_u32_b32 %0, -1, %0" : "=v"(lane_)); const int tid=wid*64+lane_;
  for(int bh=c;bh<BATCH*NHEAD;bh+=G){ build_c2(logf,bh/NHEAD,bh%NHEAD,lds,wid);
    *(f32x4a*)(cum+(long)bh*SEQ+4*tid)=*(const f32x4a*)((const float*)(lds+C2_OFF)+4*tid); __syncthreads(); }
  if(wid==0){ float a=fabsf(qg[lane_]),k=fabsf(kg[lane_]);
    #pragma unroll
    for(int o=1;o<64;o<<=1){ a=fmaxf(a,__builtin_bit_cast(float,__builtin_amdgcn_ds_bpermute((lane_^o)<<2,__builtin_bit_cast(int,a)))); k=fmaxf(k,__builtin_bit_cast(float,__builtin_amdgcn_ds_bpermute((lane_^o)<<2,__builtin_bit_cast(int,k)))); }
    if(lane_==0)*tsk=40.f+2.f*64.f*a*k*C2; }
}
__device__ __forceinline__ void load_c2(const float*cum,int bh,char*lds,int wid,int dst_off){
  int lane_; asm volatile("v_mbcnt_lo_u32_b32 %0, -1, 0\n\tv_mbcnt_hi_u32_b32 %0, -1, %0" : "=v"(lane_)); const int tid=wid*64+lane_;
  *(f32x4a*)((float*)(lds+dst_off)+4*tid)=*(const f32x4a*)(cum+(long)bh*SEQ+4*tid); __syncthreads();
}
template<int THRL,bool SM> __device__ __forceinline__ void attn_phase_t(char*lds,const AttnTensors&T,int G,int c,int wid,const float tskip){
  if(G==256){ const int x=c&7,li=c>>3,g4=li>>3,u=li&7,gid=8*g4+x;
    for(int r=0;r<8;++r){ const int b=8*(gid>>4)+r,h=(gid+r)&15,qb=(u+r)&7; const int par=r&1;
      if(r==0)load_c2(T.cum,b*NHEAD+h,lds,wid,SEAM_C2F);
      const int nb=(r<7)?8*(gid>>4)+r+1:-1,nh=(gid+r+1)&15;
      attn_unit<THRL,SM>(b,h,qb,T.PR,T.O,lds,(lds_fptr)(lds+SEAM_C2F),wid,tskip,par*RING_SET,r>0,nb,nh,(u+r+1)&7,T.cum+(long)((nb<0?0:nb)*NHEAD+nh)*SEQ,(unsigned)(uintptr_t)(lds+SEAM_C2F)); }
    return; }
  for(int it=c;it<BATCH*NHEAD*NQB;it+=G){ const int bh=it%(BATCH*NHEAD),qb=it/(BATCH*NHEAD);
    load_c2(T.cum,bh,lds,wid,SEAM_C2F);
    attn_unit<THRL,SM>(bh/NHEAD,bh%NHEAD,qb,T.PR,T.O,lds,(lds_fptr)(lds+SEAM_C2F),wid,tskip,0,false,-1,0,0,T.cum,0u); }
}
template<int THRL=8> __device__ __forceinline__ void attn_phase(char*lds,const AttnTensors&T,int G,int c,int wid){
  const float tskip=*T.tsk;
  if((tskip-40.f)*0.5f<=ATTN_SM_MAX) attn_phase_t<THRL,true>(lds,T,G,c,wid,tskip); else attn_phase_t<THRL,false>(lds,T,G,c,wid,tskip);
}
#undef SBAR
#undef WAIT_BAR
}
namespace gla {
typedef unsigned short bf16;
typedef short bf16x8 __attribute__((ext_vector_type(8)));
typedef float f32x4 __attribute__((ext_vector_type(4)));
typedef unsigned u32x2 __attribute__((ext_vector_type(2)));
typedef unsigned u32x4 __attribute__((ext_vector_type(4)));
#define GLA_LAS __attribute__((address_space(3)))
constexpr int SEQ_ = 2048, PITCH = 3328;
struct Bufs { const bf16* PROJ; const float* AUX; bf16* QIF; bf16* KDF; bf16* AF; unsigned long long* GRAN; float* DCH; bf16* OG; unsigned tag; const float* wa2; const float* ba; const float* ogain; };
__device__ __forceinline__ int lane_v() { int l; asm volatile("v_mbcnt_lo_u32_b32 %0, -1, 0\n\tv_mbcnt_hi_u32_b32 %0, -1, %0" : "=v"(l)); return l; }
__device__ __forceinline__ float b2f(bf16 b) { return __uint_as_float((unsigned)b << 16); }
typedef float f32x2g __attribute__((ext_vector_type(2))); typedef __bf16 bf16x2g __attribute__((ext_vector_type(2)));
__device__ __forceinline__ unsigned pk(float lo, float hi) { f32x2g v = {lo, hi}; bf16x2g b = __builtin_convertvector(v, bf16x2g); return __builtin_bit_cast(unsigned, b); }
__device__ __forceinline__ float logsig(float z) { return fminf(z, 0.f) - 0.6931471805599453f * __builtin_amdgcn_logf(1.f + __builtin_amdgcn_exp2f(-1.4426950408889634f * fabsf(z))); }
__device__ __forceinline__ float exp_f(float x) { return __builtin_amdgcn_exp2f(1.4426950408889634f * x); }
#define GLA_ROR(x, n) __builtin_bit_cast(float, __builtin_amdgcn_update_dpp(0, __builtin_bit_cast(int, x), 0x120 + (n), 0xf, 0xf, true))
__device__ __forceinline__ float row16_sum(float x) { x += GLA_ROR(x, 8); x += GLA_ROR(x, 4); x += GLA_ROR(x, 2); x += GLA_ROR(x, 1); return x; }
__device__ __forceinline__ float silu_f(float x) { return x * __builtin_amdgcn_rcpf(1.f + __builtin_amdgcn_exp2f(-1.4426950408889634f * x)); }

__device__ __forceinline__ void pre_phase(const Bufs& B, GLA_LAS unsigned char* lds, const int wave) {
    const int lane = lane_v(), tid = wave * 64 + lane, d = tid & 127, tq = wave >> 1, g = lane >> 4, fr = lane & 15;
    GLA_LAS bf16* qs = (GLA_LAS bf16*)lds;
    GLA_LAS bf16* ks = qs + 8192;
    GLA_LAS float* tot = (GLA_LAS float*)(lds + 32768);
    GLA_LAS float* als = (GLA_LAS float*)(lds + 34816);
    f32x4 als_n = {0.f, 0.f, 0.f, 0.f}; bf16 qn[16], kn[16];
#define GLA_PRELOAD(it_) do { const int bh_ = (it_) & 63, n_ = (it_) >> 6, b_ = bh_ >> 2, h_ = bh_ & 3; const size_t r0_ = (size_t)b_ * SEQ_ + n_ * 64; \
        if (tid < 256) als_n = *(const f32x4*)(B.AUX + r0_ * 16 + 4 * tid); \
        _Pragma("unroll") for (int tt_ = 0; tt_ < 16; ++tt_) { const size_t row_ = r0_ + tq * 16 + tt_; qn[tt_] = B.PROJ[row_ * PITCH + h_ * 128 + d]; kn[tt_] = B.PROJ[row_ * PITCH + 512 + h_ * 128 + d]; } } while (0)
    if ((int)blockIdx.x < 2048) GLA_PRELOAD((int)blockIdx.x);
    for (int it = blockIdx.x; it < 2048; it += gridDim.x) {
        const int bh = it & 63, n = it >> 6, b = bh >> 2, h = bh & 3; const size_t cid = (size_t)bh * 32 + n;
        float w2[16];
#pragma unroll
        for (int r = 0; r < 16; ++r) w2[r] = B.wa2[(size_t)r * 512 + h * 128 + d];
        const float bav = B.ba[h * 128 + d];
        if (tid < 256) *(GLA_LAS f32x4*)(als + 4 * tid) = als_n;
        bf16 qc[16], kc[16];
#pragma unroll
        for (int tt = 0; tt < 16; ++tt) { qc[tt] = qn[tt]; kc[tt] = kn[tt]; }
        asm volatile("s_waitcnt lgkmcnt(0)\n\ts_barrier" ::: "memory");
        if (it + (int)gridDim.x < 2048) GLA_PRELOAD(it + (int)gridDim.x);
        float la[16]; float run = 0.f;
#pragma unroll
        for (int tt = 0; tt < 16; ++tt) { const GLA_LAS f32x4* ar = (const GLA_LAS f32x4*)(als + (tq * 16 + tt) * 16); float z = bav;
#pragma unroll
            for (int r4 = 0; r4 < 4; ++r4) { const f32x4 a4 = ar[r4]; z += a4[0] * w2[4 * r4] + a4[1] * w2[4 * r4 + 1] + a4[2] * w2[4 * r4 + 2] + a4[3] * w2[4 * r4 + 3]; }
            run += logsig(z) * 0.0625f; la[tt] = run; }
        tot[tq * 128 + d] = run;
        asm volatile("s_waitcnt lgkmcnt(0)\n\ts_barrier" ::: "memory");
        float off = 0.f, total = 0.f;
#pragma unroll
        for (int q4 = 0; q4 < 4; ++q4) { const float v = tot[q4 * 128 + d]; if (q4 < tq) off += v; total += v; }
        const float dch = exp_f(total);
        unsigned kd[8];
#pragma unroll
        for (int tt = 0; tt < 16; tt += 2) { float kdv[2];
#pragma unroll
            for (int u = 0; u < 2; ++u) { const int t = tq * 16 + tt + u; const float cum = off + la[tt + u];
                const float e1 = exp_f(cum), e2 = exp_f(-cum);
                const float qv = b2f(qc[tt + u]), kv = b2f(kc[tt + u]);
                const float ki = kv * e2; kdv[u] = ki * dch;
                const int a = t * 128 + (((d >> 3) ^ (t & 15)) * 8) + (d & 7);
                qs[a] = (bf16)(pk(qv * e1, 0.f) & 0xffffu); ks[a] = (bf16)(pk(ki, 0.f) & 0xffffu); }
            kd[tt >> 1] = pk(kdv[0], kdv[1]); }
        { const int ksb = tq >> 1, g0 = 2 * (tq & 1); bf16* base = B.KDF + cid * 8192 + (size_t)((d >> 4) * 2 + ksb) * 512;
          *(u32x4*)(base + ((d & 15) + 16 * g0) * 8) = (u32x4){kd[0], kd[1], kd[2], kd[3]};
          *(u32x4*)(base + ((d & 15) + 16 * (g0 + 1)) * 8) = (u32x4){kd[4], kd[5], kd[6], kd[7]}; }
        if (tq == 0) B.DCH[cid * 128 + d] = dch;
        asm volatile("s_waitcnt lgkmcnt(0)\n\ts_barrier" ::: "memory");
#pragma unroll
        for (int u = 0; u < 2; ++u) { const int tile = 2 * wave + u, a = tile >> 2, b2 = tile & 3; f32x4 acc = {0.f, 0.f, 0.f, 0.f};
            const int ra = 16 * a + fr, rb = 16 * b2 + fr;
#pragma unroll
            for (int k2 = 0; k2 < 4; ++k2) { const int c = 4 * k2 + g;
                const bf16x8 af = *(const GLA_LAS bf16x8*)(ks + ra * 128 + ((c ^ (ra & 15)) * 8));
                const bf16x8 bf_ = *(const GLA_LAS bf16x8*)(qs + rb * 128 + ((c ^ (rb & 15)) * 8));
                acc = __builtin_amdgcn_mfma_f32_16x16x32_bf16(af, bf_, acc, 0, 0, 0); }
            const int t = 16 * b2 + fr; float m[4];
#pragma unroll
            for (int r = 0; r < 4; ++r) { const int tp = 16 * a + 4 * g + r; m[r] = (tp <= t) ? acc[r] : 0.f; }
            const int lp = fr + 16 * (2 * (a & 1) + (g >> 1));
            *(u32x2*)(B.AF + cid * 4096 + (size_t)(b2 * 2 + (a >> 1)) * 512 + lp * 8 + 4 * (g & 1)) = (u32x2){pk(m[0], m[1]), pk(m[2], m[3])}; }
#pragma unroll
        for (int u = 0; u < 2; ++u) { const int e = tid + 512 * u, bq = e >> 6, l = e & 63, i = bq >> 2, k2 = bq & 3, t = 16 * i + (l & 15), gg = l >> 4;
            const int d0 = 32 * k2 + 4 * gg, c0 = d0 >> 3, sub = d0 & 7;
            const u32x2 p0 = *(const GLA_LAS u32x2*)(qs + t * 128 + ((c0 ^ (t & 15)) * 8) + sub);
            const u32x2 p1 = *(const GLA_LAS u32x2*)(qs + t * 128 + (((c0 + 2) ^ (t & 15)) * 8) + sub);
            *(u32x4*)(B.QIF + cid * 8192 + (size_t)bq * 512 + l * 8) = (u32x4){p0.x, p0.y, p1.x, p1.y}; }
        asm volatile("s_waitcnt lgkmcnt(0)\n\ts_barrier" ::: "memory");
    }
#undef GLA_PRELOAD
}

typedef short s16x4 __attribute__((ext_vector_type(4)));
__device__ __forceinline__ s16x4 vtr(const GLA_LAS unsigned char* p) { return __builtin_bit_cast(s16x4, __builtin_amdgcn_ds_read_tr16_b64_v4i16((GLA_LAS s16x4*)p)); }
__device__ __forceinline__ void glds16(const void* gsrc, unsigned lds_dst) { unsigned keep;
    asm volatile("s_mov_b32 %0, m0\n\ts_mov_b32 m0, %2\n\ts_nop 0\n\tglobal_load_lds_dwordx4 %1, off\n\ts_mov_b32 m0, %0" : "=&s"(keep) : "v"(gsrc), "s"(lds_dst) : "memory"); }
constexpr int CORE_BUF = 50176, OBUF_OFF = 2 * CORE_BUF, OBUF1_OFF = 139776, OST = 68;
#define GLA_QP(x, ctl) __builtin_bit_cast(float, __builtin_amdgcn_update_dpp(0, __builtin_bit_cast(int, x), ctl, 0xf, 0xf, true))
__device__ __forceinline__ void core_phase(const Bufs& B, GLA_LAS unsigned char* lds, const int wave) {
    const int lane = lane_v(), tid = wave * 64 + lane, j = lane & 15, g = lane >> 4, jt = wave & 3, th = wave >> 2;
    const int er = tid >> 3, ec = tid & 7;
    const unsigned lds0 = (unsigned)(size_t)lds;
    GLA_LAS float* obuf0 = (GLA_LAS float*)(lds + OBUF_OFF); GLA_LAS float* obuf1 = (GLA_LAS float*)(lds + OBUF1_OFF);
    for (int it = blockIdx.x; it < 256; it += gridDim.x) {
        const int s = (it >> 3) & 3, bh = (it & 7) + 8 * (it >> 5), b = bh >> 2, h = bh & 3;
        const int ecol = h * 256 + s * 64 + 8 * ec;
        f32x4 gn0 = *(const f32x4*)(B.ogain + s * 64 + 8 * ec), gn1 = *(const f32x4*)(B.ogain + s * 64 + 8 * ec + 4);
        f32x4 S[8];
#pragma unroll
        for (int dt = 0; dt < 8; ++dt) S[dt] = (f32x4){0.f, 0.f, 0.f, 0.f};
#define GLA_STAGE(c) do { const size_t cid_ = (size_t)bh * 32 + (c); const unsigned dst_ = lds0 + ((c) & 1) * CORE_BUF + wave * 1024; \
            glds16(B.KDF + cid_ * 8192 + (size_t)wave * 512 + lane * 8,        (unsigned)__builtin_amdgcn_readfirstlane(dst_)); \
            glds16(B.KDF + cid_ * 8192 + (size_t)(wave + 8) * 512 + lane * 8,  (unsigned)__builtin_amdgcn_readfirstlane(dst_ + 8192)); \
            glds16(B.QIF + cid_ * 8192 + (size_t)wave * 512 + lane * 8,        (unsigned)__builtin_amdgcn_readfirstlane(dst_ + 16384)); \
            glds16(B.QIF + cid_ * 8192 + (size_t)(wave + 8) * 512 + lane * 8,  (unsigned)__builtin_amdgcn_readfirstlane(dst_ + 24576)); \
            glds16(B.AF + cid_ * 4096 + (size_t)wave * 512 + lane * 8,         (unsigned)__builtin_amdgcn_readfirstlane(dst_ + 32768)); \
            glds16(B.PROJ + ((size_t)b * SEQ_ + (c) * 64 + 8 * wave + (lane >> 3)) * PITCH + 1024 + h * 256 + s * 64 + 8 * (lane & 7), (unsigned)__builtin_amdgcn_readfirstlane(dst_ + 40960)); \
            if (wave == 7) glds16((const unsigned char*)(B.DCH + cid_ * 128) + lane * 16, (unsigned)__builtin_amdgcn_readfirstlane(lds0 + ((c) & 1) * CORE_BUF + 49152)); } while (0)
#define GLA_REGLOAD(c, GR) do { const size_t rowb_ = (size_t)b * SEQ_ + (c) * 64; \
            GR = *(const u32x4*)(B.PROJ + (rowb_ + er) * PITCH + 2048 + ecol); } while (0)
#define GLA_EPI_A(c, GV, VAL, QOWN) do { const GLA_LAS float* ob_ = ((c) & 1) ? obuf1 : obuf0; const f32x4 o0_ = *(const GLA_LAS f32x4*)(ob_ + er * OST + 8 * ec), o1_ = *(const GLA_LAS f32x4*)(ob_ + er * OST + 8 * ec + 4); float q_ = 0.f; \
            _Pragma("unroll") for (int e_ = 0; e_ < 4; ++e_) { const float ga_ = __uint_as_float(GV[e_] << 16), gb_ = __uint_as_float(GV[e_] & 0xffff0000u); \
                const float oa_ = (e_ < 2) ? o0_[2 * e_] : o1_[2 * e_ - 4], ob_ = (e_ < 2) ? o0_[2 * e_ + 1] : o1_[2 * e_ - 3]; \
                const float na_ = (e_ < 2) ? gn0[2 * e_] : gn1[2 * e_ - 4], nb_ = (e_ < 2) ? gn0[2 * e_ + 1] : gn1[2 * e_ - 3]; \
                q_ += oa_ * oa_ + ob_ * ob_; VAL[2 * e_] = oa_ * na_ * silu_f(ga_); VAL[2 * e_ + 1] = ob_ * nb_ * silu_f(gb_); } \
            q_ += GLA_QP(q_, 0xB1); q_ += GLA_QP(q_, 0x4E); q_ += GLA_QP(q_, 0x141);     \
            QOWN = q_; \
            if (ec == 0) __hip_atomic_store(B.GRAN + (((size_t)bh * 32 + (c)) * 4 + s) * 64 + er, ((unsigned long long)B.tag << 32) | (unsigned long long)__float_as_uint(q_), __ATOMIC_RELAXED, __HIP_MEMORY_SCOPE_AGENT); } while (0)
#define GLA_GLOAD(c, XG) do { unsigned long long* gp_ = B.GRAN + ((size_t)bh * 32 + (c)) * 256 + er; \
            _Pragma("unroll") for (int p_ = 0; p_ < 3; ++p_) XG[p_] = __hip_atomic_load(gp_ + ((s + 1 + p_) & 3) * 64, __ATOMIC_RELAXED, __HIP_MEMORY_SCOPE_AGENT); } while (0)
#define GLA_EPI_B(c, VAL, QOWN, XG) do { const size_t row_ = (size_t)b * SEQ_ + (c) * 64 + er; unsigned sp_ = 0; \
            while (!__all(((unsigned)(XG[0] >> 32) == B.tag) & ((unsigned)(XG[1] >> 32) == B.tag) & ((unsigned)(XG[2] >> 32) == B.tag)) && ++sp_ < (1u << 22)) { __builtin_amdgcn_s_sleep(1); GLA_GLOAD(c, XG); } \
            const float tot_ = QOWN + __uint_as_float((unsigned)XG[0]) + __uint_as_float((unsigned)XG[1]) + __uint_as_float((unsigned)XG[2]); \
            const float rstd_ = rsqrtf(tot_ * (1.f / 256.f) + 1e-6f); u32x4 w_; \
            _Pragma("unroll") for (int e_ = 0; e_ < 4; ++e_) w_[e_] = pk(VAL[2 * e_] * rstd_, VAL[2 * e_ + 1] * rstd_); \
            *(u32x4*)(B.OG + row_ * 1024 + ecol) = w_; } while (0)
        u32x4 gr;
        asm volatile("s_waitcnt lgkmcnt(0)\n\ts_barrier" ::: "memory");
        GLA_STAGE(0); GLA_REGLOAD(0, gr);
        u32x4 gprev = gr; float valp[8], qp = 0.f;
        for (int n = 0; n < 32; ++n) {
            asm volatile("s_waitcnt vmcnt(1) lgkmcnt(0)\n\ts_barrier" ::: "memory");
            const u32x4 gcur = gr;
            if (n + 1 < 32) { GLA_STAGE(n + 1); GLA_REGLOAD(n + 1, gr); }
            unsigned long long xg[3] = {0ull, 0ull, 0ull}; if (n > 1) GLA_GLOAD(n - 2, xg);
            float valn[8], qn = 0.f;
            if (n > 0) GLA_EPI_A(n - 1, gprev, valn, qn);
            gprev = gcur;
            const GLA_LAS unsigned char* buf = lds + (n & 1) * CORE_BUF + lane * 16;
            const GLA_LAS unsigned char* vb = lds + (n & 1) * CORE_BUF + 40960 + (8 * g + ((lane & 15) >> 2)) * 128 + (16 * jt + 4 * (lane & 3)) * 2;
            const s16x4 t00 = vtr(vb), t01 = vtr(vb + 512), t10 = vtr(vb + 4096), t11 = vtr(vb + 4096 + 512);
            const bf16x8 vf0 = (bf16x8){t00[0], t00[1], t00[2], t00[3], t01[0], t01[1], t01[2], t01[3]}, vf1 = (bf16x8){t10[0], t10[1], t10[2], t10[3], t11[0], t11[1], t11[2], t11[3]};
            u32x4 sb[4];
#pragma unroll
            for (int k2 = 0; k2 < 4; ++k2) sb[k2] = (u32x4){pk(S[2 * k2][0], S[2 * k2][1]), pk(S[2 * k2][2], S[2 * k2][3]), pk(S[2 * k2 + 1][0], S[2 * k2 + 1][1]), pk(S[2 * k2 + 1][2], S[2 * k2 + 1][3])};
#pragma unroll
            for (int dt = 0; dt < 8; ++dt) { S[dt] = S[dt] * *(const GLA_LAS f32x4*)(lds + (n & 1) * CORE_BUF + 49152 + (16 * dt + 4 * g) * 4);
                { const bf16x8 kd = *(const GLA_LAS bf16x8*)(buf + (dt * 2) * 1024); S[dt] = __builtin_amdgcn_mfma_f32_16x16x32_bf16(kd, vf0, S[dt], 0, 0, 0); }
                { const bf16x8 kd = *(const GLA_LAS bf16x8*)(buf + (dt * 2 + 1) * 1024); S[dt] = __builtin_amdgcn_mfma_f32_16x16x32_bf16(kd, vf1, S[dt], 0, 0, 0); } }
            f32x4 ov[2];
#pragma unroll
            for (int i = 0; i < 2; ++i) { const int ti = 2 * th + i; f32x4 o = {0.f, 0.f, 0.f, 0.f};
#pragma unroll
                for (int k2 = 0; k2 < 4; ++k2) { const bf16x8 qf = *(const GLA_LAS bf16x8*)(buf + 16384 + (ti * 4 + k2) * 1024); o = __builtin_amdgcn_mfma_f32_16x16x32_bf16(qf, __builtin_bit_cast(bf16x8, sb[k2]), o, 0, 0, 0); }
                { const bf16x8 a0 = *(const GLA_LAS bf16x8*)(buf + 32768 + (ti * 2) * 1024); o = __builtin_amdgcn_mfma_f32_16x16x32_bf16(a0, vf0, o, 0, 0, 0); }
                if (th == 1) { const bf16x8 a1 = *(const GLA_LAS bf16x8*)(buf + 32768 + (ti * 2 + 1) * 1024); o = __builtin_amdgcn_mfma_f32_16x16x32_bf16(a1, vf1, o, 0, 0, 0); }
                ov[i] = o; }
            { GLA_LAS float* obw = (n & 1) ? obuf1 : obuf0;
#pragma unroll
              for (int i = 0; i < 2; ++i)
#pragma unroll
                for (int r = 0; r < 4; ++r) obw[(16 * (2 * th + i) + 4 * g + r) * OST + 16 * jt + j] = ov[i][r]; }
            if (n > 1) GLA_EPI_B(n - 2, valp, qp, xg);
#pragma unroll
            for (int e = 0; e < 8; ++e) valp[e] = valn[e];
            qp = qn;
        }
        asm volatile("s_waitcnt vmcnt(0) lgkmcnt(0)\n\ts_barrier" ::: "memory");
        { float valn[8], qn = 0.f; unsigned long long xg[3]; GLA_EPI_A(31, gprev, valn, qn); GLA_GLOAD(30, xg); GLA_EPI_B(30, valp, qp, xg); GLA_GLOAD(31, xg); GLA_EPI_B(31, valn, qn, xg); }
#undef GLA_STAGE
#undef GLA_REGLOAD
#undef GLA_EPI_A
#undef GLA_EPI_B
#undef GLA_GLOAD
    }
    asm volatile("s_waitcnt vmcnt(0) lgkmcnt(0)\n\ts_barrier" ::: "memory");
}

#undef GLA_LAS
}
__device__ __forceinline__ int lane_id_v() { int l; asm volatile("v_mbcnt_lo_u32_b32 %0, -1, 0\n\tv_mbcnt_hi_u32_b32 %0, -1, %0" : "=v"(l)); return l; }
__device__ __forceinline__ float wave_sum(float v) {
#pragma unroll
    for (int o = 1; o < 64; o <<= 1) v += __shfl_xor(v, o);
    return v;
}
__device__ __forceinline__ void p0_item(const float* W, int K, int N, bf16* WT, int k0, int n0, int drow0, const float* rs, float cs, LAS float* scr, int lane) {
    const int n = n0 + (lane & 31);
    float wv[32];
#pragma unroll
    for (int i = 0; i < 32; ++i) { const int kk = 2 * i + (lane >> 5); wv[i] = (n < N) ? W[(size_t)(k0 + kk) * N + n] : 0.f; }
    float rv = 1.f; if (rs) rv = rs[k0 + (lane & 63)];
#pragma unroll
    for (int i = 0; i < 32; ++i) { const int kk = 2 * i + (lane >> 5); const float r = __shfl(rv, kk); scr[kk * 33 + (lane & 31)] = wv[i] * cs * r; }
    LDS_WAIT(); asm volatile("" ::: "memory");
    const int c = lane & 7;
#pragma unroll
    for (int j = 0; j < 4; ++j) { const int nn = (lane >> 3) + 8 * j; const LAS float* s = scr + (8 * c) * 33 + nn;
        v4u o; o.x = pk2(s[0 * 33], s[1 * 33]); o.y = pk2(s[2 * 33], s[3 * 33]); o.z = pk2(s[4 * 33], s[5 * 33]); o.w = pk2(s[6 * 33], s[7 * 33]);
        *(GAS v4u*)(WT + (size_t)(drow0 + nn) * K + k0 + 8 * c) = o; }
    LDS_WAIT(); asm volatile("" ::: "memory");
}
__device__ __forceinline__ int perm_row(int n0, int limit) {
    if (n0 >= limit) return n0;
    const int tile = n0 >> 8, w = n0 & 255, wc = w >> 6, bj = (w & 63) >> 5;
    return tile * 256 + 128 * bj + 32 * wc;
}
struct P0Ptrs { const float *x, *norm_mixer, *gla_w_in, *gla_w_out, *fox_w_in, *fox_w_out, *ple_proj, *ple_gate, *ple_norm; bf16 *WGIN, *WFIN, *WOUT, *WGATE, *WPROJ, *HB; float* SSQA; unsigned char* GRAN; };
__device__ __forceinline__ void p0_prologue(const P0Ptrs& P, LAS unsigned char* lds, int wave) {
    const int lane = lane_id_v(), gw = blockIdx.x * NWAVES + wave, NGW = gridDim.x * NWAVES;
    LAS float* scr = (LAS float*)(lds + RING_OFF + wave * 16384);
    constexpr int I_GIN = 16 * (GLA_NP / 32), I_FIN = 16 * (FOX_NP / 32), I_SQ = 16 * 32, I_PR = 4 * 32;
    constexpr int NITEMS = 2 * I_GIN + 2 * I_FIN + 4 * I_SQ + 4 * I_SQ + 4 * I_PR;
    for (int it = gw; it < NITEMS; it += NGW) {
        int r = it;
        if (r < 2 * I_GIN) { const int j = r / I_GIN; r -= j * I_GIN; const int nb = r % (GLA_NP / 32), kb = r / (GLA_NP / 32), n0 = nb * 32;
            p0_item(P.gla_w_in + (size_t)j * DM * GLA_IN, DM, GLA_IN, P.WGIN + (size_t)j * GLA_NP * DM, kb * 64, n0, perm_row(n0, 3072), P.norm_mixer + (size_t)(2 * j) * DM, n0 < 512 ? 0.08838834764831845f : 1.f, scr, lane); continue; }
        r -= 2 * I_GIN;
        if (r < 2 * I_FIN) { const int j = r / I_FIN; r -= j * I_FIN; const int nb = r % (FOX_NP / 32), kb = r / (FOX_NP / 32), n0 = nb * 32;
            p0_item(P.fox_w_in + (size_t)j * DM * FOX_IN, DM, FOX_IN, P.WFIN + (size_t)j * FOX_NP * DM, kb * 64, n0, perm_row(n0, 4096), P.norm_mixer + (size_t)(2 * j + 1) * DM, 1.f, scr, lane); continue; }
        r -= 2 * I_FIN;
        if (r < 4 * I_SQ) { const int i = r / I_SQ; r -= i * I_SQ; const int nb = r % 32, kb = r / 32;
            const float* src = (i & 1) ? P.fox_w_out + (size_t)(i >> 1) * DM * DM : P.gla_w_out + (size_t)(i >> 1) * DM * DM;
            p0_item(src, DM, DM, P.WOUT + (size_t)i * DM * DM, kb * 64, nb * 32, perm_row(nb * 32, DM), nullptr, 1.f, scr, lane); continue; }
        r -= 4 * I_SQ;
        if (r < 4 * I_SQ) { const int i = r / I_SQ; r -= i * I_SQ; const int nb = r % 32, kb = r / 32;
            p0_item(P.ple_gate + (size_t)i * DM * DM, DM, DM, P.WGATE + (size_t)i * DM * DM, kb * 64, nb * 32, perm_row(nb * 32, DM), P.ple_norm + (size_t)i * DM, 1.f, scr, lane); continue; }
        r -= 4 * I_SQ;
        { const int i = r / I_PR; r -= i * I_PR; const int nb = r % 32, kb = r / 32;
            p0_item(P.ple_proj + (size_t)i * PLE * DM, PLE, DM, P.WPROJ + (size_t)i * DM * PLE, kb * 64, nb * 32, perm_row(nb * 32, DM), nullptr, 1.f, scr, lane); }
    }
    for (int m0 = gw * 4; m0 < M; m0 += NGW * 4) {
        f32x4 v[4][4];
#pragma unroll
        for (int r = 0; r < 4; ++r) { const GAS f32x4* xr = (const GAS f32x4*)(P.x + (size_t)(m0 + r) * DM) + lane;
#pragma unroll
            for (int j = 0; j < 4; ++j) v[r][j] = xr[64 * j]; }
#pragma unroll
        for (int r = 0; r < 4; ++r) { float s = 0.f;
#pragma unroll
            for (int j = 0; j < 4; ++j) s += (v[r][j].x * v[r][j].x + v[r][j].y * v[r][j].y) + (v[r][j].z * v[r][j].z + v[r][j].w * v[r][j].w);
            s = wave_sum(s);
            GAS unsigned long long* o8 = (GAS unsigned long long*)(P.HB + (size_t)(m0 + r) * DM) + lane;
#pragma unroll
            for (int j = 0; j < 4; ++j) o8[64 * j] = (unsigned long long)pk2(v[r][j].x, v[r][j].y) | ((unsigned long long)pk2(v[r][j].z, v[r][j].w) << 32);
            if (lane < 16) P.SSQA[(size_t)(m0 + r) * 16 + lane] = (lane == 0) ? s : 0.f; }
    }
    { GAS v4u* gz = (GAS v4u*)P.GRAN; v4u z; z.x = 0u; z.y = 0u; z.z = 0u; z.w = 0u;
      for (size_t e = (size_t)gw * 64 + lane; e < GRAN_BYTES / 16; e += (size_t)NGW * 64) gz[e] = z; }
}
__device__ __forceinline__ void cvt_p_phase(const float* p, bf16* PB, int wave) {
    const int gtid = (blockIdx.x * NWAVES + wave) * 64 + lane_id_v(), NT = gridDim.x * NWAVES * 64;
    for (size_t i0 = (size_t)gtid; i0 < (size_t)M * PLE / 8; i0 += (size_t)NT * 8) {
        f32x4 a[8], b[8];
#pragma unroll
        for (int k = 0; k < 8; ++k) { const size_t i = i0 + (size_t)k * NT; if (i < (size_t)M * PLE / 8) { a[k] = *(const GAS f32x4*)(p + i * 8); b[k] = *(const GAS f32x4*)(p + i * 8 + 4); } }
#pragma unroll
        for (int k = 0; k < 8; ++k) { const size_t i = i0 + (size_t)k * NT; if (i < (size_t)M * PLE / 8) {
            v4u o; o.x = pk2(a[k].x, a[k].y); o.y = pk2(a[k].z, a[k].w); o.z = pk2(b[k].x, b[k].y); o.w = pk2(b[k].z, b[k].w);
            *(GAS v4u*)(PB + i * 8) = o; } }
    }
}
__device__ __forceinline__ void final_phase(float* out, const bf16* HB, const float* SSQA, const float* final_norm, int wave, const float pscale, const float padd) {
    const int lane = lane_id_v(), gw = blockIdx.x * NWAVES + wave, NGW = gridDim.x * NWAVES;
    f32x4 gn[2][2];
#pragma unroll
    for (int j = 0; j < 2; ++j) { const GAS f32x4* gr = (const GAS f32x4*)(final_norm + 8 * lane + 512 * j); gn[j][0] = gr[0]; gn[j][1] = gr[1]; }
    for (int m0 = gw * 4; m0 < M; m0 += NGW * 4) {
        float sq[4]; v4u hv[4][2];
#pragma unroll
        for (int r = 0; r < 4; ++r) { sq[r] = SSQA[(size_t)(m0 + r) * 16 + (lane & 15)];
#pragma unroll
            for (int j = 0; j < 2; ++j) hv[r][j] = *(const GAS v4u*)(HB + (size_t)(m0 + r) * DM + 8 * lane + 512 * j); }
#pragma unroll
        for (int r = 0; r < 4; ++r) { float s = sq[r];
            s += __builtin_bit_cast(float, __builtin_amdgcn_update_dpp(0, __builtin_bit_cast(int, s), 0x128, 0xf, 0xf, true));
            s += __builtin_bit_cast(float, __builtin_amdgcn_update_dpp(0, __builtin_bit_cast(int, s), 0x124, 0xf, 0xf, true));
            s += __builtin_bit_cast(float, __builtin_amdgcn_update_dpp(0, __builtin_bit_cast(int, s), 0x122, 0xf, 0xf, true));
            s += __builtin_bit_cast(float, __builtin_amdgcn_update_dpp(0, __builtin_bit_cast(int, s), 0x121, 0xf, 0xf, true));
            const float rstd = rsqrtf(s * (1.f / DM) + EPS) * pscale; const int m = m0 + r;
#pragma unroll
            for (int j = 0; j < 2; ++j) { const v4u h = hv[r][j]; GAS f32x4* o = (GAS f32x4*)(out + (size_t)m * DM + 8 * lane + 512 * j);
                f32x4 a, b2; a.x = __uint_as_float(h.x << 16); a.y = __uint_as_float(h.x & 0xffff0000u); a.z = __uint_as_float(h.y << 16); a.w = __uint_as_float(h.y & 0xffff0000u);
                b2.x = __uint_as_float(h.z << 16); b2.y = __uint_as_float(h.z & 0xffff0000u); b2.z = __uint_as_float(h.w << 16); b2.w = __uint_as_float(h.w & 0xffff0000u);
                f32x4 r0 = a * rstd * gn[j][0], r1 = b2 * rstd * gn[j][1]; if (m == 0 && j == 0 && lane == 0) r0.x += padd;
                o[0] = r0; o[1] = r1; } }
    }
}
__device__ __forceinline__ float bf2f(bf16 b) { return __uint_as_float((unsigned)b << 16); }
__device__ __forceinline__ float sigm(float x) { return 1.f / (1.f + __expf(-x)); }
__device__ __forceinline__ float logsigm(float x) { return fminf(x, 0.f) - log1pf(__expf(-fabsf(x))); }

struct Args { const float* in[17]; float* out; unsigned char* ws; int ph_lo, ph_hi; };
typedef const __attribute__((address_space(4))) Args* KArgs;
#define KARGS() ({ KArgs a_ = (KArgs)__builtin_amdgcn_kernarg_segment_ptr(); asm volatile("" : "+s"(a_)); a_; })
#if TPROBE
#define STAMP() do { if (blockIdx.x == 0 && wave == 0) { if (lane_id_v() == 0) ((volatile LAS unsigned long long*)(lds + LDSCTL_OFF))[sidx] = __builtin_amdgcn_s_memrealtime(); } ++sidx; } while (0)
#else
#define STAMP() do {} while (0)
#endif
#define GRID_BAR() do { XcdBarrier b2_ = bar; asm volatile("" : "+s"(b2_.x), "+s"(b2_.bar)); xcd_barrier(b2_, wave); STAMP(); } while (0)
template <bool LOGF> __device__ __forceinline__ void skinny16_phase(const bf16* HB, const bf16* W16, const float* ssq, const float* bias, float* aux, const int wave, LAS unsigned char* lds) {
    const int lane = lane_id_v(), fr = lane & 15, fq = lane >> 4, tid = wave * 64 + lane;
    constexpr int WP = 2064;
    v4u wst[4];
#pragma unroll
    for (int i = 0; i < 4; ++i) wst[i] = ((const GAS v4u*)W16)[tid + NWAVES * 64 * i];
    const int tile0 = blockIdx.x * NWAVES + wave, tstride = gridDim.x * NWAVES;
    bf16x8 a[32];
    if (tile0 < M / 16) { const bf16* ap = HB + (size_t)(tile0 * 16 + fr) * DM + 8 * fq;
#pragma unroll
        for (int j = 0; j < 32; ++j) a[j] = *(const GAS bf16x8*)(ap + 32 * j); }
#pragma unroll
    for (int i = 0; i < 4; ++i) { const int p = tid + NWAVES * 64 * i; *(LAS v4u*)(lds + (p >> 7) * WP + (p & 127) * 16) = wst[i]; }
    asm volatile("s_waitcnt lgkmcnt(0)\n\ts_barrier" ::: "memory");
    const LAS unsigned char* bl = lds + fr * WP + fq * 16;
    auto finish = [&](int tile, f32x4 acc0, f32x4 acc1) {
        const int row = tile * 16 + fr;
        const GAS f32x4* sp = (const GAS f32x4*)(ssq + (size_t)row * 16); const f32x4 s0 = sp[0], s1 = sp[1], s2 = sp[2], s3 = sp[3];
        const float ss = ((s0.x + s0.y) + (s0.z + s0.w)) + ((s1.x + s1.y) + (s1.z + s1.w)) + ((s2.x + s2.y) + (s2.z + s2.w)) + ((s3.x + s3.y) + (s3.z + s3.w));
        const float rstd = rsqrtf(ss * (1.f / DM) + EPS);
        f32x4 v = (acc0 + acc1) * rstd;
        if constexpr (LOGF) { const f32x4 bv = *(const GAS f32x4*)(bias + 4 * fq); v = v + bv;
#pragma unroll
            for (int i = 0; i < 4; ++i) v[i] = logsigm(v[i]); }
        *(GAS f32x4*)(aux + (size_t)row * 16 + 4 * fq) = v; };
    if (tile0 < M / 16) {
        f32x4 acc0 = {0.f, 0.f, 0.f, 0.f}, acc1 = {0.f, 0.f, 0.f, 0.f};
#pragma unroll
        for (int j = 0; j < 32; j += 2) {
            const bf16x8 b0 = *(const LAS bf16x8*)(bl + 64 * j), b1 = *(const LAS bf16x8*)(bl + 64 * j + 64);
            acc0 = __builtin_amdgcn_mfma_f32_16x16x32_bf16(b0, a[j], acc0, 0, 0, 0); acc1 = __builtin_amdgcn_mfma_f32_16x16x32_bf16(b1, a[j + 1], acc1, 0, 0, 0); }
        finish(tile0, acc0, acc1); }
    for (int tile = tile0 + tstride; tile < M / 16; tile += tstride) {
        const bf16* ap = HB + (size_t)(tile * 16 + fr) * DM + 8 * fq;
        f32x4 acc0 = {0.f, 0.f, 0.f, 0.f}, acc1 = {0.f, 0.f, 0.f, 0.f};
#pragma unroll 4
        for (int j = 0; j < 32; j += 2) {
            const bf16x8 a0 = *(const GAS bf16x8*)(ap + 32 * j), a1 = *(const GAS bf16x8*)(ap + 32 * j + 32);
            const bf16x8 b0 = *(const LAS bf16x8*)(bl + 64 * j), b1 = *(const LAS bf16x8*)(bl + 64 * j + 64);
            acc0 = __builtin_amdgcn_mfma_f32_16x16x32_bf16(b0, a0, acc0, 0, 0, 0); acc1 = __builtin_amdgcn_mfma_f32_16x16x32_bf16(b1, a1, acc1, 0, 0, 0); }
        finish(tile, acc0, acc1); }
}
template <class Sched> __device__ __forceinline__ void rstd_table(const Sched& S, const float* ssq, LAS unsigned char* lds, const int wave) {
    LAS float* rt = (LAS float*)(lds + RSTD_OFF); const int tid = wave * 64 + lane_id_v();
    f32x4 v[4][4]; bool ok[4];
#pragma unroll
    for (int k = 0; k < 4; ++k) { const int e = tid + NWAVES * 64 * k; pg8::Unit uu; ok[k] = S.next(e >> 8, uu);
        if (ok[k]) { const GAS f32x4* sp = (const GAS f32x4*)(ssq + (size_t)(uu.pm * 256 + (e & 255)) * 16); v[k][0] = sp[0]; v[k][1] = sp[1]; v[k][2] = sp[2]; v[k][3] = sp[3]; } }
#pragma unroll
    for (int k = 0; k < 4; ++k) if (ok[k]) { const f32x4 a = v[k][0], b = v[k][1], c = v[k][2], q = v[k][3];
        rt[tid + NWAVES * 64 * k] = rsqrtf((((a.x + a.y) + (a.z + a.w)) + ((b.x + b.y) + (b.z + b.w)) + ((c.x + c.y) + (c.z + c.w)) + ((q.x + q.y) + (q.z + q.w))) * (1.f / DM) + EPS); }
    __syncthreads();
}
template <int i> __device__ __forceinline__ void layer_body(LAS unsigned char* lds, const XcdBarrier& bar, const int wave, const int G, const int lo, const int hi, int& sidx) {
    constexpr int j = i >> 1;
#define IN(k) (lo <= (k) && (k) < hi)
#define HBC ((i & 1) ? (bf16*)((unsigned char*)A->out + 64 * MiB) : (bf16*)(ws + WS_HB))
#define HBN ((i & 1) ? (bf16*)(ws + WS_HB) : (bf16*)((unsigned char*)A->out + 64 * MiB))
        if constexpr ((i & 1) == 0) {
            if (IN(1 + 5 * i)) { KArgs A = KARGS(); unsigned char* ws = A->ws;
              skinny16_phase<false>(HBC, (const bf16*)(ws + WS_WGIN) + (size_t)j * GLA_NP * DM + (size_t)3072 * DM, (const float*)(ws + WS_SSQA), nullptr, (float*)(ws + WS_AUX), wave, lds + RING_OFF);
              cvt_p_phase(A->in[1] + (size_t)i * M * PLE, (bf16*)(ws + WS_PB), wave);
#if DUP_SKINNY
              skinny16_phase<false>(HBC, (const bf16*)(ws + WS_WGIN) + (size_t)j * GLA_NP * DM + (size_t)3072 * DM, (const float*)(ws + WS_SSQA), nullptr, (float*)(ws + WS_AUX), wave, lds + RING_OFF);
              cvt_p_phase(A->in[1] + (size_t)i * M * PLE, (bf16*)(ws + WS_PB), wave);
#endif
              pg8::Gemm g{HBC, (bf16*)(ws + WS_WGIN) + (size_t)j * GLA_NP * DM, M, 3072, DM}; pg8::StaticOrder S; S.init(M, 3072, G, (int)blockIdx.x);
              rstd_table(S, (const float*)(ws + WS_SSQA), lds, wave);
              pg8::EpiGlaIn E{(const LAS float*)(lds + RSTD_OFF), (bf16*)(ws + WS_PROJ), (float*)(ws + WS_AUX)};
              pg8::gemm_phase<pg8::EpiGlaIn, pg8::StaticOrder, true, true>(lds + RING_OFF, g, S, E, wave); }
#if DUP_INPROJ
            if (IN(1 + 5 * i)) { KArgs A = KARGS(); unsigned char* ws = A->ws;
              skinny16_phase<false>(HBC, (const bf16*)(ws + WS_WGIN) + (size_t)j * GLA_NP * DM + (size_t)3072 * DM, (const float*)(ws + WS_SSQA), nullptr, (float*)(ws + WS_AUX), wave, lds + RING_OFF);
              cvt_p_phase(A->in[1] + (size_t)i * M * PLE, (bf16*)(ws + WS_PB), wave);
#if DUP_SKINNY
              skinny16_phase<false>(HBC, (const bf16*)(ws + WS_WGIN) + (size_t)j * GLA_NP * DM + (size_t)3072 * DM, (const float*)(ws + WS_SSQA), nullptr, (float*)(ws + WS_AUX), wave, lds + RING_OFF);
              cvt_p_phase(A->in[1] + (size_t)i * M * PLE, (bf16*)(ws + WS_PB), wave);
#endif
              pg8::Gemm g{HBC, (bf16*)(ws + WS_WGIN) + (size_t)j * GLA_NP * DM, M, 3072, DM}; pg8::StaticOrder S; S.init(M, 3072, G, (int)blockIdx.x);
              rstd_table(S, (const float*)(ws + WS_SSQA), lds, wave);
              pg8::EpiGlaIn E{(const LAS float*)(lds + RSTD_OFF), (bf16*)(ws + WS_PROJ), (float*)(ws + WS_AUX)};
              pg8::gemm_phase<pg8::EpiGlaIn, pg8::StaticOrder, true, true>(lds + RING_OFF, g, S, E, wave); }
#endif
            GRID_BAR();
#define GLA_BUFS() unsigned char* os_ = (unsigned char*)A->out;     \
            gla::Bufs GB{(const gla::bf16*)(ws + WS_PROJ), (const float*)(ws + WS_AUX), (gla::bf16*)os_, (gla::bf16*)(os_ + 32 * MiB), (gla::bf16*)(ws + WS_AF), (unsigned long long*)(ws + WS_GRAN), (float*)(ws + WS_DCH), (gla::bf16*)(ws + WS_OG), (unsigned)(j + 1), \
                A->in[4] + (size_t)j * GLA_RANK * 512, A->in[5] + (size_t)j * 512, A->in[6] + (size_t)j * 256}
#if DUP_GLAPRE
            if (IN(2 + 5 * i)) { KArgs A = KARGS(); unsigned char* ws = A->ws; GLA_BUFS(); gla::pre_phase(GB, lds + RING_OFF, wave); }
#endif
            if (IN(2 + 5 * i)) { KArgs A = KARGS(); unsigned char* ws = A->ws; GLA_BUFS(); gla::pre_phase(GB, lds + RING_OFF, wave); }
            GRID_BAR();
            if (IN(2 + 5 * i)) { KArgs A = KARGS(); unsigned char* ws = A->ws; GLA_BUFS(); gla::core_phase(GB, lds + RING_OFF, wave); }
#if DUP_GLA
            GRID_BAR();
            if (IN(2 + 5 * i)) { KArgs A = KARGS(); unsigned char* ws = A->ws; GLA_BUFS(); gla::pre_phase(GB, lds + RING_OFF, wave); }
            GRID_BAR();
            if (IN(2 + 5 * i)) { KArgs A = KARGS(); unsigned char* ws = A->ws; GLA_BUFS(); gla::core_phase(GB, lds + RING_OFF, wave); }
#endif
        } else {
            if (IN(1 + 5 * i)) { KArgs A = KARGS(); unsigned char* ws = A->ws;
              skinny16_phase<true>(HBC, (const bf16*)(ws + WS_WFIN) + (size_t)j * FOX_NP * DM + (size_t)4096 * DM, (const float*)(ws + WS_SSQA), A->in[9] + (size_t)j * FOX_H, (float*)(ws + WS_AUX), wave, lds + RING_OFF);
              cvt_p_phase(A->in[1] + (size_t)i * M * PLE, (bf16*)(ws + WS_PB), wave);
#if DUP_SKINNY
              skinny16_phase<true>(HBC, (const bf16*)(ws + WS_WFIN) + (size_t)j * FOX_NP * DM + (size_t)4096 * DM, (const float*)(ws + WS_SSQA), A->in[9] + (size_t)j * FOX_H, (float*)(ws + WS_AUX), wave, lds + RING_OFF);
              cvt_p_phase(A->in[1] + (size_t)i * M * PLE, (bf16*)(ws + WS_PB), wave);
#endif
              pg8::Gemm g{HBC, (bf16*)(ws + WS_WFIN) + (size_t)j * FOX_NP * DM, M, 4096, DM}; pg8::StaticOrder S; S.init(M, 4096, G, (int)blockIdx.x);
              rstd_table(S, (const float*)(ws + WS_SSQA), lds, wave);
              pg8::EpiFoxIn E{(const LAS float*)(lds + RSTD_OFF), (bf16*)(ws + WS_PROJ), (float*)(ws + WS_AUX), A->in[9] + (size_t)j * FOX_H, A->in[10] + (size_t)j * 64, A->in[11] + (size_t)j * 64};
              pg8::gemm_phase<pg8::EpiFoxIn, pg8::StaticOrder, true, true>(lds + RING_OFF, g, S, E, wave); }
#if DUP_INPROJ
            if (IN(1 + 5 * i)) { KArgs A = KARGS(); unsigned char* ws = A->ws;
              skinny16_phase<true>(HBC, (const bf16*)(ws + WS_WFIN) + (size_t)j * FOX_NP * DM + (size_t)4096 * DM, (const float*)(ws + WS_SSQA), A->in[9] + (size_t)j * FOX_H, (float*)(ws + WS_AUX), wave, lds + RING_OFF);
              cvt_p_phase(A->in[1] + (size_t)i * M * PLE, (bf16*)(ws + WS_PB), wave);
#if DUP_SKINNY
              skinny16_phase<true>(HBC, (const bf16*)(ws + WS_WFIN) + (size_t)j * FOX_NP * DM + (size_t)4096 * DM, (const float*)(ws + WS_SSQA), A->in[9] + (size_t)j * FOX_H, (float*)(ws + WS_AUX), wave, lds + RING_OFF);
              cvt_p_phase(A->in[1] + (size_t)i * M * PLE, (bf16*)(ws + WS_PB), wave);
#endif
              pg8::Gemm g{HBC, (bf16*)(ws + WS_WFIN) + (size_t)j * FOX_NP * DM, M, 4096, DM}; pg8::StaticOrder S; S.init(M, 4096, G, (int)blockIdx.x);
              rstd_table(S, (const float*)(ws + WS_SSQA), lds, wave);
              pg8::EpiFoxIn E{(const LAS float*)(lds + RSTD_OFF), (bf16*)(ws + WS_PROJ), (float*)(ws + WS_AUX), A->in[9] + (size_t)j * FOX_H, A->in[10] + (size_t)j * 64, A->in[11] + (size_t)j * 64};
              pg8::gemm_phase<pg8::EpiFoxIn, pg8::StaticOrder, true, true>(lds + RING_OFF, g, S, E, wave); }
#endif
            GRID_BAR();
            if (IN(2 + 5 * i)) { KArgs A = KARGS(); unsigned char* ws = A->ws;
              attn_body::c2_phase((const float*)(ws + WS_AUX), A->in[10] + (size_t)j * 64, A->in[11] + (size_t)j * 64, (float*)(ws + WS_DCH), (float*)(ws + WS_CTL) + 8, (char*)lds + RING_OFF, G, (int)blockIdx.x, wave); }
            GRID_BAR();
            if (IN(2 + 5 * i)) { KArgs A = KARGS(); unsigned char* ws = A->ws;
              const attn_body::bf16* PR = (const attn_body::bf16*)(ws + WS_PROJ);
              const attn_body::AttnTensors AT{PR, (attn_body::bf16*)(ws + WS_OG), (const float*)(ws + WS_DCH), (const float*)(ws + WS_CTL) + 8};
              static_assert(attn_body::ATTN_LDS_TOTAL <= RING_BYTES, "attention LDS");
              attn_body::attn_phase<ATTN_THRL>((char*)lds + RING_OFF, AT, G, (int)blockIdx.x, wave); }
#if DUP_ATTN
            if (IN(2 + 5 * i)) { KArgs A = KARGS(); unsigned char* ws = A->ws;
              const attn_body::bf16* PR = (const attn_body::bf16*)(ws + WS_PROJ);
              const attn_body::AttnTensors AT{PR, (attn_body::bf16*)(ws + WS_OG), (const float*)(ws + WS_DCH), (const float*)(ws + WS_CTL) + 8};
              static_assert(attn_body::ATTN_LDS_TOTAL <= RING_BYTES, "attention LDS");
              attn_body::attn_phase<ATTN_THRL>((char*)lds + RING_OFF, AT, G, (int)blockIdx.x, wave); }
#endif
        }
        GRID_BAR();
        if (IN(3 + 5 * i)) { KArgs A = KARGS(); unsigned char* ws = A->ws;
          pg8::Gemm g{(bf16*)(ws + WS_OG), (bf16*)(ws + WS_WOUT) + (size_t)i * DM * DM, M, DM, DM}; pg8::StaticOrder S; S.init(M, DM, G, (int)blockIdx.x);
          pg8::EpiOut<i == 0> E{A->in[0], HBC, (float*)(ws + WS_SSQB)};
          pg8::gemm_phase<pg8::EpiOut<i == 0>, pg8::StaticOrder, true, true>(lds + RING_OFF, g, S, E, wave);
          int kq = PLE; asm volatile("" : "+s"(kq));
          pg8::Gemm g2{(bf16*)(ws + WS_PB), (bf16*)(ws + WS_WPROJ) + (size_t)i * DM * PLE, M, DM, kq}; pg8::EpiP E2{(bf16*)(ws + WS_SG)};
          pg8::gemm_phase<pg8::EpiP, pg8::StaticOrder, true, true>(lds + RING_OFF, g2, S, E2, wave); }
        GRID_BAR();
        if (IN(4 + 5 * i)) { KArgs A = KARGS(); unsigned char* ws = A->ws;
          pg8::Gemm g{HBC, (bf16*)(ws + WS_WGATE) + (size_t)i * DM * DM, M, DM, DM}; pg8::StaticOrder S; S.init(M, DM, G, (int)blockIdx.x);
          rstd_table(S, (const float*)(ws + WS_SSQB), lds, wave);
          pg8::EpiGateFinal E{ws, HBC, HBN, (const LAS float*)(lds + RSTD_OFF), WS_SG, WS_SSQA};
          pg8::gemm_phase<pg8::EpiGateFinal, pg8::StaticOrder, true, true>(lds + RING_OFF, g, S, E, wave); }
        GRID_BAR();
}
__global__ void __launch_bounds__(NWAVES * 64, 2) mega_fwd(Args args_unused) {
    extern __shared__ __attribute__((aligned(16))) unsigned char lds_raw[];
    LAS unsigned char* lds = (LAS unsigned char*)lds_raw;
    volatile LAS unsigned* MISC = (volatile LAS unsigned*)(lds + MISC_OFF);
    const int wave = __builtin_amdgcn_readfirstlane((int)threadIdx.x >> 6); const int G = gridDim.x;
    for (int u = threadIdx.x; u < (LDS_BYTES - LDSCTL_OFF) / 4; u += NWAVES * 64) ((LAS unsigned*)(lds + LDSCTL_OFF))[u] = 0u;
    __syncthreads();
    XcdBarrier bar;
    { KArgs A = KARGS(); bar = xcd_barrier_post((unsigned*)(A->ws + WS_CTL) + CW_BAR, MISC + 8); }

    int lo, hi; { KArgs A = KARGS(); lo = A->ph_lo; hi = A->ph_hi; }
    int sidx = 0; STAMP();
    if (IN(0)) { KArgs A = KARGS(); unsigned char* ws = A->ws; P0Ptrs P;
      P.x = A->in[0]; P.norm_mixer = A->in[2]; P.gla_w_in = A->in[3]; P.gla_w_out = A->in[7]; P.fox_w_in = A->in[8]; P.fox_w_out = A->in[12]; P.ple_proj = A->in[13]; P.ple_gate = A->in[14]; P.ple_norm = A->in[15];
      P.WGIN = (bf16*)(ws + WS_WGIN); P.WFIN = (bf16*)(ws + WS_WFIN); P.WOUT = (bf16*)(ws + WS_WOUT); P.WGATE = (bf16*)(ws + WS_WGATE); P.WPROJ = (bf16*)(ws + WS_WPROJ); P.HB = (bf16*)(ws + WS_HB); P.SSQA = (float*)(ws + WS_SSQA); P.GRAN = ws + WS_GRAN;
      p0_prologue(P, lds, wave);
#if DUP_P0
      p0_prologue(P, lds, wave);
#endif
      }
    GRID_BAR();
#if DUP_BAR
    for (int xb = 0; xb < 16; ++xb) GRID_BAR();
#endif
    layer_body<0>(lds, bar, wave, G, lo, hi, sidx);
    layer_body<1>(lds, bar, wave, G, lo, hi, sidx);
    layer_body<2>(lds, bar, wave, G, lo, hi, sidx);
    layer_body<3>(lds, bar, wave, G, lo, hi, sidx);
    float pscale = 1.f, padd = 0.f;
#if TPROBE
    if (blockIdx.x == 0) { volatile LAS unsigned long long* ts = (volatile LAS unsigned long long*)(lds + LDSCTL_OFF);
        const float ua = (float)(ts[PROBE_A] - ts[PROBE_A - 1]) * 0.01f, ub = (float)(ts[PROBE_B] - ts[PROBE_B - 1]) * 0.01f;
        pscale = 1.f + ua * 0.01f; padd = ub; }
#endif
    if (IN(21)) { KArgs A = KARGS(); final_phase(A->out, (const bf16*)(A->ws + WS_HB), (const float*)(A->ws + WS_SSQA), A->in[16], wave, pscale, padd); }
}

static int mega_grid = 0;
static bool mega_setup(int n_in, int out_size, size_t ws_size) {
    if (mega_grid == 0) {
        if (n_in != 17 || out_size != M * DM || ws_size < WS_END) { fprintf(stderr, "kernel_launch: unexpected shapes: n_in %d out %d ws %zu (need %zu); nothing launched\n", n_in, out_size, ws_size, (size_t)WS_END); mega_grid = -1; return false; }
        int dev = 0, cus = 0, per_cu = 0;
        if (hipGetDevice(&dev) != hipSuccess || hipDeviceGetAttribute(&cus, hipDeviceAttributeMultiprocessorCount, dev) != hipSuccess) { mega_grid = -1; return false; }
        if (hipFuncSetAttribute((const void*)mega_fwd, hipFuncAttributeMaxDynamicSharedMemorySize, LDS_BYTES) != hipSuccess) { fprintf(stderr, "kernel_launch: hipFuncSetAttribute failed\n"); mega_grid = -1; return false; }
        if (hipOccupancyMaxActiveBlocksPerMultiprocessor(&per_cu, (const void*)mega_fwd, NWAVES * 64, LDS_BYTES) != hipSuccess || per_cu < 1) { fprintf(stderr, "kernel_launch: occupancy query says %d blocks per CU\n", per_cu); (void)hipGetLastError(); mega_grid = -1; return false; }
        mega_grid = cus;
    }
    return mega_grid > 0;
}
static void mega_launch(void* const* d_in, void* d_out, void* d_ws, hipStream_t stream, int lo, int hi) {
    if (hipMemsetAsync((char*)d_ws + WS_CTL, 0, CTL_ZERO_BYTES, stream) != hipSuccess) { fprintf(stderr, "kernel_launch: memset failed\n"); return; }
    Args a{};
    for (int i = 0; i < 17; ++i) a.in[i] = (const float*)d_in[i];
    a.out = (float*)d_out; a.ws = (unsigned char*)d_ws; a.ph_lo = lo; a.ph_hi = hi;
    void* kargs[] = {&a};
    hipError_t e = hipLaunchCooperativeKernel((const void*)mega_fwd, dim3(mega_grid), dim3(NWAVES * 64), kargs, LDS_BYTES, stream);
    if (e != hipSuccess) fprintf(stderr, "kernel_launch: cooperative launch failed: %s (grid %d)\n", hipGetErrorString(e), mega_grid);
}
extern "C" void kernel_launch(void* const* d_in, const int* in_sizes, int n_in, void* d_out, int out_size, void* d_ws, size_t ws_size, hipStream_t stream) {
    if (!mega_setup(n_in, out_size, ws_size)) return;
    mega_launch(d_in, d_out, d_ws, stream, 0, 22);
}
```

```cpp
#include <hip/hip_runtime.h>
#include <stdint.h>
#include <cstdio>
#include <cmath>
constexpr int DM = 1024, BATCH = 16, SEQ = 2048, DEPTH = 4, M = BATCH * SEQ;
constexpr int PLE = 256;
constexpr int GLA_H = 4, GLA_RANK = 16;
constexpr int GLA_IN = 3088, GLA_NP = 3328;
constexpr int FOX_H = 16, FOX_IN = 4112, FOX_NP = 4352;
constexpr float EPS = 1e-6f;
constexpr float LOG2E = 1.4426950408889634f;
constexpr float C2 = 0.125f * LOG2E;
constexpr int NWAVES = 8;

constexpr size_t MiB = 1u << 20;
constexpr size_t WS_CTL = 0, CTL_ZERO_BYTES = 64 * 1024;
constexpr size_t WS_WGIN = 1 * MiB;
constexpr size_t WS_WFIN = 14 * MiB;
constexpr size_t WS_WOUT = 31 * MiB;
constexpr size_t WS_WGATE = 39 * MiB;
constexpr size_t WS_WPROJ = 47 * MiB;
constexpr size_t WS_SSQA = 49 * MiB;
constexpr size_t WS_SSQB = 51 * MiB;
constexpr size_t WS_AUX = 53 * MiB;
constexpr size_t WS_PB = 57 * MiB;
constexpr size_t WS_HB = 73 * MiB;
constexpr size_t WS_OG = 137 * MiB;
constexpr size_t WS_PROJ = 201 * MiB;
constexpr size_t WS_SG = WS_PROJ;
constexpr size_t WS_DCH = 55 * MiB;
constexpr size_t WS_SSQG = 474 * MiB;
constexpr size_t WS_AF = 482 * MiB;
constexpr size_t WS_GRAN = 498 * MiB, GRAN_BYTES = 4 * MiB;
constexpr size_t WS_END = 502 * MiB;
constexpr int CW_BAR = 1024;

constexpr int RING_OFF = 0, RING_BYTES = 131072;
constexpr int LDSCTL_OFF = RING_BYTES, MISC_OFF = LDSCTL_OFF + 320;
constexpr int RSTD_OFF = RING_BYTES + 512;
constexpr int LDS_BYTES = 163840;
#ifndef ATTN_THRL
#define ATTN_THRL 64
#endif
#ifndef DUP_INPROJ
#define DUP_INPROJ 0
#endif
#ifndef DUP_GLA
#define DUP_GLA 0
#endif
#ifndef DUP_ATTN
#define DUP_ATTN 0
#endif
#ifndef DUP_GATE
#define DUP_GATE 0
#endif
#ifndef DUP_P0
#define DUP_P0 0
#endif
#ifndef DUP_BAR
#define DUP_BAR 0
#endif
#ifndef DUP_OUT0
#define DUP_OUT0 0
#endif
#ifndef DUP_GLAPRE
#define DUP_GLAPRE 0
#endif
#ifndef TPROBE
#define TPROBE 0
#endif
#ifndef PROBE_A
#define PROBE_A 1
#endif
#ifndef PROBE_B
#define PROBE_B 1
#endif
#ifndef DUP_SKINNY
#define DUP_SKINNY 0
#endif
#ifndef ATTN_XCDMAP
#define ATTN_XCDMAP 0
#endif
#ifndef ATTN_SKIP
#define ATTN_SKIP 0
#endif
#ifndef PROJ_NT
#define PROJ_NT 1
#endif
#ifndef ATTN_SM_MAX
#define ATTN_SM_MAX 40.0f
#endif
namespace pg8 {
#define PG8_LAS __attribute__((address_space(3)))
typedef unsigned short bf16_t;
typedef short bf16x8 __attribute__((ext_vector_type(8)));
typedef float f32x4 __attribute__((ext_vector_type(4)));
typedef unsigned u32x4 __attribute__((ext_vector_type(4)));
constexpr int BM = 256, BK = 64, HALF = 128, HTB = HALF * BK * 2  , STAGE_BYTES = 8 * HTB, NXCD = 8, WGM = 4;

__host__ __device__ __forceinline__ int lds_byte(int r, int c) { const int st = (r >> 4) * 2 + (c >> 5), rr = r & 15, cc = c & 31, ob = rr * 64 + cc * 2; return st * 1024 + (ob ^ (((ob >> 9) & 1) << 5)); }
__host__ __device__ __forceinline__ void stage_rc(int b, int& R, int& C) { const int st = b / 1024, sb = b % 1024, swz = sb ^ (((sb >> 9) & 1) << 5); R = (st >> 1) * 16 + swz / 64; C = (st & 1) * 32 + (swz % 64) / 2; }
__host__ __device__ __forceinline__ int perm32(int rho) { const int n = rho >> 4, i = rho & 15; return 8 * (i >> 2) + 4 * n + (i & 3); }

struct Unit { int pm, pn, idx; };
struct Gemm { const bf16_t* A; const bf16_t* Bt; int M, N, K; };

struct StaticOrder {
    int nM, nN, nwg, G, c;
    __host__ __device__ void init(int M, int N, int G_, int c_) { nM = M / BM; nN = N / BM; nwg = nM * nN; G = G_; c = c_; }
    __host__ __device__ bool next(int i, Unit& u) const {
        const long L = (long)i * G + c; if (L >= nwg) return false;
        int wgid = (int)L; { const int q = nwg / NXCD, r = nwg % NXCD, xcd = wgid % NXCD, off = wgid / NXCD; wgid = (xcd < r ? xcd * (q + 1) : r * (q + 1) + (xcd - r) * q) + off; }
        if (nN == 12 && nM == 128 && G == 256) { const int xcd = (int)(L % NXCD), off = (int)(L / NXCD);
            if (off < 128) { const int w = off & 31; u.pm = xcd * 16 + (off >> 5) * 4 + (w & 3); u.pn = w >> 2; }
            else { const int o2 = off - 128, w = o2 & 31; u.pm = xcd * 16 + (o2 >> 5) * 8 + (w & 7); u.pn = 8 + (w >> 3); }
            u.idx = i; return true; }
        const int nig = WGM * nN, gid = wgid / nig, fm = gid * WGM, gsz = (nM - fm) < WGM ? (nM - fm) : WGM;
        u.pm = fm + ((wgid % nig) % gsz); u.pn = (wgid % nig) / gsz; u.idx = i; return true;
    }
    __device__ __forceinline__ void a_ready(const Unit&) const {}
    __device__ __forceinline__ void done(const Unit&) const {}
};
typedef float f32x2c_t __attribute__((ext_vector_type(2))); typedef __bf16 bf16x2c_t __attribute__((ext_vector_type(2)));
__device__ __forceinline__ unsigned cvt_pk_bf16(float lo, float hi) { f32x2c_t v = {lo, hi}; bf16x2c_t b = __builtin_convertvector(v, bf16x2c_t); return __builtin_bit_cast(unsigned, b); }
typedef float f32x2 __attribute__((ext_vector_type(2)));
typedef unsigned u32x2 __attribute__((ext_vector_type(2)));
__device__ __forceinline__ float sigmoid_f(float x) { return __builtin_amdgcn_rcpf(1.f + __builtin_amdgcn_exp2f(-1.4426950408889634f * x)); }
__device__ __forceinline__ float logsigmoid_f(float x) { return fminf(x, 0.f) - log1pf(__expf(-fabsf(x))); }
__device__ __forceinline__ void lane_rstd(const float* ssq, int row0, int fq, float (&rs)[2][4]) {
#pragma unroll
    for (int ai = 0; ai < 2; ++ai)
#pragma unroll
        for (int m = 0; m < 4; ++m) {
            const f32x4 v = *(const f32x4*)(ssq + (size_t)(row0 + ai * HALF + m * 16) * 16 + 4 * fq);
            float s = (v[0] + v[1]) + (v[2] + v[3]); s += __shfl_xor(s, 16); s += __shfl_xor(s, 32);
            rs[ai][m] = rsqrtf(s * (1.0f / 1024.0f) + 1e-6f);
        }
}
__device__ __forceinline__ void lane_rstd_lds(const PG8_LAS float* rt, int idx, int rloc, float (&rs)[2][4]) {
#pragma unroll
    for (int ai = 0; ai < 2; ++ai)
#pragma unroll
        for (int m = 0; m < 4; ++m) rs[ai][m] = rt[idx * 256 + rloc + ai * HALF + m * 16];
}
__device__ __forceinline__ u32x4 pack8(const f32x4 a, const f32x4 b) { u32x4 w; w.x = cvt_pk_bf16(a[0], a[1]); w.y = cvt_pk_bf16(a[2], a[3]); w.z = cvt_pk_bf16(b[0], b[1]); w.w = cvt_pk_bf16(b[2], b[3]); return w; }

__device__ __forceinline__ float rows4_sum(float q) {
    { auto rr = __builtin_amdgcn_permlane16_swap(__float_as_uint(q), __float_as_uint(q), false, false); q = __uint_as_float(rr[0]) + __uint_as_float(rr[1]); }
    { auto rr = __builtin_amdgcn_permlane32_swap(__float_as_uint(q), __float_as_uint(q), false, false); q = __uint_as_float(rr[0]) + __uint_as_float(rr[1]); }
    return q; }
__device__ __forceinline__ void swap8(const u32x4 a, const u32x4 b, u32x4& xa, u32x4& xb) {
#pragma unroll
    for (int e = 0; e < 4; ++e) {
        xb[e] = (unsigned)__builtin_amdgcn_update_dpp((int)b[e], (int)a[e], 0x128, 0xf, 0x3, false);
        xa[e] = (unsigned)__builtin_amdgcn_update_dpp((int)a[e], (int)b[e], 0x128, 0xf, 0xC, false); } }
__device__ __forceinline__ u32x4 ror8(const u32x4 v) { u32x4 r;
#pragma unroll
    for (int d = 0; d < 4; ++d) r[d] = (unsigned)__builtin_amdgcn_update_dpp(0, (int)v[d], 0x128, 0xf, 0xf, true);
    return r; }
template <bool NT = false>
__device__ __forceinline__ void store_pair(bf16_t* base, int pitch, int rowb, int colw, int fr, const u32x4 p0, const u32x4 p1) {
    const bool hi8 = (fr & 8) != 0; u32x4 dA, dB; swap8(p0, p1, dA, dB);
    bf16_t* pa = base + (size_t)(rowb + (fr & 7)) * pitch + colw + (hi8 ? 32 : 0);
    if constexpr (NT) { __builtin_nontemporal_store(dA, (u32x4*)pa); __builtin_nontemporal_store(dB, (u32x4*)(pa + (size_t)8 * pitch)); }
    else { *(u32x4*)pa = dA; *(u32x4*)(pa + (size_t)8 * pitch) = dB; } }
__device__ __forceinline__ void load_raw(const bf16_t* base, int pitch, int rowb, int colw, int fr, u32x4& LA, u32x4& LB) {
    const bool hi8 = (fr & 8) != 0; const bf16_t* pa = base + (size_t)(rowb + (fr & 7)) * pitch + colw + (hi8 ? 32 : 0);
    LA = *(const u32x4*)pa; LB = *(const u32x4*)(pa + (size_t)8 * pitch); }
__device__ __forceinline__ void unswap(int fr, const u32x4 LA, const u32x4 LB, u32x4& p0, u32x4& p1) {
    (void)fr; swap8(LA, LB, p0, p1); }

struct EpiGlaIn {
    static constexpr bool PERM = true, AFTER_DRAIN = false;
    const PG8_LAS float* rt; bf16_t* proj; float* aux;
    __device__ __forceinline__ void operator()(const f32x4 (&acc)[2][2][4][2], const Unit& u, int wr, int wc, int fr, int fq) const {
        asm volatile("" : "+v"(fr), "+v"(fq));
        const int rowb0 = u.pm * BM + wr * 64, colw = u.pn * BM + 64 * wc + 8 * fq; float rs[2][4]; lane_rstd_lds(rt, u.idx, wr * 64 + fr, rs);
#pragma unroll
        for (int ai = 0; ai < 2; ++ai)
#pragma unroll
            for (int m = 0; m < 4; ++m) { const float s = rs[ai][m];
                store_pair<PROJ_NT != 0>(proj, 3328, rowb0 + ai * HALF + m * 16, colw, fr, pack8(acc[ai][0][m][0] * s, acc[ai][0][m][1] * s), pack8(acc[ai][1][m][0] * s, acc[ai][1][m][1] * s)); }
    }
};
struct EpiFoxIn {
    static constexpr bool PERM = true, AFTER_DRAIN = false;
    const PG8_LAS float* rt; bf16_t* proj; float* aux; const float* bf; const float* qg; const float* kg;
    __device__ __forceinline__ void operator()(const f32x4 (&acc)[2][2][4][2], const Unit& u, int wr, int wc, int fr, int fq) const {
        asm volatile("" : "+v"(fr), "+v"(fq));
        const int rowb0 = u.pm * BM + wr * 64, colw = u.pn * BM + 64 * wc + 8 * fq; float rs[2][4]; lane_rstd_lds(rt, u.idx, wr * 64 + fr, rs);
        if (u.pn < 8) {
            const bool isq = u.pn < 4; const float* gsrc = isq ? qg : kg; const float gmul = isq ? (0.125f * 1.4426950408889634f) : 1.0f;
            f32x4 gv[2][2];
#pragma unroll
            for (int bj = 0; bj < 2; ++bj)
#pragma unroll
                for (int n = 0; n < 2; ++n) gv[bj][n] = *(const f32x4*)(gsrc + 32 * bj + 8 * fq + 4 * n) * gmul;
#pragma unroll
            for (int ai = 0; ai < 2; ++ai)
#pragma unroll
                for (int m = 0; m < 4; ++m) { const float s = rs[ai][m]; f32x4 v[2][2]; float q = 0.f;
#pragma unroll
                    for (int bj = 0; bj < 2; ++bj)
#pragma unroll
                        for (int n = 0; n < 2; ++n) { v[bj][n] = acc[ai][bj][m][n] * s; q += (v[bj][n][0] * v[bj][n][0] + v[bj][n][1] * v[bj][n][1]) + (v[bj][n][2] * v[bj][n][2] + v[bj][n][3] * v[bj][n][3]); }
                    q = rows4_sum(q);
                    const float hr = rsqrtf(q * (1.0f / 64.0f) + 1e-6f);
                    store_pair<PROJ_NT != 0>(proj, 4352, rowb0 + ai * HALF + m * 16, colw, fr, pack8(v[0][0] * hr * gv[0][0], v[0][1] * hr * gv[0][1]), pack8(v[1][0] * hr * gv[1][0], v[1][1] * hr * gv[1][1])); }
        } else {
#pragma unroll
            for (int ai = 0; ai < 2; ++ai)
#pragma unroll
                for (int m = 0; m < 4; ++m) { const float s = rs[ai][m];
                    store_pair<PROJ_NT != 0>(proj, 4352, rowb0 + ai * HALF + m * 16, colw, fr, pack8(acc[ai][0][m][0] * s, acc[ai][0][m][1] * s), pack8(acc[ai][1][m][0] * s, acc[ai][1][m][1] * s)); }
        }
    }
};
__device__ __forceinline__ void unpack8(const u32x4 g, f32x4& g0, f32x4& g1) {
    g0[0] = __uint_as_float(g.x << 16); g0[1] = __uint_as_float(g.x & 0xffff0000u); g0[2] = __uint_as_float(g.y << 16); g0[3] = __uint_as_float(g.y & 0xffff0000u);
    g1[0] = __uint_as_float(g.z << 16); g1[1] = __uint_as_float(g.z & 0xffff0000u); g1[2] = __uint_as_float(g.w << 16); g1[3] = __uint_as_float(g.w & 0xffff0000u);
}
__device__ __forceinline__ void store_h_rows(bf16_t* hb, float* ssq, int rowb, int colw, int slot, int fr, int fq, const f32x4 (&v)[2][2]) {
    float q = 0.f;
#pragma unroll
    for (int bj = 0; bj < 2; ++bj)
#pragma unroll
        for (int n = 0; n < 2; ++n) q += (v[bj][n][0] * v[bj][n][0] + v[bj][n][1] * v[bj][n][1]) + (v[bj][n][2] * v[bj][n][2] + v[bj][n][3] * v[bj][n][3]);
    store_pair(hb, 1024, rowb, colw, fr, pack8(v[0][0], v[0][1]), pack8(v[1][0], v[1][1]));
    q = rows4_sum(q);
    if (fq == 0) ssq[(size_t)(rowb + fr) * 16 + slot] = q;
}
template <bool X32> struct EpiOut {
    static constexpr bool PERM = true, AFTER_DRAIN = false;
    const float* x; bf16_t* hb; float* ssq;
    __device__ __forceinline__ void operator()(const f32x4 (&acc)[2][2][4][2], const Unit& u, int wr, int wc, int fr, int fq) const {
        asm volatile("" : "+v"(fr), "+v"(fq));
        const int rowb0 = u.pm * BM + wr * 64, colw = u.pn * BM + 64 * wc + 8 * fq, slot = u.pn * 4 + wc;
#pragma unroll
        for (int ai = 0; ai < 2; ++ai) {
            if constexpr (X32) {
                f32x4 pre[4][2][2];
#pragma unroll
                for (int m = 0; m < 4; ++m)
#pragma unroll
                    for (int bj = 0; bj < 2; ++bj) { const size_t o = (size_t)(rowb0 + ai * HALF + m * 16 + fr) * 1024 + colw + 32 * bj; pre[m][bj][0] = *(const f32x4*)(x + o); pre[m][bj][1] = *(const f32x4*)(x + o + 4); }
#pragma unroll
                for (int m = 0; m < 4; ++m) { f32x4 v[2][2];
#pragma unroll
                    for (int bj = 0; bj < 2; ++bj) { v[bj][0] = pre[m][bj][0] + acc[ai][bj][m][0]; v[bj][1] = pre[m][bj][1] + acc[ai][bj][m][1]; }
                    store_h_rows(hb, ssq, rowb0 + ai * HALF + m * 16, colw, slot, fr, fq, v); }
            } else {
                u32x4 la[4], lb[4];
#pragma unroll
                for (int m = 0; m < 4; ++m) load_raw(hb, 1024, rowb0 + ai * HALF + m * 16, colw, fr, la[m], lb[m]);
#pragma unroll
                for (int m = 0; m < 4; ++m) { u32x4 q0, q1; unswap(fr, la[m], lb[m], q0, q1); f32x4 v[2][2], h0, h1;
                    unpack8(q0, h0, h1); v[0][0] = h0 + acc[ai][0][m][0]; v[0][1] = h1 + acc[ai][0][m][1];
                    unpack8(q1, h0, h1); v[1][0] = h0 + acc[ai][1][m][0]; v[1][1] = h1 + acc[ai][1][m][1];
                    store_h_rows(hb, ssq, rowb0 + ai * HALF + m * 16, colw, slot, fr, fq, v); }
            }
            asm volatile("" ::: "memory");
        }
    }
};
struct EpiP {
    static constexpr bool PERM = true, AFTER_DRAIN = false;
    bf16_t* pp;
    __device__ __forceinline__ void operator()(const f32x4 (&acc)[2][2][4][2], const Unit& u, int wr, int wc, int fr, int fq) const {
        asm volatile("" : "+v"(fr), "+v"(fq));
        const int rowb0 = u.pm * BM + wr * 64, colw = u.pn * BM + 64 * wc + 8 * fq;
#pragma unroll
        for (int ai = 0; ai < 2; ++ai)
#pragma unroll
            for (int m = 0; m < 4; ++m) store_pair(pp, 1024, rowb0 + ai * HALF + m * 16, colw, fr, pack8(acc[ai][0][m][0], acc[ai][0][m][1]), pack8(acc[ai][1][m][0], acc[ai][1][m][1]));
    }
};
struct EpiGateFinal {
    static constexpr bool PERM = true, AFTER_DRAIN = false;
    unsigned char* ws; const bf16_t* hin; bf16_t* hout; const PG8_LAS float* rt; size_t off_pp, off_ssq_out;
    __device__ __forceinline__ void operator()(const f32x4 (&acc)[2][2][4][2], const Unit& u, int wr, int wc, int fr, int fq) const {
        asm volatile("" : "+v"(fr), "+v"(fq));
        const bf16_t* pp = (const bf16_t*)(ws + off_pp); float* ssq_out = (float*)(ws + off_ssq_out);
        const int rowb0 = u.pm * BM + wr * 64, colw = u.pn * BM + 64 * wc + 8 * fq, slot = u.pn * 4 + wc; float rs[2][4]; lane_rstd_lds(rt, u.idx, wr * 64 + fr, rs);
#pragma unroll
        for (int ai = 0; ai < 2; ++ai)
#pragma unroll
            for (int mh = 0; mh < 2; ++mh) {
                u32x4 ha[2], hb_[2], ga[2], gb[2];
#pragma unroll
                for (int mm = 0; mm < 2; ++mm) { const int rowb = rowb0 + ai * HALF + (2 * mh + mm) * 16; load_raw(hin, 1024, rowb, colw, fr, ha[mm], hb_[mm]); load_raw(pp, 1024, rowb, colw, fr, ga[mm], gb[mm]); }
#pragma unroll
                for (int mm = 0; mm < 2; ++mm) { const int m = 2 * mh + mm; const float s = rs[ai][m] * -1.4426950408889634f; f32x4 v[2][2]; u32x4 hq[2], pq[2];
                    unswap(fr, ha[mm], hb_[mm], hq[0], hq[1]); unswap(fr, ga[mm], gb[mm], pq[0], pq[1]);
#pragma unroll
                    for (int bj = 0; bj < 2; ++bj) { f32x4 h0, h1, p0, p1; unpack8(hq[bj], h0, h1); unpack8(pq[bj], p0, p1);
                        f32x4 a = acc[ai][bj][m][0] * s, b = acc[ai][bj][m][1] * s;
#pragma unroll
                        for (int i = 0; i < 4; ++i) { a[i] = __builtin_amdgcn_rcpf(1.f + __builtin_amdgcn_exp2f(a[i])); b[i] = __builtin_amdgcn_rcpf(1.f + __builtin_amdgcn_exp2f(b[i])); }
                        v[bj][0] = h0 + p0 * a; v[bj][1] = h1 + p1 * b; }
                    store_h_rows(hout, ssq_out, rowb0 + ai * HALF + m * 16, colw, slot, fr, fq, v); }
                asm volatile("" ::: "memory");
            }
    }
};
template <class Epi, class Sched, bool ALIGN_EPI = false, bool SP2 = false>
__device__ __forceinline__ void gemm_phase(PG8_LAS unsigned char* lds, const Gemm g, const Sched& S, const Epi& E, const int wid  ) {
    int lane_; asm volatile("v_mbcnt_lo_u32_b32 %0, -1, 0\n\tv_mbcnt_hi_u32_b32 %0, -1, %0" : "=v"(lane_));
    const int lane = lane_, tid = wid * 64 + lane, wr = wid >> 2, wc = wid & 3, fr = lane & 15, fq = lane >> 4;
    const int K = g.K, nt = K / BK;
    unsigned voffA[2], voffB[2];
#pragma unroll
    for (int i = 0; i < 2; ++i) { int R, C; stage_rc(tid * 16 + i * 8192, R, C); const int Rb = Epi::PERM ? ((R & ~31) + perm32(R & 31)) : R;
        voffA[i] = (unsigned)(R * K + C) * 2u; voffB[i] = (unsigned)(Rb * K + C) * 2u; }
    const size_t kstep = (size_t)(BK * 2);
    const size_t hstep = (size_t)HALF * K * 2;
    const size_t tstep = 2 * hstep;
    const unsigned ldsw = (unsigned)wid * 1024u;
    const int aoff = lds_byte(wr * 64 + fr, fq * 8), boff = lds_byte(wc * 32 + fr, fq * 8);
#define PG8_SA(b, h) (((b) * 2 + (h)) * HTB)
#define PG8_SB(b, h) ((4 + (b) * 2 + (h)) * HTB)
#define PG8_STAGE(bufoff, gbase, voff) do { _Pragma("unroll") for (int _i = 0; _i < 2; ++_i) \
        __builtin_amdgcn_global_load_lds((const unsigned*)((const char*)(gbase) + (voff)[_i]), (PG8_LAS unsigned*)(lds + (bufoff) + ldsw + _i * 8192), 16, 0, 0); } while (0)
#define PG8_LDA(dst, b, h) do { _Pragma("unroll") for (int m = 0; m < 4; ++m) _Pragma("unroll") for (int k = 0; k < 2; ++k) dst[m][k] = *(const PG8_LAS bf16x8*)(lds + PG8_SA(b, h) + aoff + m * 2048 + k * 1024); } while (0)
#define PG8_LDB(dst, b, h) do { _Pragma("unroll") for (int n = 0; n < 2; ++n) _Pragma("unroll") for (int k = 0; k < 2; ++k) dst[n][k] = *(const PG8_LAS bf16x8*)(lds + PG8_SB(b, h) + boff + n * 2048 + k * 1024); } while (0)
#define PG8_MMA(ai, bj, At, Bt) do { __builtin_amdgcn_s_setprio(1); _Pragma("unroll") for (int m = 0; m < 4; ++m) _Pragma("unroll") for (int n = 0; n < 2; ++n) _Pragma("unroll") for (int k = 0; k < 2; ++k) \
        acc[ai][bj][m][n] = __builtin_amdgcn_mfma_f32_16x16x32_bf16(Bt[n][k], At[m][k], acc[ai][bj][m][n], 0, 0, 0); __builtin_amdgcn_s_setprio(0); } while (0)
#define PG8_WAIT_V(n) asm volatile("s_waitcnt vmcnt(" #n ")" ::: "memory")
#define PG8_WAIT_L(n) asm volatile("s_waitcnt lgkmcnt(" #n ")" ::: "memory")
#define PG8_BAR __builtin_amdgcn_s_barrier()
#define PG8_SCHED __builtin_amdgcn_sched_barrier(0)
    Unit cur, nxt; int ui = 0;
    if (!S.next(0, cur)) return;
    f32x4 acc[2][2][4][2];
#pragma unroll
    for (int a = 0; a < 2; ++a)
#pragma unroll
        for (int b = 0; b < 2; ++b)
#pragma unroll
            for (int m = 0; m < 4; ++m)
#pragma unroll
                for (int n = 0; n < 2; ++n) acc[a][b][m][n] = (f32x4){0.f, 0.f, 0.f, 0.f};
    bf16x8 At[4][2], B0[2][2], B1[2][2];
    const char* cA = (const char*)g.A + (size_t)cur.pm * tstep; const char* cB = (const char*)g.Bt + (size_t)cur.pn * tstep;
    S.a_ready(cur);
    if constexpr (SP2) {
        PG8_STAGE(PG8_SB(0, 0), cB, voffB); PG8_STAGE(PG8_SB(0, 1), cB + hstep, voffB); PG8_STAGE(PG8_SA(0, 0), cA, voffA); PG8_STAGE(PG8_SA(0, 1), cA + hstep, voffA);
        if (wr == 1) PG8_BAR;
        PG8_WAIT_V(2); PG8_BAR;
        PG8_STAGE(PG8_SB(1, 0), cB + kstep, voffB); PG8_STAGE(PG8_SA(1, 0), cA + kstep, voffA); PG8_STAGE(PG8_SB(1, 1), cB + hstep + kstep, voffB);
        PG8_WAIT_V(6); PG8_BAR;
    } else {
        PG8_STAGE(PG8_SB(0, 0), cB, voffB); PG8_STAGE(PG8_SA(0, 0), cA, voffA); PG8_STAGE(PG8_SB(0, 1), cB + hstep, voffB); PG8_STAGE(PG8_SA(0, 1), cA + hstep, voffA);
        if (wr == 1) PG8_BAR;
        PG8_WAIT_V(4); PG8_BAR;
        PG8_STAGE(PG8_SB(1, 0), cB + kstep, voffB); PG8_STAGE(PG8_SA(1, 0), cA + kstep, voffA); PG8_STAGE(PG8_SB(1, 1), cB + hstep + kstep, voffB);
        PG8_WAIT_V(6); PG8_BAR;
    }
    for (;;) {
        const bool has_next = S.next(ui + 1, nxt);
        const char* nA = has_next ? (const char*)g.A + (size_t)nxt.pm * tstep : cA; const char* nB = has_next ? (const char*)g.Bt + (size_t)nxt.pn * tstep : cB;
        for (int t = 0; t < nt; t += 2) {
            const bool last = (t == nt - 2);
            const char* a1 = cA + (size_t)(t + 1) * kstep;
            const char* a2 = last ? nA : cA + (size_t)(t + 2) * kstep; const char* b2 = last ? nB : cB + (size_t)(t + 2) * kstep;
            const char* a3 = a2 + kstep; const char* b3 = b2 + kstep;
            if (last && has_next) S.a_ready(nxt);
            if constexpr (SP2) {
            PG8_LDB(B0, 0, 0); PG8_LDB(B1, 0, 1); PG8_SCHED; PG8_LDA(At, 0, 0); PG8_STAGE(PG8_SA(1, 1), a1 + hstep, voffA);
            PG8_WAIT_V(8); PG8_WAIT_L(0); PG8_BAR; PG8_MMA(0, 0, At, B0); PG8_MMA(0, 1, At, B1); PG8_BAR; PG8_SCHED;
            PG8_LDA(At, 0, 1); PG8_STAGE(PG8_SB(0, 0), b2, voffB); PG8_STAGE(PG8_SB(0, 1), b2 + hstep, voffB); PG8_STAGE(PG8_SA(0, 0), a2, voffA);
            PG8_WAIT_V(8); PG8_WAIT_L(0); PG8_BAR; PG8_MMA(1, 0, At, B0); PG8_MMA(1, 1, At, B1); PG8_BAR; PG8_SCHED;
            PG8_LDB(B0, 1, 0); PG8_LDB(B1, 1, 1); PG8_SCHED; PG8_LDA(At, 1, 0); PG8_STAGE(PG8_SA(0, 1), a2 + hstep, voffA);
            PG8_WAIT_V(8); PG8_WAIT_L(0); PG8_BAR; PG8_MMA(0, 0, At, B0); PG8_MMA(0, 1, At, B1); PG8_BAR; PG8_SCHED;
            PG8_LDA(At, 1, 1); PG8_STAGE(PG8_SB(1, 0), b3, voffB); PG8_STAGE(PG8_SB(1, 1), b3 + hstep, voffB); PG8_STAGE(PG8_SA(1, 0), a3, voffA);
            PG8_WAIT_V(8); PG8_WAIT_L(0); PG8_BAR; PG8_MMA(1, 0, At, B0); PG8_MMA(1, 1, At, B1); PG8_BAR; PG8_SCHED;
            } else {
            PG8_LDB(B0, 0, 0); PG8_SCHED; PG8_LDA(At, 0, 0); PG8_STAGE(PG8_SA(1, 1), a1 + hstep, voffA);
            PG8_WAIT_L(8); PG8_BAR; PG8_WAIT_L(0); PG8_MMA(0, 0, At, B0); PG8_BAR; PG8_SCHED;
            PG8_LDB(B1, 0, 1); PG8_STAGE(PG8_SB(0, 0), b2, voffB);
            PG8_BAR; PG8_WAIT_L(0); PG8_MMA(0, 1, At, B1); PG8_BAR;
            PG8_LDA(At, 0, 1); PG8_STAGE(PG8_SA(0, 0), a2, voffA);
            PG8_BAR; PG8_WAIT_L(0); PG8_MMA(1, 0, At, B0); PG8_BAR; PG8_SCHED;
            PG8_STAGE(PG8_SB(0, 1), b2 + hstep, voffB);
            PG8_WAIT_V(6); PG8_BAR; PG8_MMA(1, 1, At, B1); PG8_BAR;
            PG8_LDB(B0, 1, 0); PG8_SCHED; PG8_LDA(At, 1, 0); PG8_STAGE(PG8_SA(0, 1), a2 + hstep, voffA);
            PG8_WAIT_L(8); PG8_BAR; PG8_WAIT_L(0); PG8_MMA(0, 0, At, B0); PG8_BAR; PG8_SCHED;
            PG8_LDB(B1, 1, 1); PG8_STAGE(PG8_SB(1, 0), b3, voffB);
            PG8_BAR; PG8_WAIT_L(0); PG8_MMA(0, 1, At, B1); PG8_BAR;
            PG8_LDA(At, 1, 1); PG8_STAGE(PG8_SA(1, 0), a3, voffA);
            PG8_BAR; PG8_WAIT_L(0); PG8_MMA(1, 0, At, B0); PG8_BAR; PG8_SCHED;
            PG8_STAGE(PG8_SB(1, 1), b3 + hstep, voffB);
            PG8_WAIT_V(6); PG8_BAR; PG8_MMA(1, 1, At, B1); PG8_BAR;
            }
        }
        if constexpr (ALIGN_EPI) { if (wr == 0) PG8_BAR; }
        if constexpr (!Epi::AFTER_DRAIN) { E(acc, cur, wr, wc, fr, fq); S.done(cur); }
        if (!has_next) break;
#pragma unroll
        for (int a = 0; a < 2; ++a)
#pragma unroll
            for (int b = 0; b < 2; ++b)
#pragma unroll
                for (int m = 0; m < 4; ++m)
#pragma unroll
                    for (int n = 0; n < 2; ++n) acc[a][b][m][n] = (f32x4){0.f, 0.f, 0.f, 0.f};
        cur = nxt; cA = nA; cB = nB; ++ui;
        if constexpr (ALIGN_EPI) { if (wr == 1) PG8_BAR; }
    }
    PG8_WAIT_V(0);
    if constexpr (!ALIGN_EPI) { if (wr == 0) PG8_BAR; }
    PG8_BAR;
    if constexpr (Epi::AFTER_DRAIN) { E.fused(acc, cur, wr, wc, fr, fq, lds, wid, lane); S.done(cur); }
#undef PG8_SA
#undef PG8_SB
#undef PG8_STAGE
#undef PG8_LDA
#undef PG8_LDB
#undef PG8_MMA
#undef PG8_WAIT_V
#undef PG8_WAIT_L
#undef PG8_BAR
#undef PG8_SCHED
}
}
#define GAS __attribute__((address_space(1)))
#define LAS __attribute__((address_space(3)))
typedef unsigned short bf16;
typedef unsigned v4u __attribute__((ext_vector_type(4)));
typedef float f32x4 __attribute__((ext_vector_type(4)));
typedef short bf16x8 __attribute__((ext_vector_type(8)));
typedef GAS unsigned gu32;
typedef GAS unsigned long long gu64;
#define RLX_AGENT __ATOMIC_RELAXED, __HIP_MEMORY_SCOPE_AGENT
#define LDS_WAIT() asm volatile("s_waitcnt lgkmcnt(0)" ::: "memory")
#define VM_WAIT() asm volatile("s_waitcnt vmcnt(0)" ::: "memory")
__device__ __forceinline__ unsigned long long rt() { return __builtin_amdgcn_s_memrealtime(); }
__device__ __forceinline__ unsigned f2bf(float f) { unsigned u = __builtin_bit_cast(unsigned, f); return (u + 0x7fffu + ((u >> 16) & 1u)) >> 16; }
__device__ __forceinline__ unsigned pk2(float lo, float hi) { return f2bf(lo) | (f2bf(hi) << 16); }
#define XB_TMO      128
#define XB_XCNT(j)  (256  + 64 * (j))
#define XB_XSUB(j)  (1280 + 64 * (j))
#define XB_XGEN(j)  (2304 + 64 * (j))
#define XB_TOP      3328
#define XB_TOPGEN   3392
#define XCD_BAR_WORDS 3456
#define XB_SPIN_CAP (1u << 18)

__device__ __forceinline__ unsigned xb_ld(unsigned* p)              { return __hip_atomic_load(p, __ATOMIC_RELAXED, __HIP_MEMORY_SCOPE_AGENT); }
__device__ __forceinline__ unsigned xb_add(unsigned* p, unsigned v) { return __hip_atomic_fetch_add(p, v, __ATOMIC_RELAXED, __HIP_MEMORY_SCOPE_AGENT); }
__device__ __forceinline__ unsigned xb_xcc_id() { return (unsigned)__builtin_amdgcn_s_getreg((3 << 11) | 20) & 0xFu; }
#define XB_SPIN(cond, bar) do { unsigned _sp = 0; while (cond) { __builtin_amdgcn_s_sleep(1); \
    if ((++_sp & 255u) == 0u) { if (xb_ld(&(bar)[XB_TMO])) break; if (_sp > XB_SPIN_CAP) { atomicAdd(&(bar)[XB_TMO], 1u); break; } } } } while (0)

struct XcdBarrier {
    unsigned* bar; unsigned x;
    volatile LAS unsigned* st;
};

__device__ __forceinline__ XcdBarrier xcd_barrier_post(unsigned* bar, volatile LAS unsigned* st) {
    XcdBarrier b; b.bar = bar; b.x = xb_xcc_id(); b.st = st;
    if (threadIdx.x == 0) (void)xb_add(&bar[XB_XCNT(b.x)], 1u);
    return b;
}
__device__ __forceinline__ void xcd_barrier_complete(unsigned* bar, unsigned x, unsigned& nloc, unsigned& nx) {
    const unsigned G = gridDim.x * gridDim.y * gridDim.z;
    unsigned sum, cnt, mine, sp = 0u;
    for (;;) {
        sum = 0u; cnt = 0u; mine = 0u;
#pragma unroll
        for (unsigned j = 0; j < 16; ++j) { const unsigned c = xb_ld(&bar[XB_XCNT(j)]); sum += c; cnt += (c > 0u) ? 1u : 0u; mine = (j == x) ? c : mine; }
        if (sum == G) break;
        __builtin_amdgcn_s_sleep(1);
        if ((++sp & 255u) == 0u) { if (xb_ld(&bar[XB_TMO])) break; if (sp > XB_SPIN_CAP) { atomicAdd(&bar[XB_TMO], 1u); break; } }
    }
    nloc = mine > 0u ? mine : 1u; nx = cnt > 0u ? cnt : 1u;
}

__device__ __forceinline__ void xcd_barrier(const XcdBarrier& b, const int wave_) {
    asm volatile("s_waitcnt vmcnt(0)" ::: "memory");
    __syncthreads();
    int l0_; asm volatile("v_mbcnt_lo_u32_b32 %0, -1, 0\n\tv_mbcnt_hi_u32_b32 %0, -1, %0" : "=v"(l0_));
    if (wave_ == 0 && l0_ == 0) {
        unsigned* bar = b.bar;
        __builtin_amdgcn_s_waitcnt(0);
        unsigned nloc = b.st[0], nx = b.st[1];
        if (nloc == 0u) { xcd_barrier_complete(bar, b.x, nloc, nx); b.st[0] = nloc; b.st[1] = nx; }
        const unsigned old = xb_add(&bar[XB_XSUB(b.x)], 1u);
        const unsigned gen = old / nloc;
        if (old + 1u == (gen + 1u) * nloc) {
            __builtin_amdgcn_fence(__ATOMIC_RELEASE, "agent");
            asm volatile("s_waitcnt vmcnt(0)" ::: "memory");
            const unsigned og = xb_add(&bar[XB_TOP], 1u);
            const unsigned tg = og / nx;
            if (og + 1u == (tg + 1u) * nx) xb_add(&bar[XB_TOPGEN], 1u);
            else XB_SPIN(xb_ld(&bar[XB_TOPGEN]) == tg, bar);
            __builtin_amdgcn_fence(__ATOMIC_ACQUIRE, "agent");
            xb_add(&bar[XB_XGEN(b.x)], 1u);
            asm volatile("s_waitcnt vmcnt(0)" ::: "memory");
        } else {
            XB_SPIN(xb_ld(&bar[XB_XGEN(b.x)]) == gen, bar);
            __builtin_amdgcn_fence(__ATOMIC_ACQUIRE, "agent");
            asm volatile("s_waitcnt vmcnt(0)" ::: "memory");
        }
    }
    __syncthreads();
}
#include <hip/hip_bf16.h>
#include <cmath>
namespace attn_body {
using bf16=__hip_bfloat16;
using bf16x8=__attribute__((ext_vector_type(8)))short;
using s16x4=__attribute__((ext_vector_type(4)))short;
using f32x16=__attribute__((ext_vector_type(16)))float;
using u32x4=__attribute__((ext_vector_type(4)))unsigned;
using u32x2_t=__attribute__((ext_vector_type(2)))unsigned;
constexpr int BATCH=16,NHEAD=16,SEQ=2048,D=64,DM=4352,PO=1024;
constexpr int NW=8,QBLK=32,QB=QBLK*NW,KVBLK=64,NQB=SEQ/QB;
constexpr int ATTN_PITCH=DM, ATTN_UNIT_ROWS=QB;
typedef __attribute__((address_space(3))) const float* lds_fptr; typedef float f32x4a __attribute__((ext_vector_type(4)));
__device__ __forceinline__ int crow(int r,int hi){return (r&3)+8*(r>>2)+4*hi;}
__device__ __forceinline__ int fresh_lane(){ int l; asm volatile("v_mbcnt_lo_u32_b32 %0, -1, 0\n\tv_mbcnt_hi_u32_b32 %0, -1, %0" : "=v"(l)); return l; }
#define SBAR() __builtin_amdgcn_sched_barrier(0)
__device__ __forceinline__ void cmask(f32x16&p0,f32x16&p1,int jb,int qrel,int hi){
  const float NEG=-INFINITY; int kb=64*jb+4*hi;
  #pragma unroll
  for(int r=0;r<16;++r){int kv=kb+(r&3)+8*(r>>2); if(kv>qrel)p0[r]=NEG; if(kv+32>qrel)p1[r]=NEG;}
}

constexpr int NSLOT=3, SLOTB=8192;
constexpr int LDS_K=0, LDS_V=NSLOT*SLOTB, QST_HI=131584  , RING_SET=2*NSLOT*SLOTB  , LDS_WS=2*RING_SET, LDS_BYTES=LDS_WS+NW*64*4+SEQ*4+SEQ*8+4096;
constexpr int SEAM_C2F=LDS_WS+NW*64*4  , SEAM_C2S=SEAM_C2F+SEQ*4  , QST_W7=SEAM_C2S+SEQ*8;
constexpr float C2=0.125f*1.4426950408889634f;
__device__ __forceinline__ void glds16(const void*gsrc,unsigned lds_dst){unsigned keep;
  asm volatile("s_mov_b32 %0, m0\n\ts_mov_b32 m0, %2\n\ts_nop 0\n\tglobal_load_lds_dwordx4 %1, off\n\ts_mov_b32 m0, %0":"=&s"(keep):"v"(gsrc),"s"(lds_dst):"memory");}
__device__ __forceinline__ float max3f(float a,float b,float c){float r;asm("v_max3_f32 %0, %1, %2, %3":"=v"(r):"v"(a),"v"(b),"v"(c));return r;}
__device__ __forceinline__ float max2f(float a,float b){float r;asm("v_max_f32_e32 %0, %1, %2":"=v"(r):"v"(a),"v"(b));return r;}
__device__ __forceinline__ float fadd_s(float a,float b){float r;asm("v_add_f32_e32 %0, %1, %2":"=v"(r):"v"(a),"v"(b));return r;}
__device__ __forceinline__ float fsub_s(float a,float b){float r;asm("v_sub_f32_e32 %0, %1, %2":"=v"(r):"v"(a),"v"(b));return r;}
typedef float f32x2_t __attribute__((ext_vector_type(2))); typedef __bf16 bf16x2_t __attribute__((ext_vector_type(2)));
__device__ __forceinline__ unsigned cvtpk_s(float lo,float hi){f32x2_t v={lo,hi};bf16x2_t b=__builtin_convertvector(v,bf16x2_t);return __builtin_bit_cast(unsigned,b);}
#define WAIT_BAR(N) asm volatile("s_waitcnt vmcnt(" #N ") lgkmcnt(0)\n\ts_barrier":::"memory")

__device__ __forceinline__ void qkt(f32x16&p0,f32x16&p1,const char*Kslot,const bf16x8*qr,const f32x16&negm0,const f32x16&negm1,int r32,int hi){
  const char*kb=Kslot+hi*1024+r32*16;
  #pragma unroll
  for(int d0=0;d0<4;++d0){
    const bf16x8 b0=*reinterpret_cast<const bf16x8*>(kb+d0*2048);
    const bf16x8 b1=*reinterpret_cast<const bf16x8*>(kb+d0*2048+512);
    if(d0==0){p0=__builtin_amdgcn_mfma_f32_32x32x16_bf16(b0,qr[0],negm0,0,0,0);p1=__builtin_amdgcn_mfma_f32_32x32x16_bf16(b1,qr[0],negm1,0,0,0);}
    else{p0=__builtin_amdgcn_mfma_f32_32x32x16_bf16(b0,qr[d0],p0,0,0,0);p1=__builtin_amdgcn_mfma_f32_32x32x16_bf16(b1,qr[d0],p1,0,0,0);}}
}
typedef __attribute__((address_space(3))) const char* lds_cptr;
typedef short v4i16_t __attribute__((ext_vector_type(4)));
__device__ __forceinline__ void kload8(bf16x8*kf,lds_cptr kp){
  kf[0]=*(const __attribute__((address_space(3))) bf16x8*)(kp);      kf[1]=*(const __attribute__((address_space(3))) bf16x8*)(kp+512);
  kf[2]=*(const __attribute__((address_space(3))) bf16x8*)(kp+2048); kf[3]=*(const __attribute__((address_space(3))) bf16x8*)(kp+2560);
  kf[4]=*(const __attribute__((address_space(3))) bf16x8*)(kp+4096); kf[5]=*(const __attribute__((address_space(3))) bf16x8*)(kp+4608);
  kf[6]=*(const __attribute__((address_space(3))) bf16x8*)(kp+6144); kf[7]=*(const __attribute__((address_space(3))) bf16x8*)(kp+6656);
}
__device__ __forceinline__ void kload2(bf16x8*kf,lds_cptr kp,int j){ kf[2*j]=*(const __attribute__((address_space(3))) bf16x8*)(kp+j*2048); kf[2*j+1]=*(const __attribute__((address_space(3))) bf16x8*)(kp+j*2048+512); }
__device__ __forceinline__ s16x4 vtr(lds_cptr p){ return __builtin_bit_cast(s16x4,__builtin_amdgcn_ds_read_tr16_b64_v4i16((__attribute__((address_space(3))) v4i16_t*)p)); }
__device__ __forceinline__ float rowmax(const f32x16&p0,const f32x16&p1){
  float a=max3f(p0[0],p0[1],p1[0]),b=max3f(p0[2],p0[3],p1[1]);a=max3f(a,p1[2],p1[3]);
  #pragma unroll
  for(int r=4;r<16;r+=4){a=max3f(a,p0[r],p0[r+1]);b=max3f(b,p0[r+2],p0[r+3]);a=max3f(a,p1[r],p1[r+1]);b=max3f(b,p1[r+2],p1[r+3]);}
  const float m=max2f(a,b);
  auto rr=__builtin_amdgcn_permlane32_swap(__float_as_uint(m),__float_as_uint(m),false,false);
  return max2f(__uint_as_float(rr[0]),__uint_as_float(rr[1]));
}
__device__ __forceinline__ void pv(f32x16*o,int vb,bf16x8 pa0,bf16x8 pa1,bf16x8 pa2,bf16x8 pa3){
  #pragma unroll
  for(int d0=0;d0<2;++d0){s16x4 lo[4],hi[4];
    #pragma unroll
    for(int ks=0;ks<4;++ks){
      asm volatile("ds_read_b64_tr_b16 %0,%1 offset:%c2":"=&v"(lo[ks]):"v"(vb),"i"(d0*4096+ks*1024):"memory");
      asm volatile("ds_read_b64_tr_b16 %0,%1 offset:%c2":"=&v"(hi[ks]):"v"(vb),"i"(d0*4096+ks*1024+512):"memory");}
    asm volatile("s_waitcnt lgkmcnt(0)":::"memory");SBAR();
    #define PK(k) (bf16x8){lo[k][0],lo[k][1],lo[k][2],lo[k][3],hi[k][0],hi[k][1],hi[k][2],hi[k][3]}
    o[d0]=__builtin_amdgcn_mfma_f32_32x32x16_bf16(pa0,PK(0),o[d0],0,0,0);
    o[d0]=__builtin_amdgcn_mfma_f32_32x32x16_bf16(pa1,PK(1),o[d0],0,0,0);
    o[d0]=__builtin_amdgcn_mfma_f32_32x32x16_bf16(pa2,PK(2),o[d0],0,0,0);
    o[d0]=__builtin_amdgcn_mfma_f32_32x32x16_bf16(pa3,PK(3),o[d0],0,0,0);
    #undef PK
  }
}

#ifndef ATTN_STORE16
#define ATTN_STORE16(p,v) (*(u32x4*)(p)=(v))
#endif
template<int THRL,bool SM> __device__ __forceinline__ void attn_unit(int b,int h,int qb,const bf16*PR,bf16*O,char*shm,const lds_fptr c2l,const int wid,const float tskip,const int rb,const bool pre,const int nb,const int nh,const int nqb,const float*cumn,const unsigned c2n_lds){
  const int qst_off=(wid<7)?(QST_HI+wid*4096):QST_W7;
  char*shmr=shm+rb;
  const bf16*Q=PR; const bf16*K=PR+1024; const bf16*V=PR+2048; const bf16*Gt=PR+3072;
  int lane_; asm volatile("v_mbcnt_lo_u32_b32 %0, -1, 0\n\tv_mbcnt_hi_u32_b32 %0, -1, %0" : "=v"(lane_)); const int lane=lane_,r32=lane&31,hi=lane>>5;
  const long rowbase=(long)b*SEQ; const int q0=qb*QB;
  const bf16*Qw=Q+(rowbase+q0+wid*QBLK)*DM+h*D;
  const bf16*Kh=K+rowbase*DM+h*D,*Vh=V+rowbase*DM+h*D;
  const unsigned lds0=(unsigned)(uintptr_t)shmr;
  float*wsf=(float*)(shm+LDS_WS)+wid*64;
  const bf16*ksrc=Kh+(long)lane*DM+wid*8;
  const bf16*vsrc=Vh+(long)(16*(wid&3)+(lane>>2))*DM+(wid>>2)*32+(lane&3)*8;
  const unsigned kdst=lds0+LDS_K+wid*1024, vdst=lds0+LDS_V+wid*1024;
  #define DMA_K(t,slot) glds16(ksrc+(long)(t)*KVBLK*DM,(unsigned)__builtin_amdgcn_readfirstlane(kdst+(slot)))
  #define DMA_V(t,slot) glds16(vsrc+(long)(t)*KVBLK*DM,(unsigned)__builtin_amdgcn_readfirstlane(vdst+(slot)))
  const char*Kbase=shmr+LDS_K; bf16x8 kf[8];
  const lds_cptr shm3=(lds_cptr)shmr; const lds_cptr kp0=shm3+LDS_K+hi*1024+r32*16; const lds_cptr vp0=shm3+LDS_V+((lane>>4)&1)*32+(lane&3)*8+(4*hi+((lane&15)>>2))*64;
  const int NT=(q0+QB)/KVBLK;
#if ATTN_SKIP
  int t0; { const float cq0_=c2l[q0]; const float ce_=(lane<NT)?c2l[KVBLK*lane+KVBLK-1]:0.f; const unsigned long long m_=__ballot((lane<NT)&&((lane>=NT-4)||(cq0_-ce_>=-tskip)));
    t0=(int)__builtin_ctzll(m_|(1ull<<(NT-4))); t0&=~1; t0=__builtin_amdgcn_readfirstlane(t0); }
#else
  const int t0=0; (void)tskip;
#endif
  if(!pre){DMA_K(t0,0);DMA_V(t0,0);DMA_K(t0+1,SLOTB);}
  bf16x8 qr[4];
  if(!pre){
  #pragma unroll
  for(int d0=0;d0<4;++d0)qr[d0]=*reinterpret_cast<const bf16x8*>(&Qw[(long)r32*DM+d0*16+hi*8]); }
  typedef __attribute__((address_space(3))) const u32x2_t* lds_u2ptr;
  const lds_u2ptr cbl=(lds_u2ptr)((lds_cptr)shm+SEAM_C2S)+r32;
  const bf16x8 bneg=(hi==0)?(bf16x8){(short)0xBF80,(short)0xBF80,(short)0xBF80,0,0,0,0,0}:(bf16x8){0,0,0,0,0,0,0,0};
  #define BIASOP(a) __builtin_bit_cast(bf16x8,(u32x4){(a)[0],(a)[1],0u,0u})
  #define BIASM(t,half) __builtin_amdgcn_mfma_f32_32x32x16_bf16(BIASOP(cbl[(t)*KVBLK+32*(half)]),bneg,negm,0,0,0)
  #define CMASK(P0,P1,t) do{int jb_=(t)-(NT-4); if(jb_>=0){ const int L2_=fresh_lane(); cmask(P0,P1,jb_,wid*QBLK+(L2_&31),L2_>>5);} }while(0)
  bool resc=false;
  #define START(P0,P1) do{ resc=false; if constexpr(!SM){ const float rm=rowmax(P0,P1); \
    { const float dl=rm; mhat=fadd_s(mhat,dl); \
      _Pragma("unroll") for(int r=0;r<16;++r){P0[r]=fsub_s(P0[r],dl);P1[r]=fsub_s(P1[r],dl);} \
      _Pragma("unroll") for(int r=0;r<16;++r)negm[r]=-mhat; asm volatile("":"+v"(negm)); } } \
    _Pragma("unroll") for(int r=0;r<16;++r)P0[r]=__builtin_amdgcn_exp2f(P0[r]); }while(0)
  #define RESC() do{ if(resc){ asm volatile("s_waitcnt lgkmcnt(0)":::"memory"); \
      const int h3_=fresh_lane()>>5; _Pragma("unroll") for(int d_=0;d_<2;++d_) _Pragma("unroll") for(int r=0;r<16;++r)o[d_][r]*=wsf[crow(r,h3_)]; } }while(0)
  f32x16 pA0,pA1,pB0,pB1;
  int sl_prev=0,sl_cur=0,sl_next=SLOTB;
  #define ROT() do{sl_prev=sl_cur;sl_cur=sl_next;sl_next=(sl_next==(NSLOT-1)*SLOTB)?0:sl_next+SLOTB;}while(0)
  if(!pre){ DMA_K(t0+2,2*SLOTB);
    WAIT_BAR(3); }
  else { WAIT_BAR(4);
    const lds_cptr qs_=(lds_cptr)shm+qst_off+r32*128+hi*16;
    #pragma unroll
    for(int d0=0;d0<4;++d0)qr[d0]=*(const __attribute__((address_space(3))) bf16x8*)(qs_+d0*32); }
  {
    const int T5_=fresh_lane()+64*wid; const f32x4a c4_=*(const __attribute__((address_space(3))) f32x4a*)((lds_cptr)shm+SEAM_C2F+16*T5_); u32x4 s0_,s1_;
    #pragma unroll
    for(int e_=0;e_<4;++e_){ const float c_=c4_[e_]; const unsigned h_=cvtpk_s(c_,0.f)&0xffffu; const float r1_=c_-__uint_as_float(h_<<16);
      const unsigned m_=cvtpk_s(r1_,0.f)&0xffffu; const float r2_=r1_-__uint_as_float(m_<<16); const unsigned l_=cvtpk_s(r2_,0.f)&0xffffu;
      if(e_<2){s0_[2*e_]=h_|(m_<<16);s0_[2*e_+1]=l_;}else{s1_[2*(e_-2)]=h_|(m_<<16);s1_[2*(e_-2)+1]=l_;} }
    __attribute__((address_space(3))) u32x4*sp_=(__attribute__((address_space(3))) u32x4*)((lds_cptr)shm+SEAM_C2S+32*T5_); sp_[0]=s0_; sp_[1]=s1_;
    asm volatile("s_waitcnt lgkmcnt(0)\n\ts_barrier":::"memory"); }
  const float cq2=c2l[q0+wid*QBLK+r32];
  float mhat=-cq2,l_reg=0.f;f32x16 o[2];o[0]=f32x16{};o[1]=f32x16{};f32x16 negm;
  const float bnd=(tskip-40.f)*0.505f+0.25f;
  _Pragma("unroll") for(int r=0;r<16;++r)negm[r]=SM?(cq2-bnd):cq2; asm volatile("":"+v"(negm));
  { const f32x16 n0_=BIASM(t0,0),n1_=BIASM(t0,1); qkt(pA0,pA1,Kbase,qr,n0_,n1_,r32,hi); } asm volatile("s_nop 15\n\ts_nop 7":"+v"(pA0),"+v"(pA1));CMASK(pA0,pA1,t0);
  START(pA0,pA1);
  _Pragma("unroll") for(int r=0;r<16;++r)pA1[r]=__builtin_amdgcn_exp2f(pA1[r]);
  WAIT_BAR(0);
  DMA_K(t0+3,0);DMA_V(t0+1,SLOTB);
  ROT();
  kload8(kf,kp0+sl_cur);
  WAIT_BAR(2);
  s16x4 vlo[8],vhi[8]; u32x4 pw0,pw1,pw2,pw3;
  #define PKW(P,B) cvtpk_s(P[B],P[B+1])
  #define PAF(k) __builtin_bit_cast(bf16x8,pw##k)
  #define VFR(i) (bf16x8){vlo[i][0],vlo[i][1],vlo[i][2],vlo[i][3],vhi[i][0],vhi[i][1],vhi[i][2],vhi[i][3]}
  #define PIN(x) asm volatile("":"+v"(x))
  #define MX3(a,b,c) __builtin_fmaxf(__builtin_fmaxf((a),(b)),(c))
  #define GAPA(MF,A0,A1,A2,A3,W0,W1,PW) do{ MF; sacc+=A0; sacc+=A1; sacc+=A2; sacc+=A3; PIN(sacc); W0; W1; PIN(PW); SBAR(); }while(0)
  #define EX(v) __builtin_amdgcn_exp2f(v)
  #define GAPB(MF,X,B) do{ MF; X[B]=EX(X[B]); X[B+1]=EX(X[B+1]); X[B+2]=EX(X[B+2]); X[B+3]=EX(X[B+3]); PIN(X); SBAR(); }while(0)
  #define VRD(i) do{ vlo[i]=vtr(vp_+(((i)>>2)*4096+((i)&3)*1024)); vhi[i]=vtr(vp_+(((i)>>2)*4096+((i)&3)*1024+512)); }while(0)
  #define KRD(G,j) do{ if(G){ kload2(kf,kp0+sl_next,j); SBAR(); } }while(0)
  #define STEP(C0,C1,P0,P1,t,GK,GV,GL) do{ SBAR(); \
    const lds_cptr vp_=vp0+sl_prev; \
    VRD(0); SBAR(); float sacc=(P0[0]+P0[1]); \
    C0=__builtin_amdgcn_mfma_f32_32x32x16_bf16(BIASOP(cbA),bneg,negm,0,0,0); C1=__builtin_amdgcn_mfma_f32_32x32x16_bf16(BIASOP(cbB),bneg,negm,0,0,0); cbA=cbl[((t)+1)*KVBLK]; cbB=cbl[((t)+1)*KVBLK+32]; SBAR(); \
    GAPA(C0=__builtin_amdgcn_mfma_f32_32x32x16_bf16(kf[0],qr[0],C0,0,0,0), P0[2],P0[3],P0[4],P0[5],     pw0[0]=PKW(P0,0), pw0[1]=PKW(P0,2), pw0); \
    VRD(4); SBAR(); GAPA(C1=__builtin_amdgcn_mfma_f32_32x32x16_bf16(kf[1],qr[0],C1,0,0,0), P0[6],P0[7],P0[8],P0[9],     pw0[2]=PKW(P0,4), pw0[3]=PKW(P0,6), pw0); \
    VRD(1); SBAR(); GAPA(C0=__builtin_amdgcn_mfma_f32_32x32x16_bf16(kf[2],qr[1],C0,0,0,0),   P0[10],P0[11],P0[12],P0[13], pw1[0]=PKW(P0,8), pw1[1]=PKW(P0,10), pw1); \
    VRD(5); SBAR(); GAPA(C1=__builtin_amdgcn_mfma_f32_32x32x16_bf16(kf[3],qr[1],C1,0,0,0),   P0[14],P0[15],P1[0],P1[1],   pw1[2]=PKW(P0,12),pw1[3]=PKW(P0,14), pw1); \
    VRD(2); SBAR(); GAPA(C0=__builtin_amdgcn_mfma_f32_32x32x16_bf16(kf[4],qr[2],C0,0,0,0),   P1[2],P1[3],P1[4],P1[5],     pw2[0]=PKW(P1,0), pw2[1]=PKW(P1,2), pw2); \
    VRD(6); SBAR(); GAPA(C1=__builtin_amdgcn_mfma_f32_32x32x16_bf16(kf[5],qr[2],C1,0,0,0),   P1[6],P1[7],P1[8],P1[9],     pw2[2]=PKW(P1,4), pw2[3]=PKW(P1,6), pw2); \
    VRD(3); SBAR(); GAPA(C0=__builtin_amdgcn_mfma_f32_32x32x16_bf16(kf[6],qr[3],C0,0,0,0),   P1[10],P1[11],P1[12],P1[13], pw3[0]=PKW(P1,8), pw3[1]=PKW(P1,10), pw3); \
    VRD(7); SBAR(); GAPA(C1=__builtin_amdgcn_mfma_f32_32x32x16_bf16(kf[7],qr[3],C1,0,0,0),   P1[14],P1[15],0.f,0.f,       pw3[2]=PKW(P1,12),pw3[3]=PKW(P1,14), pw3); \
    l_reg+=sacc; \
    if(GK){DMA_K((t)+3,sl_cur);} if(GV){DMA_V((t)+1,sl_next);} \
    CMASK(C0,C1,t); \
    if constexpr(!SM){ float a=MX3(C0[0],C0[1],C1[0]),b=MX3(C0[2],C0[3],C1[1]); a=MX3(a,C1[2],C1[3]); \
      _Pragma("unroll") for(int r=4;r<16;r+=4){a=MX3(a,C0[r],C0[r+1]);b=MX3(b,C0[r+2],C0[r+3]);a=MX3(a,C1[r],C1[r+1]);b=MX3(b,C1[r+2],C1[r+3]);} \
      float rm=__builtin_fmaxf(a,b); { auto rr=__builtin_amdgcn_permlane32_swap(__float_as_uint(rm),__float_as_uint(rm),false,false); rm=__builtin_fmaxf(__uint_as_float(rr[0]),__uint_as_float(rr[1])); } \
      resc=false; \
      if(__builtin_expect(__any(rm>(float)THRL),0)){ const float dl=__builtin_fmaxf(rm,0.f); mhat+=dl; \
        _Pragma("unroll") for(int r=0;r<16;++r){C0[r]-=dl;C1[r]-=dl;} \
        _Pragma("unroll") for(int r=0;r<16;++r)negm[r]=-mhat; asm volatile("":"+v"(negm)); \
        const float f=__builtin_amdgcn_exp2f(-dl); l_reg*=f; { const int L3_=fresh_lane(); if((L3_>>5)==0)wsf[L3_&31]=f; } resc=true; } } \
    SBAR(); \
    GAPB(o[0]=__builtin_amdgcn_mfma_f32_32x32x16_bf16(PAF(0),VFR(0),o[0],0,0,0), C0,0); \
    GAPB(o[1]=__builtin_amdgcn_mfma_f32_32x32x16_bf16(PAF(0),VFR(4),o[1],0,0,0), C0,4); \
    KRD(GL,0); GAPB(o[0]=__builtin_amdgcn_mfma_f32_32x32x16_bf16(PAF(1),VFR(1),o[0],0,0,0), C0,8); \
    KRD(GL,1); GAPB(o[1]=__builtin_amdgcn_mfma_f32_32x32x16_bf16(PAF(1),VFR(5),o[1],0,0,0), C0,12); \
    KRD(GL,2); GAPB(o[0]=__builtin_amdgcn_mfma_f32_32x32x16_bf16(PAF(2),VFR(2),o[0],0,0,0), C1,0); \
    KRD(GL,3); GAPB(o[1]=__builtin_amdgcn_mfma_f32_32x32x16_bf16(PAF(2),VFR(6),o[1],0,0,0), C1,4); \
    GAPB(o[0]=__builtin_amdgcn_mfma_f32_32x32x16_bf16(PAF(3),VFR(3),o[0],0,0,0), C1,8); \
    GAPB(o[1]=__builtin_amdgcn_mfma_f32_32x32x16_bf16(PAF(3),VFR(7),o[1],0,0,0), C1,12); \
    }while(0)
  u32x2_t cbA=cbl[(t0+1)*KVBLK],cbB=cbl[(t0+1)*KVBLK+32];
  int t=t0+1;
  #undef CMASK
  #define CMASK(P0,P1,t) do{}while(0)
  for(;t+5<NT;t+=2){
    STEP(pB0,pB1,pA0,pA1,t,true,true,true);     WAIT_BAR(2); RESC(); ROT();
    STEP(pA0,pA1,pB0,pB1,t+1,true,true,true);   WAIT_BAR(2); RESC(); ROT();
  }
  #undef CMASK
  #define CMASK(P0,P1,t) do{int jb_=(t)-(NT-4); if(jb_>=0){ const int L2_=fresh_lane(); cmask(P0,P1,jb_,wid*QBLK+(L2_&31),L2_>>5);} }while(0)
  #define ENDW(tt) do{ if((tt)+3<NT){WAIT_BAR(2);} else if((tt)+2<NT){WAIT_BAR(1);} else {WAIT_BAR(0);} }while(0)
  for(;t+1<NT;t+=2){
    STEP(pB0,pB1,pA0,pA1,t,(t+3<NT),(t+1<NT),(t+1<NT));       ENDW(t);   RESC(); ROT();
    STEP(pA0,pA1,pB0,pB1,t+1,(t+4<NT),(t+2<NT),(t+2<NT));     ENDW(t+1); RESC(); ROT();
  }
  if(nb>=0){ const int L5_=fresh_lane();
    const bf16*ksn=K+((long)nb*SEQ+L5_)*DM+nh*D+wid*8; const bf16*vsn=V+((long)nb*SEQ+16*(wid&3)+(L5_>>2))*DM+nh*D+(wid>>2)*32+(L5_&3)*8;
    const unsigned l0n=(unsigned)(uintptr_t)(shm+(RING_SET-rb)), kdn=l0n+LDS_K+wid*1024, vdn=l0n+LDS_V+wid*1024;
    glds16(ksn,(unsigned)__builtin_amdgcn_readfirstlane(kdn)); glds16(vsn,(unsigned)__builtin_amdgcn_readfirstlane(vdn));
    glds16(ksn+(long)KVBLK*DM,(unsigned)__builtin_amdgcn_readfirstlane(kdn+SLOTB)); glds16(ksn+2L*KVBLK*DM,(unsigned)__builtin_amdgcn_readfirstlane(kdn+2*SLOTB));
    glds16(cumn+4*(wid*64+L5_),(unsigned)__builtin_amdgcn_readfirstlane(c2n_lds+wid*1024));
    const bf16*qsn=Q+((long)nb*SEQ+nqb*QB+wid*QBLK+(L5_>>3))*DM+nh*D+(L5_&7)*8; const unsigned qdn=(unsigned)(uintptr_t)(shm+qst_off);
    #pragma unroll
    for(int j=0;j<4;++j)glds16(qsn+(long)(8*j)*DM,(unsigned)__builtin_amdgcn_readfirstlane(qdn+j*1024)); }
  STEP(pB0,pB1,pA0,pA1,NT-1,false,false,false); RESC();
  { float sacc=pB0[0]+pB0[1]; _Pragma("unroll") for(int r=2;r<16;++r)sacc+=pB0[r]; _Pragma("unroll") for(int r=0;r<16;++r)sacc+=pB1[r]; l_reg+=sacc;
    pw0=(u32x4){PKW(pB0,0),PKW(pB0,2),PKW(pB0,4),PKW(pB0,6)};pw1=(u32x4){PKW(pB0,8),PKW(pB0,10),PKW(pB0,12),PKW(pB0,14)};pw2=(u32x4){PKW(pB1,0),PKW(pB1,2),PKW(pB1,4),PKW(pB1,6)};pw3=(u32x4){PKW(pB1,8),PKW(pB1,10),PKW(pB1,12),PKW(pB1,14)};
    SBAR(); { const int L4_=fresh_lane(); const int vb1_=(int)(lds0+LDS_V)+((L4_>>4)&1)*32+(L4_&3)*8+(4*(L4_>>5)+((L4_&15)>>2))*64; pv(o,vb1_+sl_cur,PAF(0),PAF(1),PAF(2),PAF(3)); } }
  #undef PKW
  #undef PAF
  #undef VFR
  #undef PIN
  #undef MX3
  #undef GAPA
  #undef GAPB
  #undef EX
  #undef VRD
  #undef KRD
  #undef STEP
  #undef ENDW
  int eL; asm volatile("v_mbcnt_lo_u32_b32 %0, -1, 0\n\tv_mbcnt_hi_u32_b32 %0, -1, %0" : "=v"(eL)); const int eR=eL&31,eH=eL>>5;
  const bf16*Gw=Gt+(rowbase+q0+wid*QBLK)*DM+h*D; u32x4 ggv[4];
  #pragma unroll
  for(int i=0;i<4;++i)ggv[i]=*(const u32x4*)(Gw+(long)(i*8+(eL>>3))*DM+(eL&7)*8);
  {auto rr=__builtin_amdgcn_permlane32_swap(__float_as_uint(l_reg),__float_as_uint(l_reg),false,false);l_reg=__uint_as_float(rr[0])+__uint_as_float(rr[1]);}
  if(eH==0)wsf[32+eR]=l_reg;asm volatile("s_waitcnt lgkmcnt(0)":::"memory");
  float rli[16];
  #pragma unroll
  for(int r=0;r<16;++r)rli[r]=__builtin_amdgcn_rcpf(wsf[32+crow(r,eH)]);
  bf16*Ow=O+(rowbase+q0+wid*QBLK)*PO+h*D;
  asm volatile("s_waitcnt lgkmcnt(0)\n\ts_barrier":::"memory");
  { bf16*stg=(bf16*)(shmr)+wid*2048;
    #pragma unroll
    for(int r=0;r<16;++r){const int orow=crow(r,eH);
      #pragma unroll
      for(int d0=0;d0<2;++d0)stg[orow*64+d0*32+eR]=__float2bfloat16(o[d0][r]*rli[r]);}
    asm volatile("s_waitcnt lgkmcnt(0)":::"memory");
    #pragma unroll
    for(int i=0;i<4;++i){const int row=i*8+(eL>>3),ch=eL&7; const u32x4 v=*(const u32x4*)(stg+row*64+ch*8); const u32x4 gg=ggv[i]; u32x4 w;
      #pragma unroll
      for(int e=0;e<4;++e){ const float o0=__uint_as_float(v[e]<<16),o1=__uint_as_float(v[e]&0xffff0000u),g0=__uint_as_float(gg[e]<<16),g1=__uint_as_float(gg[e]&0xffff0000u);
        const float s0=g0*__builtin_amdgcn_rcpf(1.f+__builtin_amdgcn_exp2f(-1.4426950408889634f*g0)),s1=g1*__builtin_amdgcn_rcpf(1.f+__builtin_amdgcn_exp2f(-1.4426950408889634f*g1)); w[e]=cvtpk_s(o0*s0,o1*s1);}
      ATTN_STORE16(Ow+(long)row*PO+ch*8,w);} }
  asm volatile("s_waitcnt lgkmcnt(0)\n\ts_barrier":::"memory");
  #undef DMA_K
  #undef DMA_V
  #undef CMASK
  #undef START
  #undef RESC
  #undef ROT
  #undef BIASM
  #undef BIASOP
}
constexpr int ATTN_LDS_BYTES=LDS_BYTES;
struct AttnTensors { const bf16* PR; bf16* O; const float* cum; const float* tsk; };
struct AttnUnit { int bh; int qb; };
constexpr int C2_OFF=2048, SCAN_OFF=0;
constexpr int ATTN_LDS_TOTAL=LDS_BYTES;
__device__ __forceinline__ void build_c2(const float*logf,int b,int h,char*shm,int wid){
  int lane_; asm volatile("v_mbcnt_lo_u32_b32 %0, -1, 0\n\tv_mbcnt_hi_u32_b32 %0, -1, %0" : "=v"(lane_)); const int lane=lane_,tid=wid*64+lane;
  float*tot=(float*)(shm+SCAN_OFF); float*c2=(float*)(shm+C2_OFF);
  float l4[4]; { float run=0.f;
    #pragma unroll
    for(int i=0;i<4;++i){ run+=logf[((long)b*SEQ+4*tid+i)*16+h]; l4[i]=run; } tot[tid]=run; }
  __syncthreads();
  if(wid==0){ float run=0.f; float e[8];
    #pragma unroll
    for(int i=0;i<8;++i){ e[i]=run; run+=tot[8*lane+i]; }
    float inc=run;
    #pragma unroll
    for(int o=1;o<64;o<<=1){ const float y=__builtin_bit_cast(float,__builtin_amdgcn_ds_bpermute((lane-o)<<2,__builtin_bit_cast(int,inc))); if(lane>=o)inc+=y; }
    const float excl=inc-run;
    #pragma unroll
    for(int i=0;i<8;++i)tot[8*lane+i]=excl+e[i]; }
  __syncthreads();
  { const float off=tot[tid];
    #pragma unroll
    for(int i=0;i<4;++i)c2[4*tid+i]=(off+l4[i])*1.4426950408889634f; }
  __syncthreads();
}
__device__ __forceinline__ void c2_phase(const float*logf,const float*qg,const float*kg,float*cum,float*tsk,char*lds,int G,int c,int wid){
  int lane_; asm volatile("v_mbcnt_lo_u32_b32 %0, -1, 0\n\tv_mbcnt_hi_u32_b32 %0, -1, %0" : "=v"(lane_)); const int tid=wid*64+lane_;
  for(int bh=c;bh<BATCH*NHEAD;bh+=G){ build_c2(logf,bh/NHEAD,bh%NHEAD,lds,wid);
    *(f32x4a*)(cum+(long)bh*SEQ+4*tid)=*(const f32x4a*)((const float*)(lds+C2_OFF)+4*tid); __syncthreads(); }
  if(wid==0){ float a=fabsf(qg[lane_]),k=fabsf(kg[lane_]);
    #pragma unroll
    for(int o=1;o<64;o<<=1){ a=fmaxf(a,__builtin_bit_cast(float,__builtin_amdgcn_ds_bpermute((lane_^o)<<2,__builtin_bit_cast(int,a)))); k=fmaxf(k,__builtin_bit_cast(float,__builtin_amdgcn_ds_bpermute((lane_^o)<<2,__builtin_bit_cast(int,k)))); }
    if(lane_==0)*tsk=40.f+2.f*64.f*a*k*C2; }
}
__device__ __forceinline__ void load_c2(const float*cum,int bh,char*lds,int wid,int dst_off){
  int lane_; asm volatile("v_mbcnt_lo_u32_b32 %0, -1, 0\n\tv_mbcnt_hi_u32_b32 %0, -1, %0" : "=v"(lane_)); const int tid=wid*64+lane_;
  *(f32x4a*)((float*)(lds+dst_off)+4*tid)=*(const f32x4a*)(cum+(long)bh*SEQ+4*tid); __syncthreads();
}
template<int THRL,bool SM> __device__ __forceinline__ void attn_phase_t(char*lds,const AttnTensors&T,int G,int c,int wid,const float tskip){
  if(G==256){ const int x=c&7,li=c>>3,g4=li>>3,u=li&7,gid=8*g4+x;
    for(int r=0;r<8;++r){ const int b=8*(gid>>4)+r,h=(gid+r)&15,qb=(u+r)&7; const int par=r&1;
      if(r==0)load_c2(T.cum,b*NHEAD+h,lds,wid,SEAM_C2F);
      const int nb=(r<7)?8*(gid>>4)+r+1:-1,nh=(gid+r+1)&15;
      attn_unit<THRL,SM>(b,h,qb,T.PR,T.O,lds,(lds_fptr)(lds+SEAM_C2F),wid,tskip,par*RING_SET,r>0,nb,nh,(u+r+1)&7,T.cum+(long)((nb<0?0:nb)*NHEAD+nh)*SEQ,(unsigned)(uintptr_t)(lds+SEAM_C2F)); }
    return; }
  for(int it=c;it<BATCH*NHEAD*NQB;it+=G){ const int bh=it%(BATCH*NHEAD),qb=it/(BATCH*NHEAD);
    load_c2(T.cum,bh,lds,wid,SEAM_C2F);
    attn_unit<THRL,SM>(bh/NHEAD,bh%NHEAD,qb,T.PR,T.O,lds,(lds_fptr)(lds+SEAM_C2F),wid,tskip,0,false,-1,0,0,T.cum,0u); }
}
template<int THRL=8> __device__ __forceinline__ void attn_phase(char*lds,const AttnTensors&T,int G,int c,int wid){
  const float tskip=*T.tsk;
  if((tskip-40.f)*0.5f<=ATTN_SM_MAX) attn_phase_t<THRL,true>(lds,T,G,c,wid,tskip); else attn_phase_t<THRL,false>(lds,T,G,c,wid,tskip);
}
#undef SBAR
#undef WAIT_BAR
}
namespace gla {
typedef unsigned short bf16;
typedef short bf16x8 __attribute__((ext_vector_type(8)));
typedef float f32x4 __attribute__((ext_vector_type(4)));
typedef unsigned u32x2 __attribute__((ext_vector_type(2)));
typedef unsigned u32x4 __attribute__((ext_vector_type(4)));
#define GLA_LAS __attribute__((address_space(3)))
constexpr int SEQ_ = 2048, PITCH = 3328;
struct Bufs { const bf16* PROJ; const float* AUX; bf16* QIF; bf16* KDF; bf16* AF; unsigned long long* GRAN; float* DCH; bf16* OG; unsigned tag; const float* wa2; const float* ba; const float* ogain; };
__device__ __forceinline__ int lane_v() { int l; asm volatile("v_mbcnt_lo_u32_b32 %0, -1, 0\n\tv_mbcnt_hi_u32_b32 %0, -1, %0" : "=v"(l)); return l; }
__device__ __forceinline__ float b2f(bf16 b) { return __uint_as_float((unsigned)b << 16); }
typedef float f32x2g __attribute__((ext_vector_type(2))); typedef __bf16 bf16x2g __attribute__((ext_vector_type(2)));
__device__ __forceinline__ unsigned pk(float lo, float hi) { f32x2g v = {lo, hi}; bf16x2g b = __builtin_convertvector(v, bf16x2g); return __builtin_bit_cast(unsigned, b); }
__device__ __forceinline__ float logsig(float z) { return fminf(z, 0.f) - 0.6931471805599453f * __builtin_amdgcn_logf(1.f + __builtin_amdgcn_exp2f(-1.4426950408889634f * fabsf(z))); }
__device__ __forceinline__ float exp_f(float x) { return __builtin_amdgcn_exp2f(1.4426950408889634f * x); }
#define GLA_ROR(x, n) __builtin_bit_cast(float, __builtin_amdgcn_update_dpp(0, __builtin_bit_cast(int, x), 0x120 + (n), 0xf, 0xf, true))
__device__ __forceinline__ float row16_sum(float x) { x += GLA_ROR(x, 8); x += GLA_ROR(x, 4); x += GLA_ROR(x, 2); x += GLA_ROR(x, 1); return x; }
__device__ __forceinline__ float silu_f(float x) { return x * __builtin_amdgcn_rcpf(1.f + __builtin_amdgcn_exp2f(-1.4426950408889634f * x)); }

__device__ __forceinline__ void pre_phase(const Bufs& B, GLA_LAS unsigned char* lds, const int wave) {
    const int lane = lane_v(), tid = wave * 64 + lane, d = tid & 127, tq = wave >> 1, g = lane >> 4, fr = lane & 15;
    GLA_LAS bf16* qs = (GLA_LAS bf16*)lds;
    GLA_LAS bf16* ks = qs + 8192;
    GLA_LAS float* tot = (GLA_LAS float*)(lds + 32768);
    GLA_LAS float* als = (GLA_LAS float*)(lds + 34816);
    f32x4 als_n = {0.f, 0.f, 0.f, 0.f}; bf16 qn[16], kn[16];
#define GLA_PRELOAD(it_) do { const int bh_ = (it_) & 63, n_ = (it_) >> 6, b_ = bh_ >> 2, h_ = bh_ & 3; const size_t r0_ = (size_t)b_ * SEQ_ + n_ * 64; \
        if (tid < 256) als_n = *(const f32x4*)(B.AUX + r0_ * 16 + 4 * tid); \
        _Pragma("unroll") for (int tt_ = 0; tt_ < 16; ++tt_) { const size_t row_ = r0_ + tq * 16 + tt_; qn[tt_] = B.PROJ[row_ * PITCH + h_ * 128 + d]; kn[tt_] = B.PROJ[row_ * PITCH + 512 + h_ * 128 + d]; } } while (0)
    if ((int)blockIdx.x < 2048) GLA_PRELOAD((int)blockIdx.x);
    for (int it = blockIdx.x; it < 2048; it += gridDim.x) {
        const int bh = it & 63, n = it >> 6, b = bh >> 2, h = bh & 3; const size_t cid = (size_t)bh * 32 + n;
        float w2[16];
#pragma unroll
        for (int r = 0; r < 16; ++r) w2[r] = B.wa2[(size_t)r * 512 + h * 128 + d];
        const float bav = B.ba[h * 128 + d];
        if (tid < 256) *(GLA_LAS f32x4*)(als + 4 * tid) = als_n;
        bf16 qc[16], kc[16];
#pragma unroll
        for (int tt = 0; tt < 16; ++tt) { qc[tt] = qn[tt]; kc[tt] = kn[tt]; }
        asm volatile("s_waitcnt lgkmcnt(0)\n\ts_barrier" ::: "memory");
        if (it + (int)gridDim.x < 2048) GLA_PRELOAD(it + (int)gridDim.x);
        float la[16]; float run = 0.f;
#pragma unroll
        for (int tt = 0; tt < 16; ++tt) { const GLA_LAS f32x4* ar = (const GLA_LAS f32x4*)(als + (tq * 16 + tt) * 16); float z = bav;
#pragma unroll
            for (int r4 = 0; r4 < 4; ++r4) { const f32x4 a4 = ar[r4]; z += a4[0] * w2[4 * r4] + a4[1] * w2[4 * r4 + 1] + a4[2] * w2[4 * r4 + 2] + a4[3] * w2[4 * r4 + 3]; }
            run += logsig(z) * 0.0625f; la[tt] = run; }
        tot[tq * 128 + d] = run;
        asm volatile("s_waitcnt lgkmcnt(0)\n\ts_barrier" ::: "memory");
        float off = 0.f, total = 0.f;
#pragma unroll
        for (int q4 = 0; q4 < 4; ++q4) { const float v = tot[q4 * 128 + d]; if (q4 < tq) off += v; total += v; }
        const float dch = exp_f(total);
        unsigned kd[8];
#pragma unroll
        for (int tt = 0; tt < 16; tt += 2) { float kdv[2];
#pragma unroll
            for (int u = 0; u < 2; ++u) { const int t = tq * 16 + tt + u; const float cum = off + la[tt + u];
                const float e1 = exp_f(cum), e2 = exp_f(-cum);
                const float qv = b2f(qc[tt + u]), kv = b2f(kc[tt + u]);
                const float ki = kv * e2; kdv[u] = ki * dch;
                const int a = t * 128 + (((d >> 3) ^ (t & 15)) * 8) + (d & 7);
                qs[a] = (bf16)(pk(qv * e1, 0.f) & 0xffffu); ks[a] = (bf16)(pk(ki, 0.f) & 0xffffu); }
            kd[tt >> 1] = pk(kdv[0], kdv[1]); }
        { const int ksb = tq >> 1, g0 = 2 * (tq & 1); bf16* base = B.KDF + cid * 8192 + (size_t)((d >> 4) * 2 + ksb) * 512;
          *(u32x4*)(base + ((d & 15) + 16 * g0) * 8) = (u32x4){kd[0], kd[1], kd[2], kd[3]};
          *(u32x4*)(base + ((d & 15) + 16 * (g0 + 1)) * 8) = (u32x4){kd[4], kd[5], kd[6], kd[7]}; }
        if (tq == 0) B.DCH[cid * 128 + d] = dch;
        asm volatile("s_waitcnt lgkmcnt(0)\n\ts_barrier" ::: "memory");
#pragma unroll
        for (int u = 0; u < 2; ++u) { const int tile = 2 * wave + u, a = tile >> 2, b2 = tile & 3; f32x4 acc = {0.f, 0.f, 0.f, 0.f};
            const int ra = 16 * a + fr, rb = 16 * b2 + fr;
#pragma unroll
            for (int k2 = 0; k2 < 4; ++k2) { const int c = 4 * k2 + g;
                const bf16x8 af = *(const GLA_LAS bf16x8*)(ks + ra * 128 + ((c ^ (ra & 15)) * 8));
                const bf16x8 bf_ = *(const GLA_LAS bf16x8*)(qs + rb * 128 + ((c ^ (rb & 15)) * 8));
                acc = __builtin_amdgcn_mfma_f32_16x16x32_bf16(af, bf_, acc, 0, 0, 0); }
            const int t = 16 * b2 + fr; float m[4];
#pragma unroll
            for (int r = 0; r < 4; ++r) { const int tp = 16 * a + 4 * g + r; m[r] = (tp <= t) ? acc[r] : 0.f; }
            const int lp = fr + 16 * (2 * (a & 1) + (g >> 1));
            *(u32x2*)(B.AF + cid * 4096 + (size_t)(b2 * 2 + (a >> 1)) * 512 + lp * 8 + 4 * (g & 1)) = (u32x2){pk(m[0], m[1]), pk(m[2], m[3])}; }
#pragma unroll
        for (int u = 0; u < 2; ++u) { const int e = tid + 512 * u, bq = e >> 6, l = e & 63, i = bq >> 2, k2 = bq & 3, t = 16 * i + (l & 15), gg = l >> 4;
            const int d0 = 32 * k2 + 4 * gg, c0 = d0 >> 3, sub = d0 & 7;
            const u32x2 p0 = *(const GLA_LAS u32x2*)(qs + t * 128 + ((c0 ^ (t & 15)) * 8) + sub);
            const u32x2 p1 = *(const GLA_LAS u32x2*)(qs + t * 128 + (((c0 + 2) ^ (t & 15)) * 8) + sub);
            *(u32x4*)(B.QIF + cid * 8192 + (size_t)bq * 512 + l * 8) = (u32x4){p0.x, p0.y, p1.x, p1.y}; }
        asm volatile("s_waitcnt lgkmcnt(0)\n\ts_barrier" ::: "memory");
    }
#undef GLA_PRELOAD
}

typedef short s16x4 __attribute__((ext_vector_type(4)));
__device__ __forceinline__ s16x4 vtr(const GLA_LAS unsigned char* p) { return __builtin_bit_cast(s16x4, __builtin_amdgcn_ds_read_tr16_b64_v4i16((GLA_LAS s16x4*)p)); }
__device__ __forceinline__ void glds16(const void* gsrc, unsigned lds_dst) { unsigned keep;
    asm volatile("s_mov_b32 %0, m0\n\ts_mov_b32 m0, %2\n\ts_nop 0\n\tglobal_load_lds_dwordx4 %1, off\n\ts_mov_b32 m0, %0" : "=&s"(keep) : "v"(gsrc), "s"(lds_dst) : "memory"); }
constexpr int CORE_BUF = 50176, OBUF_OFF = 2 * CORE_BUF, OBUF1_OFF = 139776, OST = 68;
#define GLA_QP(x, ctl) __builtin_bit_cast(float, __builtin_amdgcn_update_dpp(0, __builtin_bit_cast(int, x), ctl, 0xf, 0xf, true))
__device__ __forceinline__ void core_phase(const Bufs& B, GLA_LAS unsigned char* lds, const int wave) {
    const int lane = lane_v(), tid = wave * 64 + lane, j = lane & 15, g = lane >> 4, jt = wave & 3, th = wave >> 2;
    const int er = tid >> 3, ec = tid & 7;
    const unsigned lds0 = (unsigned)(size_t)lds;
    GLA_LAS float* obuf0 = (GLA_LAS float*)(lds + OBUF_OFF); GLA_LAS float* obuf1 = (GLA_LAS float*)(lds + OBUF1_OFF);
    for (int it = blockIdx.x; it < 256; it += gridDim.x) {
        const int s = (it >> 3) & 3, bh = (it & 7) + 8 * (it >> 5), b = bh >> 2, h = bh & 3;
        const int ecol = h * 256 + s * 64 + 8 * ec;
        f32x4 gn0 = *(const f32x4*)(B.ogain + s * 64 + 8 * ec), gn1 = *(const f32x4*)(B.ogain + s * 64 + 8 * ec + 4);
        f32x4 S[8];
#pragma unroll
        for (int dt = 0; dt < 8; ++dt) S[dt] = (f32x4){0.f, 0.f, 0.f, 0.f};
#define GLA_STAGE(c) do { const size_t cid_ = (size_t)bh * 32 + (c); const unsigned dst_ = lds0 + ((c) & 1) * CORE_BUF + wave * 1024; \
            glds16(B.KDF + cid_ * 8192 + (size_t)wave * 512 + lane * 8,        (unsigned)__builtin_amdgcn_readfirstlane(dst_)); \
            glds16(B.KDF + cid_ * 8192 + (size_t)(wave + 8) * 512 + lane * 8,  (unsigned)__builtin_amdgcn_readfirstlane(dst_ + 8192)); \
            glds16(B.QIF + cid_ * 8192 + (size_t)wave * 512 + lane * 8,        (unsigned)__builtin_amdgcn_readfirstlane(dst_ + 16384)); \
            glds16(B.QIF + cid_ * 8192 + (size_t)(wave + 8) * 512 + lane * 8,  (unsigned)__builtin_amdgcn_readfirstlane(dst_ + 24576)); \
            glds16(B.AF + cid_ * 4096 + (size_t)wave * 512 + lane * 8,         (unsigned)__builtin_amdgcn_readfirstlane(dst_ + 32768)); \
            glds16(B.PROJ + ((size_t)b * SEQ_ + (c) * 64 + 8 * wave + (lane >> 3)) * PITCH + 1024 + h * 256 + s * 64 + 8 * (lane & 7), (unsigned)__builtin_amdgcn_readfirstlane(dst_ + 40960)); \
            if (wave == 7) glds16((const unsigned char*)(B.DCH + cid_ * 128) + lane * 16, (unsigned)__builtin_amdgcn_readfirstlane(lds0 + ((c) & 1) * CORE_BUF + 49152)); } while (0)
#define GLA_REGLOAD(c, GR) do { const size_t rowb_ = (size_t)b * SEQ_ + (c) * 64; \
            GR = *(const u32x4*)(B.PROJ + (rowb_ + er) * PITCH + 2048 + ecol); } while (0)
#define GLA_EPI_A(c, GV, VAL, QOWN) do { const GLA_LAS float* ob_ = ((c) & 1) ? obuf1 : obuf0; const f32x4 o0_ = *(const GLA_LAS f32x4*)(ob_ + er * OST + 8 * ec), o1_ = *(const GLA_LAS f32x4*)(ob_ + er * OST + 8 * ec + 4); float q_ = 0.f; \
            _Pragma("unroll") for (int e_ = 0; e_ < 4; ++e_) { const float ga_ = __uint_as_float(GV[e_] << 16), gb_ = __uint_as_float(GV[e_] & 0xffff0000u); \
                const float oa_ = (e_ < 2) ? o0_[2 * e_] : o1_[2 * e_ - 4], ob_ = (e_ < 2) ? o0_[2 * e_ + 1] : o1_[2 * e_ - 3]; \
                const float na_ = (e_ < 2) ? gn0[2 * e_] : gn1[2 * e_ - 4], nb_ = (e_ < 2) ? gn0[2 * e_ + 1] : gn1[2 * e_ - 3]; \
                q_ += oa_ * oa_ + ob_ * ob_; VAL[2 * e_] = oa_ * na_ * silu_f(ga_); VAL[2 * e_ + 1] = ob_ * nb_ * silu_f(gb_); } \
            q_ += GLA_QP(q_, 0xB1); q_ += GLA_QP(q_, 0x4E); q_ += GLA_QP(q_, 0x141);     \
            QOWN = q_; \
            if (ec == 0) __hip_atomic_store(B.GRAN + (((size_t)bh * 32 + (c)) * 4 + s) * 64 + er, ((unsigned long long)B.tag << 32) | (unsigned long long)__float_as_uint(q_), __ATOMIC_RELAXED, __HIP_MEMORY_SCOPE_AGENT); } while (0)
#define GLA_GLOAD(c, XG) do { unsigned long long* gp_ = B.GRAN + ((size_t)bh * 32 + (c)) * 256 + er; \
            _Pragma("unroll") for (int p_ = 0; p_ < 3; ++p_) XG[p_] = __hip_atomic_load(gp_ + ((s + 1 + p_) & 3) * 64, __ATOMIC_RELAXED, __HIP_MEMORY_SCOPE_AGENT); } while (0)
#define GLA_EPI_B(c, VAL, QOWN, XG) do { const size_t row_ = (size_t)b * SEQ_ + (c) * 64 + er; unsigned sp_ = 0; \
            while (!__all(((unsigned)(XG[0] >> 32) == B.tag) & ((unsigned)(XG[1] >> 32) == B.tag) & ((unsigned)(XG[2] >> 32) == B.tag)) && ++sp_ < (1u << 22)) { __builtin_amdgcn_s_sleep(1); GLA_GLOAD(c, XG); } \
            const float tot_ = QOWN + __uint_as_float((unsigned)XG[0]) + __uint_as_float((unsigned)XG[1]) + __uint_as_float((unsigned)XG[2]); \
            const float rstd_ = rsqrtf(tot_ * (1.f / 256.f) + 1e-6f); u32x4 w_; \
            _Pragma("unroll") for (int e_ = 0; e_ < 4; ++e_) w_[e_] = pk(VAL[2 * e_] * rstd_, VAL[2 * e_ + 1] * rstd_); \
            *(u32x4*)(B.OG + row_ * 1024 + ecol) = w_; } while (0)
        u32x4 gr;
        asm volatile("s_waitcnt lgkmcnt(0)\n\ts_barrier" ::: "memory");
        GLA_STAGE(0); GLA_REGLOAD(0, gr);
        u32x4 gprev = gr; float valp[8], qp = 0.f;
        for (int n = 0; n < 32; ++n) {
            asm volatile("s_waitcnt vmcnt(1) lgkmcnt(0)\n\ts_barrier" ::: "memory");
            const u32x4 gcur = gr;
            if (n + 1 < 32) { GLA_STAGE(n + 1); GLA_REGLOAD(n + 1, gr); }
            unsigned long long xg[3] = {0ull, 0ull, 0ull}; if (n > 1) GLA_GLOAD(n - 2, xg);
            float valn[8], qn = 0.f;
            if (n > 0) GLA_EPI_A(n - 1, gprev, valn, qn);
            gprev = gcur;
            const GLA_LAS unsigned char* buf = lds + (n & 1) * CORE_BUF + lane * 16;
            const GLA_LAS unsigned char* vb = lds + (n & 1) * CORE_BUF + 40960 + (8 * g + ((lane & 15) >> 2)) * 128 + (16 * jt + 4 * (lane & 3)) * 2;
            const s16x4 t00 = vtr(vb), t01 = vtr(vb + 512), t10 = vtr(vb + 4096), t11 = vtr(vb + 4096 + 512);
            const bf16x8 vf0 = (bf16x8){t00[0], t00[1], t00[2], t00[3], t01[0], t01[1], t01[2], t01[3]}, vf1 = (bf16x8){t10[0], t10[1], t10[2], t10[3], t11[0], t11[1], t11[2], t11[3]};
            u32x4 sb[4];
#pragma unroll
            for (int k2 = 0; k2 < 4; ++k2) sb[k2] = (u32x4){pk(S[2 * k2][0], S[2 * k2][1]), pk(S[2 * k2][2], S[2 * k2][3]), pk(S[2 * k2 + 1][0], S[2 * k2 + 1][1]), pk(S[2 * k2 + 1][2], S[2 * k2 + 1][3])};
#pragma unroll
            for (int dt = 0; dt < 8; ++dt) { S[dt] = S[dt] * *(const GLA_LAS f32x4*)(lds + (n & 1) * CORE_BUF + 49152 + (16 * dt + 4 * g) * 4);
                { const bf16x8 kd = *(const GLA_LAS bf16x8*)(buf + (dt * 2) * 1024); S[dt] = __builtin_amdgcn_mfma_f32_16x16x32_bf16(kd, vf0, S[dt], 0, 0, 0); }
                { const bf16x8 kd = *(const GLA_LAS bf16x8*)(buf + (dt * 2 + 1) * 1024); S[dt] = __builtin_amdgcn_mfma_f32_16x16x32_bf16(kd, vf1, S[dt], 0, 0, 0); } }
            f32x4 ov[2];
#pragma unroll
            for (int i = 0; i < 2; ++i) { const int ti = 2 * th + i; f32x4 o = {0.f, 0.f, 0.f, 0.f};
#pragma unroll
                for (int k2 = 0; k2 < 4; ++k2) { const bf16x8 qf = *(const GLA_LAS bf16x8*)(buf + 16384 + (ti * 4 + k2) * 1024); o = __builtin_amdgcn_mfma_f32_16x16x32_bf16(qf, __builtin_bit_cast(bf16x8, sb[k2]), o, 0, 0, 0); }
                { const bf16x8 a0 = *(const GLA_LAS bf16x8*)(buf + 32768 + (ti * 2) * 1024); o = __builtin_amdgcn_mfma_f32_16x16x32_bf16(a0, vf0, o, 0, 0, 0); }
                if (th == 1) { const bf16x8 a1 = *(const GLA_LAS bf16x8*)(buf + 32768 + (ti * 2 + 1) * 1024); o = __builtin_amdgcn_mfma_f32_16x16x32_bf16(a1, vf1, o, 0, 0, 0); }
                ov[i] = o; }
            { GLA_LAS float* obw = (n & 1) ? obuf1 : obuf0;
#pragma unroll
              for (int i = 0; i < 2; ++i)
#pragma unroll
                for (int r = 0; r < 4; ++r) obw[(16 * (2 * th + i) + 4 * g + r) * OST + 16 * jt + j] = ov[i][r]; }
            if (n > 1) GLA_EPI_B(n - 2, valp, qp, xg);
#pragma unroll
            for (int e = 0; e < 8; ++e) valp[e] = valn[e];
            qp = qn;
        }
        asm volatile("s_waitcnt vmcnt(0) lgkmcnt(0)\n\ts_barrier" ::: "memory");
        { float valn[8], qn = 0.f; unsigned long long xg[3]; GLA_EPI_A(31, gprev, valn, qn); GLA_GLOAD(30, xg); GLA_EPI_B(30, valp, qp, xg); GLA_GLOAD(31, xg); GLA_EPI_B(31, valn, qn, xg); }
#undef GLA_STAGE
#undef GLA_REGLOAD
#undef GLA_EPI_A
#undef GLA_EPI_B
#undef GLA_GLOAD
    }
    asm volatile("s_waitcnt vmcnt(0) lgkmcnt(0)\n\ts_barrier" ::: "memory");
}

#undef GLA_LAS
}
__device__ __forceinline__ int lane_id_v() { int l; asm volatile("v_mbcnt_lo_u32_b32 %0, -1, 0\n\tv_mbcnt_hi_u32_b32 %0, -1, %0" : "=v"(l)); return l; }
__device__ __forceinline__ float wave_sum(float v) {
#pragma unroll
    for (int o = 1; o < 64; o <<= 1) v += __shfl_xor(v, o);
    return v;
}
__device__ __forceinline__ void p0_item(const float* W, int K, int N, bf16* WT, int k0, int n0, int drow0, const float* rs, float cs, LAS float* scr, int lane) {
    const int n = n0 + (lane & 31);
    float wv[32];
#pragma unroll
    for (int i = 0; i < 32; ++i) { const int kk = 2 * i + (lane >> 5); wv[i] = (n < N) ? W[(size_t)(k0 + kk) * N + n] : 0.f; }
    float rv = 1.f; if (rs) rv = rs[k0 + (lane & 63)];
#pragma unroll
    for (int i = 0; i < 32; ++i) { const int kk = 2 * i + (lane >> 5); const float r = __shfl(rv, kk); scr[kk * 33 + (lane & 31)] = wv[i] * cs * r; }
    LDS_WAIT(); asm volatile("" ::: "memory");
    const int c = lane & 7;
#pragma unroll
    for (int j = 0; j < 4; ++j) { const int nn = (lane >> 3) + 8 * j; const LAS float* s = scr + (8 * c) * 33 + nn;
        v4u o; o.x = pk2(s[0 * 33], s[1 * 33]); o.y = pk2(s[2 * 33], s[3 * 33]); o.z = pk2(s[4 * 33], s[5 * 33]); o.w = pk2(s[6 * 33], s[7 * 33]);
        *(GAS v4u*)(WT + (size_t)(drow0 + nn) * K + k0 + 8 * c) = o; }
    LDS_WAIT(); asm volatile("" ::: "memory");
}
__device__ __forceinline__ int perm_row(int n0, int limit) {
    if (n0 >= limit) return n0;
    const int tile = n0 >> 8, w = n0 & 255, wc = w >> 6, bj = (w & 63) >> 5;
    return tile * 256 + 128 * bj + 32 * wc;
}
struct P0Ptrs { const float *x, *norm_mixer, *gla_w_in, *gla_w_out, *fox_w_in, *fox_w_out, *ple_proj, *ple_gate, *ple_norm; bf16 *WGIN, *WFIN, *WOUT, *WGATE, *WPROJ, *HB; float* SSQA; unsigned char* GRAN; };
__device__ __forceinline__ void p0_prologue(const P0Ptrs& P, LAS unsigned char* lds, int wave) {
    const int lane = lane_id_v(), gw = blockIdx.x * NWAVES + wave, NGW = gridDim.x * NWAVES;
    LAS float* scr = (LAS float*)(lds + RING_OFF + wave * 16384);
    constexpr int I_GIN = 16 * (GLA_NP / 32), I_FIN = 16 * (FOX_NP / 32), I_SQ = 16 * 32, I_PR = 4 * 32;
    constexpr int NITEMS = 2 * I_GIN + 2 * I_FIN + 4 * I_SQ + 4 * I_SQ + 4 * I_PR;
    for (int it = gw; it < NITEMS; it += NGW) {
        int r = it;
        if (r < 2 * I_GIN) { const int j = r / I_GIN; r -= j * I_GIN; const int nb = r % (GLA_NP / 32), kb = r / (GLA_NP / 32), n0 = nb * 32;
            p0_item(P.gla_w_in + (size_t)j * DM * GLA_IN, DM, GLA_IN, P.WGIN + (size_t)j * GLA_NP * DM, kb * 64, n0, perm_row(n0, 3072), P.norm_mixer + (size_t)(2 * j) * DM, n0 < 512 ? 0.08838834764831845f : 1.f, scr, lane); continue; }
        r -= 2 * I_GIN;
        if (r < 2 * I_FIN) { const int j = r / I_FIN; r -= j * I_FIN; const int nb = r % (FOX_NP / 32), kb = r / (FOX_NP / 32), n0 = nb * 32;
            p0_item(P.fox_w_in + (size_t)j * DM * FOX_IN, DM, FOX_IN, P.WFIN + (size_t)j * FOX_NP * DM, kb * 64, n0, perm_row(n0, 4096), P.norm_mixer + (size_t)(2 * j + 1) * DM, 1.f, scr, lane); continue; }
        r -= 2 * I_FIN;
        if (r < 4 * I_SQ) { const int i = r / I_SQ; r -= i * I_SQ; const int nb = r % 32, kb = r / 32;
            const float* src = (i & 1) ? P.fox_w_out + (size_t)(i >> 1) * DM * DM : P.gla_w_out + (size_t)(i >> 1) * DM * DM;
            p0_item(src, DM, DM, P.WOUT + (size_t)i * DM * DM, kb * 64, nb * 32, perm_row(nb * 32, DM), nullptr, 1.f, scr, lane); continue; }
        r -= 4 * I_SQ;
        if (r < 4 * I_SQ) { const int i = r / I_SQ; r -= i * I_SQ; const int nb = r % 32, kb = r / 32;
            p0_item(P.ple_gate + (size_t)i * DM * DM, DM, DM, P.WGATE + (size_t)i * DM * DM, kb * 64, nb * 32, perm_row(nb * 32, DM), P.ple_norm + (size_t)i * DM, 1.f, scr, lane); continue; }
        r -= 4 * I_SQ;
        { const int i = r / I_PR; r -= i * I_PR; const int nb = r % 32, kb = r / 32;
            p0_item(P.ple_proj + (size_t)i * PLE * DM, PLE, DM, P.WPROJ + (size_t)i * DM * PLE, kb * 64, nb * 32, perm_row(nb * 32, DM), nullptr, 1.f, scr, lane); }
    }
    for (int m0 = gw * 4; m0 < M; m0 += NGW * 4) {
        f32x4 v[4][4];
#pragma unroll
        for (int r = 0; r < 4; ++r) { const GAS f32x4* xr = (const GAS f32x4*)(P.x + (size_t)(m0 + r) * DM) + lane;
#pragma unroll
            for (int j = 0; j < 4; ++j) v[r][j] = xr[64 * j]; }
#pragma unroll
        for (int r = 0; r < 4; ++r) { float s = 0.f;
#pragma unroll
            for (int j = 0; j < 4; ++j) s += (v[r][j].x * v[r][j].x + v[r][j].y * v[r][j].y) + (v[r][j].z * v[r][j].z + v[r][j].w * v[r][j].w);
            s = wave_sum(s);
            GAS unsigned long long* o8 = (GAS unsigned long long*)(P.HB + (size_t)(m0 + r) * DM) + lane;
#pragma unroll
            for (int j = 0; j < 4; ++j) o8[64 * j] = (unsigned long long)pk2(v[r][j].x, v[r][j].y) | ((unsigned long long)pk2(v[r][j].z, v[r][j].w) << 32);
            if (lane < 16) P.SSQA[(size_t)(m0 + r) * 16 + lane] = (lane == 0) ? s : 0.f; }
    }
    { GAS v4u* gz = (GAS v4u*)P.GRAN; v4u z; z.x = 0u; z.y = 0u; z.z = 0u; z.w = 0u;
      for (size_t e = (size_t)gw * 64 + lane; e < GRAN_BYTES / 16; e += (size_t)NGW * 64) gz[e] = z; }
}
__device__ __forceinline__ void cvt_p_phase(const float* p, bf16* PB, int wave) {
    const int gtid = (blockIdx.x * NWAVES + wave) * 64 + lane_id_v(), NT = gridDim.x * NWAVES * 64;
    for (size_t i0 = (size_t)gtid; i0 < (size_t)M * PLE / 8; i0 += (size_t)NT * 8) {
        f32x4 a[8], b[8];
#pragma unroll
        for (int k = 0; k < 8; ++k) { const size_t i = i0 + (size_t)k * NT; if (i < (size_t)M * PLE / 8) { a[k] = *(const GAS f32x4*)(p + i * 8); b[k] = *(const GAS f32x4*)(p + i * 8 + 4); } }
#pragma unroll
        for (int k = 0; k < 8; ++k) { const size_t i = i0 + (size_t)k * NT; if (i < (size_t)M * PLE / 8) {
            v4u o; o.x = pk2(a[k].x, a[k].y); o.y = pk2(a[k].z, a[k].w); o.z = pk2(b[k].x, b[k].y); o.w = pk2(b[k].z, b[k].w);
            *(GAS v4u*)(PB + i * 8) = o; } }
    }
}
__device__ __forceinline__ void final_phase(float* out, const bf16* HB, const float* SSQA, const float* final_norm, int wave, const float pscale, const float padd) {
    const int lane = lane_id_v(), gw = blockIdx.x * NWAVES + wave, NGW = gridDim.x * NWAVES;
    f32x4 gn[2][2];
#pragma unroll
    for (int j = 0; j < 2; ++j) { const GAS f32x4* gr = (const GAS f32x4*)(final_norm + 8 * lane + 512 * j); gn[j][0] = gr[0]; gn[j][1] = gr[1]; }
    for (int m0 = gw * 4; m0 < M; m0 += NGW * 4) {
        float sq[4]; v4u hv[4][2];
#pragma unroll
        for (int r = 0; r < 4; ++r) { sq[r] = SSQA[(size_t)(m0 + r) * 16 + (lane & 15)];
#pragma unroll
            for (int j = 0; j < 2; ++j) hv[r][j] = *(const GAS v4u*)(HB + (size_t)(m0 + r) * DM + 8 * lane + 512 * j); }
#pragma unroll
        for (int r = 0; r < 4; ++r) { float s = sq[r];
            s += __builtin_bit_cast(float, __builtin_amdgcn_update_dpp(0, __builtin_bit_cast(int, s), 0x128, 0xf, 0xf, true));
            s += __builtin_bit_cast(float, __builtin_amdgcn_update_dpp(0, __builtin_bit_cast(int, s), 0x124, 0xf, 0xf, true));
            s += __builtin_bit_cast(float, __builtin_amdgcn_update_dpp(0, __builtin_bit_cast(int, s), 0x122, 0xf, 0xf, true));
            s += __builtin_bit_cast(float, __builtin_amdgcn_update_dpp(0, __builtin_bit_cast(int, s), 0x121, 0xf, 0xf, true));
            const float rstd = rsqrtf(s * (1.f / DM) + EPS) * pscale; const int m = m0 + r;
#pragma unroll
            for (int j = 0; j < 2; ++j) { const v4u h = hv[r][j]; GAS f32x4* o = (GAS f32x4*)(out + (size_t)m * DM + 8 * lane + 512 * j);
                f32x4 a, b2; a.x = __uint_as_float(h.x << 16); a.y = __uint_as_float(h.x & 0xffff0000u); a.z = __uint_as_float(h.y << 16); a.w = __uint_as_float(h.y & 0xffff0000u);
                b2.x = __uint_as_float(h.z << 16); b2.y = __uint_as_float(h.z & 0xffff0000u); b2.z = __uint_as_float(h.w << 16); b2.w = __uint_as_float(h.w & 0xffff0000u);
                f32x4 r0 = a * rstd * gn[j][0], r1 = b2 * rstd * gn[j][1]; if (m == 0 && j == 0 && lane == 0) r0.x += padd;
                o[0] = r0; o[1] = r1; } }
    }
}
__device__ __forceinline__ float bf2f(bf16 b) { return __uint_as_float((unsigned)b << 16); }
__device__ __forceinline__ float sigm(float x) { return 1.f / (1.f + __expf(-x)); }
__device__ __forceinline__ float logsigm(float x) { return fminf(x, 0.f) - log1pf(__expf(-fabsf(x))); }

struct Args { const float* in[17]; float* out; unsigned char* ws; int ph_lo, ph_hi; };
typedef const __attribute__((address_space(4))) Args* KArgs;
#define KARGS() ({ KArgs a_ = (KArgs)__builtin_amdgcn_kernarg_segment_ptr(); asm volatile("" : "+s"(a_)); a_; })
#if TPROBE
#define STAMP() do { if (blockIdx.x == 0 && wave == 0) { if (lane_id_v() == 0) ((volatile LAS unsigned long long*)(lds + LDSCTL_OFF))[sidx] = __builtin_amdgcn_s_memrealtime(); } ++sidx; } while (0)
#else
#define STAMP() do {} while (0)
#endif
#define GRID_BAR() do { XcdBarrier b2_ = bar; asm volatile("" : "+s"(b2_.x), "+s"(b2_.bar)); xcd_barrier(b2_, wave); STAMP(); } while (0)
template <bool LOGF> __device__ __forceinline__ void skinny16_phase(const bf16* HB, const bf16* W16, const float* ssq, const float* bias, float* aux, const int wave, LAS unsigned char* lds) {
    const int lane = lane_id_v(), fr = lane & 15, fq = lane >> 4, tid = wave * 64 + lane;
    constexpr int WP = 2064;
    v4u wst[4];
#pragma unroll
    for (int i = 0; i < 4; ++i) wst[i] = ((const GAS v4u*)W16)[tid + NWAVES * 64 * i];
    const int tile0 = blockIdx.x * NWAVES + wave, tstride = gridDim.x * NWAVES;
    bf16x8 a[32];
    if (tile0 < M / 16) { const bf16* ap = HB + (size_t)(tile0 * 16 + fr) * DM + 8 * fq;
#pragma unroll
        for (int j = 0; j < 32; ++j) a[j] = *(const GAS bf16x8*)(ap + 32 * j); }
#pragma unroll
    for (int i = 0; i < 4; ++i) { const int p = tid + NWAVES * 64 * i; *(LAS v4u*)(lds + (p >> 7) * WP + (p & 127) * 16) = wst[i]; }
    asm volatile("s_waitcnt lgkmcnt(0)\n\ts_barrier" ::: "memory");
    const LAS unsigned char* bl = lds + fr * WP + fq * 16;
    auto finish = [&](int tile, f32x4 acc0, f32x4 acc1) {
        const int row = tile * 16 + fr;
        const GAS f32x4* sp = (const GAS f32x4*)(ssq + (size_t)row * 16); const f32x4 s0 = sp[0], s1 = sp[1], s2 = sp[2], s3 = sp[3];
        const float ss = ((s0.x + s0.y) + (s0.z + s0.w)) + ((s1.x + s1.y) + (s1.z + s1.w)) + ((s2.x + s2.y) + (s2.z + s2.w)) + ((s3.x + s3.y) + (s3.z + s3.w));
        const float rstd = rsqrtf(ss * (1.f / DM) + EPS);
        f32x4 v = (acc0 + acc1) * rstd;
        if constexpr (LOGF) { const f32x4 bv = *(const GAS f32x4*)(bias + 4 * fq); v = v + bv;
#pragma unroll
            for (int i = 0; i < 4; ++i) v[i] = logsigm(v[i]); }
        *(GAS f32x4*)(aux + (size_t)row * 16 + 4 * fq) = v; };
    if (tile0 < M / 16) {
        f32x4 acc0 = {0.f, 0.f, 0.f, 0.f}, acc1 = {0.f, 0.f, 0.f, 0.f};
#pragma unroll
        for (int j = 0; j < 32; j += 2) {
            const bf16x8 b0 = *(const LAS bf16x8*)(bl + 64 * j), b1 = *(const LAS bf16x8*)(bl + 64 * j + 64);
            acc0 = __builtin_amdgcn_mfma_f32_16x16x32_bf16(b0, a[j], acc0, 0, 0, 0); acc1 = __builtin_amdgcn_mfma_f32_16x16x32_bf16(b1, a[j + 1], acc1, 0, 0, 0); }
        finish(tile0, acc0, acc1); }
    for (int tile = tile0 + tstride; tile < M / 16; tile += tstride) {
        const bf16* ap = HB + (size_t)(tile * 16 + fr) * DM + 8 * fq;
        f32x4 acc0 = {0.f, 0.f, 0.f, 0.f}, acc1 = {0.f, 0.f, 0.f, 0.f};
#pragma unroll 4
        for (int j = 0; j < 32; j += 2) {
            const bf16x8 a0 = *(const GAS bf16x8*)(ap + 32 * j), a1 = *(const GAS bf16x8*)(ap + 32 * j + 32);
            const bf16x8 b0 = *(const LAS bf16x8*)(bl + 64 * j), b1 = *(const LAS bf16x8*)(bl + 64 * j + 64);
            acc0 = __builtin_amdgcn_mfma_f32_16x16x32_bf16(b0, a0, acc0, 0, 0, 0); acc1 = __builtin_amdgcn_mfma_f32_16x16x32_bf16(b1, a1, acc1, 0, 0, 0); }
        finish(tile, acc0, acc1); }
}
template <class Sched> __device__ __forceinline__ void rstd_table(const Sched& S, const float* ssq, LAS unsigned char* lds, const int wave) {
    LAS float* rt = (LAS float*)(lds + RSTD_OFF); const int tid = wave * 64 + lane_id_v();
    f32x4 v[4][4]; bool ok[4];
#pragma unroll
    for (int k = 0; k < 4; ++k) { const int e = tid + NWAVES * 64 * k; pg8::Unit uu; ok[k] = S.next(e >> 8, uu);
        { const int pm_ = ok[k] ? uu.pm : 0;
          const GAS f32x4* sp = (const GAS f32x4*)(ssq + (size_t)(pm_ * 256 + (e & 255)) * 16); v[k][0] = sp[0]; v[k][1] = sp[1]; v[k][2] = sp[2]; v[k][3] = sp[3]; } }
#pragma unroll
    for (int k = 0; k < 4; ++k) if (ok[k]) { const f32x4 a = v[k][0], b = v[k][1], c = v[k][2], q = v[k][3];
        rt[tid + NWAVES * 64 * k] = rsqrtf((((a.x + a.y) + (a.z + a.w)) + ((b.x + b.y) + (b.z + b.w)) + ((c.x + c.y) + (c.z + c.w)) + ((q.x + q.y) + (q.z + q.w))) * (1.f / DM) + EPS); }
    __syncthreads();
}
template <int i> __device__ __forceinline__ void layer_body(LAS unsigned char* lds, const XcdBarrier& bar, const int wave, const int G, const int lo, const int hi, int& sidx) {
    constexpr int j = i >> 1;
#define IN(k) (lo <= (k) && (k) < hi)
#define HBC ((i & 1) ? (bf16*)((unsigned char*)A->out + 64 * MiB) : (bf16*)(ws + WS_HB))
#define HBN ((i & 1) ? (bf16*)(ws + WS_HB) : (bf16*)((unsigned char*)A->out + 64 * MiB))
        if constexpr ((i & 1) == 0) {
            if (IN(1 + 5 * i)) { KArgs A = KARGS(); unsigned char* ws = A->ws;
              skinny16_phase<false>(HBC, (const bf16*)(ws + WS_WGIN) + (size_t)j * GLA_NP * DM + (size_t)3072 * DM, (const float*)(ws + WS_SSQA), nullptr, (float*)(ws + WS_AUX), wave, lds + RING_OFF);
              cvt_p_phase(A->in[1] + (size_t)i * M * PLE, (bf16*)(ws + WS_PB), wave);
#if DUP_SKINNY
              skinny16_phase<false>(HBC, (const bf16*)(ws + WS_WGIN) + (size_t)j * GLA_NP * DM + (size_t)3072 * DM, (const float*)(ws + WS_SSQA), nullptr, (float*)(ws + WS_AUX), wave, lds + RING_OFF);
              cvt_p_phase(A->in[1] + (size_t)i * M * PLE, (bf16*)(ws + WS_PB), wave);
#endif
              pg8::Gemm g{HBC, (bf16*)(ws + WS_WGIN) + (size_t)j * GLA_NP * DM, M, 3072, DM}; pg8::StaticOrder S; S.init(M, 3072, G, (int)blockIdx.x);
              rstd_table(S, (const float*)(ws + WS_SSQA), lds, wave);
              pg8::EpiGlaIn E{(const LAS float*)(lds + RSTD_OFF), (bf16*)(ws + WS_PROJ), (float*)(ws + WS_AUX)};
              pg8::gemm_phase<pg8::EpiGlaIn, pg8::StaticOrder, true, true>(lds + RING_OFF, g, S, E, wave); }
#if DUP_INPROJ
            if (IN(1 + 5 * i)) { KArgs A = KARGS(); unsigned char* ws = A->ws;
              skinny16_phase<false>(HBC, (const bf16*)(ws + WS_WGIN) + (size_t)j * GLA_NP * DM + (size_t)3072 * DM, (const float*)(ws + WS_SSQA), nullptr, (float*)(ws + WS_AUX), wave, lds + RING_OFF);
              cvt_p_phase(A->in[1] + (size_t)i * M * PLE, (bf16*)(ws + WS_PB), wave);
#if DUP_SKINNY
              skinny16_phase<false>(HBC, (const bf16*)(ws + WS_WGIN) + (size_t)j * GLA_NP * DM + (size_t)3072 * DM, (const float*)(ws + WS_SSQA), nullptr, (float*)(ws + WS_AUX), wave, lds + RING_OFF);
              cvt_p_phase(A->in[1] + (size_t)i * M * PLE, (bf16*)(ws + WS_PB), wave);
#endif
              pg8::Gemm g{HBC, (bf16*)(ws + WS_WGIN) + (size_t)j * GLA_NP * DM, M, 3072, DM}; pg8::StaticOrder S; S.init(M, 3072, G, (int)blockIdx.x);
              rstd_table(S, (const float*)(ws + WS_SSQA), lds, wave);
              pg8::EpiGlaIn E{(const LAS float*)(lds + RSTD_OFF), (bf16*)(ws + WS_PROJ), (float*)(ws + WS_AUX)};
              pg8::gemm_phase<pg8::EpiGlaIn, pg8::StaticOrder, true, true>(lds + RING_OFF, g, S, E, wave); }
#endif
            GRID_BAR();
#define GLA_BUFS() unsigned char* os_ = (unsigned char*)A->out;     \
            gla::Bufs GB{(const gla::bf16*)(ws + WS_PROJ), (const float*)(ws + WS_AUX), (gla::bf16*)os_, (gla::bf16*)(os_ + 32 * MiB), (gla::bf16*)(ws + WS_AF), (unsigned long long*)(ws + WS_GRAN), (float*)(ws + WS_DCH), (gla::bf16*)(ws + WS_OG), (unsigned)(j + 1), \
                A->in[4] + (size_t)j * GLA_RANK * 512, A->in[5] + (size_t)j * 512, A->in[6] + (size_t)j * 256}
#if DUP_GLAPRE
            if (IN(2 + 5 * i)) { KArgs A = KARGS(); unsigned char* ws = A->ws; GLA_BUFS(); gla::pre_phase(GB, lds + RING_OFF, wave); }
#endif
            if (IN(2 + 5 * i)) { KArgs A = KARGS(); unsigned char* ws = A->ws; GLA_BUFS(); gla::pre_phase(GB, lds + RING_OFF, wave); }
            GRID_BAR();
            if (IN(2 + 5 * i)) { KArgs A = KARGS(); unsigned char* ws = A->ws; GLA_BUFS(); gla::core_phase(GB, lds + RING_OFF, wave); }
#if DUP_GLA
            GRID_BAR();
            if (IN(2 + 5 * i)) { KArgs A = KARGS(); unsigned char* ws = A->ws; GLA_BUFS(); gla::pre_phase(GB, lds + RING_OFF, wave); }
            GRID_BAR();
            if (IN(2 + 5 * i)) { KArgs A = KARGS(); unsigned char* ws = A->ws; GLA_BUFS(); gla::core_phase(GB, lds + RING_OFF, wave); }
#endif
        } else {
            if (IN(1 + 5 * i)) { KArgs A = KARGS(); unsigned char* ws = A->ws;
              skinny16_phase<true>(HBC, (const bf16*)(ws + WS_WFIN) + (size_t)j * FOX_NP * DM + (size_t)4096 * DM, (const float*)(ws + WS_SSQA), A->in[9] + (size_t)j * FOX_H, (float*)(ws + WS_AUX), wave, lds + RING_OFF);
              cvt_p_phase(A->in[1] + (size_t)i * M * PLE, (bf16*)(ws + WS_PB), wave);
#if DUP_SKINNY
              skinny16_phase<true>(HBC, (const bf16*)(ws + WS_WFIN) + (size_t)j * FOX_NP * DM + (size_t)4096 * DM, (const float*)(ws + WS_SSQA), A->in[9] + (size_t)j * FOX_H, (float*)(ws + WS_AUX), wave, lds + RING_OFF);
              cvt_p_phase(A->in[1] + (size_t)i * M * PLE, (bf16*)(ws + WS_PB), wave);
#endif
              pg8::Gemm g{HBC, (bf16*)(ws + WS_WFIN) + (size_t)j * FOX_NP * DM, M, 4096, DM}; pg8::StaticOrder S; S.init(M, 4096, G, (int)blockIdx.x);
              rstd_table(S, (const float*)(ws + WS_SSQA), lds, wave);
              pg8::EpiFoxIn E{(const LAS float*)(lds + RSTD_OFF), (bf16*)(ws + WS_PROJ), (float*)(ws + WS_AUX), A->in[9] + (size_t)j * FOX_H, A->in[10] + (size_t)j * 64, A->in[11] + (size_t)j * 64};
              pg8::gemm_phase<pg8::EpiFoxIn, pg8::StaticOrder, true, true>(lds + RING_OFF, g, S, E, wave); }
#if DUP_INPROJ
            if (IN(1 + 5 * i)) { KArgs A = KARGS(); unsigned char* ws = A->ws;
              skinny16_phase<true>(HBC, (const bf16*)(ws + WS_WFIN) + (size_t)j * FOX_NP * DM + (size_t)4096 * DM, (const float*)(ws + WS_SSQA), A->in[9] + (size_t)j * FOX_H, (float*)(ws + WS_AUX), wave, lds + RING_OFF);
              cvt_p_phase(A->in[1] + (size_t)i * M * PLE, (bf16*)(ws + WS_PB), wave);
#if DUP_SKINNY
              skinny16_phase<true>(HBC, (const bf16*)(ws + WS_WFIN) + (size_t)j * FOX_NP * DM + (size_t)4096 * DM, (const float*)(ws + WS_SSQA), A->in[9] + (size_t)j * FOX_H, (float*)(ws + WS_AUX), wave, lds + RING_OFF);
              cvt_p_phase(A->in[1] + (size_t)i * M * PLE, (bf16*)(ws + WS_PB), wave);
#endif
              pg8::Gemm g{HBC, (bf16*)(ws + WS_WFIN) + (size_t)j * FOX_NP * DM, M, 4096, DM}; pg8::StaticOrder S; S.init(M, 4096, G, (int)blockIdx.x);
              rstd_table(S, (const float*)(ws + WS_SSQA), lds, wave);
              pg8::EpiFoxIn E{(const LAS float*)(lds + RSTD_OFF), (bf16*)(ws + WS_PROJ), (float*)(ws + WS_AUX), A->in[9] + (size_t)j * FOX_H, A->in[10] + (size_t)j * 64, A->in[11] + (size_t)j * 64};
              pg8::gemm_phase<pg8::EpiFoxIn, pg8::StaticOrder, true, true>(lds + RING_OFF, g, S, E, wave); }
#endif
            GRID_BAR();
            if (IN(2 + 5 * i)) { KArgs A = KARGS(); unsigned char* ws = A->ws;
              attn_body::c2_phase((const float*)(ws + WS_AUX), A->in[10] + (size_t)j * 64, A->in[11] + (size_t)j * 64, (float*)(ws + WS_DCH), (float*)(ws + WS_CTL) + 8, (char*)lds + RING_OFF, G, (int)blockIdx.x, wave); }
            GRID_BAR();
            if (IN(2 + 5 * i)) { KArgs A = KARGS(); unsigned char* ws = A->ws;
              const attn_body::bf16* PR = (const attn_body::bf16*)(ws + WS_PROJ);
              const attn_body::AttnTensors AT{PR, (attn_body::bf16*)(ws + WS_OG), (const float*)(ws + WS_DCH), (const float*)(ws + WS_CTL) + 8};
              static_assert(attn_body::ATTN_LDS_TOTAL <= RING_BYTES, "attention LDS");
              attn_body::attn_phase<ATTN_THRL>((char*)lds + RING_OFF, AT, G, (int)blockIdx.x, wave); }
#if DUP_ATTN
            if (IN(2 + 5 * i)) { KArgs A = KARGS(); unsigned char* ws = A->ws;
              const attn_body::bf16* PR = (const attn_body::bf16*)(ws + WS_PROJ);
              const attn_body::AttnTensors AT{PR, (attn_body::bf16*)(ws + WS_OG), (const float*)(ws + WS_DCH), (const float*)(ws + WS_CTL) + 8};
              static_assert(attn_body::ATTN_LDS_TOTAL <= RING_BYTES, "attention LDS");
              attn_body::attn_phase<ATTN_THRL>((char*)lds + RING_OFF, AT, G, (int)blockIdx.x, wave); }
#endif
        }
        GRID_BAR();
        if (IN(3 + 5 * i)) { KArgs A = KARGS(); unsigned char* ws = A->ws;
          pg8::Gemm g{(bf16*)(ws + WS_OG), (bf16*)(ws + WS_WOUT) + (size_t)i * DM * DM, M, DM, DM}; pg8::StaticOrder S; S.init(M, DM, G, (int)blockIdx.x);
          pg8::EpiOut<i == 0> E{A->in[0], HBC, (float*)(ws + WS_SSQB)};
          pg8::gemm_phase<pg8::EpiOut<i == 0>, pg8::StaticOrder, true, true>(lds + RING_OFF, g, S, E, wave);
          int kq = PLE; asm volatile("" : "+s"(kq));
          pg8::Gemm g2{(bf16*)(ws + WS_PB), (bf16*)(ws + WS_WPROJ) + (size_t)i * DM * PLE, M, DM, kq}; pg8::EpiP E2{(bf16*)(ws + WS_SG)};
          pg8::gemm_phase<pg8::EpiP, pg8::StaticOrder, true, true>(lds + RING_OFF, g2, S, E2, wave); }
        GRID_BAR();
        if (IN(4 + 5 * i)) { KArgs A = KARGS(); unsigned char* ws = A->ws;
          pg8::Gemm g{HBC, (bf16*)(ws + WS_WGATE) + (size_t)i * DM * DM, M, DM, DM}; pg8::StaticOrder S; S.init(M, DM, G, (int)blockIdx.x);
          rstd_table(S, (const float*)(ws + WS_SSQB), lds, wave);
          pg8::EpiGateFinal E{ws, HBC, HBN, (const LAS float*)(lds + RSTD_OFF), WS_SG, WS_SSQA};
          pg8::gemm_phase<pg8::EpiGateFinal, pg8::StaticOrder, true, true>(lds + RING_OFF, g, S, E, wave); }
        GRID_BAR();
}
__global__ void __launch_bounds__(NWAVES * 64, 2) mega_fwd(Args args_unused) {
    extern __shared__ __attribute__((aligned(16))) unsigned char lds_raw[];
    LAS unsigned char* lds = (LAS unsigned char*)lds_raw;
    volatile LAS unsigned* MISC = (volatile LAS unsigned*)(lds + MISC_OFF);
    const int wave = __builtin_amdgcn_readfirstlane((int)threadIdx.x >> 6); const int G = gridDim.x;
    for (int u = threadIdx.x; u < (LDS_BYTES - LDSCTL_OFF) / 4; u += NWAVES * 64) ((LAS unsigned*)(lds + LDSCTL_OFF))[u] = 0u;
    __syncthreads();
    XcdBarrier bar;
    { KArgs A = KARGS(); bar = xcd_barrier_post((unsigned*)(A->ws + WS_CTL) + CW_BAR, MISC + 8); }

    int lo, hi; { KArgs A = KARGS(); lo = A->ph_lo; hi = A->ph_hi; }
    int sidx = 0; STAMP();
    if (IN(0)) { KArgs A = KARGS(); unsigned char* ws = A->ws; P0Ptrs P;
      P.x = A->in[0]; P.norm_mixer = A->in[2]; P.gla_w_in = A->in[3]; P.gla_w_out = A->in[7]; P.fox_w_in = A->in[8]; P.fox_w_out = A->in[12]; P.ple_proj = A->in[13]; P.ple_gate = A->in[14]; P.ple_norm = A->in[15];
      P.WGIN = (bf16*)(ws + WS_WGIN); P.WFIN = (bf16*)(ws + WS_WFIN); P.WOUT = (bf16*)(ws + WS_WOUT); P.WGATE = (bf16*)(ws + WS_WGATE); P.WPROJ = (bf16*)(ws + WS_WPROJ); P.HB = (bf16*)(ws + WS_HB); P.SSQA = (float*)(ws + WS_SSQA); P.GRAN = ws + WS_GRAN;
      p0_prologue(P, lds, wave);
#if DUP_P0
      p0_prologue(P, lds, wave);
#endif
      }
    GRID_BAR();
#if DUP_BAR
    for (int xb = 0; xb < 16; ++xb) GRID_BAR();
#endif
    layer_body<0>(lds, bar, wave, G, lo, hi, sidx);
    layer_body<1>(lds, bar, wave, G, lo, hi, sidx);
    layer_body<2>(lds, bar, wave, G, lo, hi, sidx);
    layer_body<3>(lds, bar, wave, G, lo, hi, sidx);
    float pscale = 1.f, padd = 0.f;
#if TPROBE
    if (blockIdx.x == 0) { volatile LAS unsigned long long* ts = (volatile LAS unsigned long long*)(lds + LDSCTL_OFF);
        const float ua = (float)(ts[PROBE_A] - ts[PROBE_A - 1]) * 0.01f, ub = (float)(ts[PROBE_B] - ts[PROBE_B - 1]) * 0.01f;
        pscale = 1.f + ua * 0.01f; padd = ub; }
#endif
    if (IN(21)) { KArgs A = KARGS(); final_phase(A->out, (const bf16*)(A->ws + WS_HB), (const float*)(A->ws + WS_SSQA), A->in[16], wave, pscale, padd); }
}

static int mega_grid = 0;
static bool mega_setup(int n_in, int out_size, size_t ws_size) {
    if (mega_grid == 0) {
        if (n_in != 17 || out_size != M * DM || ws_size < WS_END) { fprintf(stderr, "kernel_launch: unexpected shapes: n_in %d out %d ws %zu (need %zu); nothing launched\n", n_in, out_size, ws_size, (size_t)WS_END); mega_grid = -1; return false; }
        int dev = 0, cus = 0, per_cu = 0;
        if (hipGetDevice(&dev) != hipSuccess || hipDeviceGetAttribute(&cus, hipDeviceAttributeMultiprocessorCount, dev) != hipSuccess) { mega_grid = -1; return false; }
        if (hipFuncSetAttribute((const void*)mega_fwd, hipFuncAttributeMaxDynamicSharedMemorySize, LDS_BYTES) != hipSuccess) { fprintf(stderr, "kernel_launch: hipFuncSetAttribute failed\n"); mega_grid = -1; return false; }
        if (hipOccupancyMaxActiveBlocksPerMultiprocessor(&per_cu, (const void*)mega_fwd, NWAVES * 64, LDS_BYTES) != hipSuccess || per_cu < 1) { fprintf(stderr, "kernel_launch: occupancy query says %d blocks per CU\n", per_cu); (void)hipGetLastError(); mega_grid = -1; return false; }
        mega_grid = cus;
    }
    return mega_grid > 0;
}
static void mega_launch(void* const* d_in, void* d_out, void* d_ws, hipStream_t stream, int lo, int hi) {
    if (hipMemsetAsync((char*)d_ws + WS_CTL, 0, CTL_ZERO_BYTES, stream) != hipSuccess) { fprintf(stderr, "kernel_launch: memset failed\n"); return; }
    Args a{};
    for (int i = 0; i < 17; ++i) a.in[i] = (const float*)d_in[i];
    a.out = (float*)d_out; a.ws = (unsigned char*)d_ws; a.ph_lo = lo; a.ph_hi = hi;
    void* kargs[] = {&a};
    hipError_t e = hipLaunchCooperativeKernel((const void*)mega_fwd, dim3(mega_grid), dim3(NWAVES * 64), kargs, LDS_BYTES, stream);
    if (e != hipSuccess) fprintf(stderr, "kernel_launch: cooperative launch failed: %s (grid %d)\n", hipGetErrorString(e), mega_grid);
}
extern "C" void kernel_launch(void* const* d_in, const int* in_sizes, int n_in, void* d_out, int out_size, void* d_ws, size_t ws_size, hipStream_t stream) {
    if (!mega_setup(n_in, out_size, ws_size)) return;
    mega_launch(d_in, d_out, d_ws, stream, 0, 22);
}
```

```cpp
#include <hip/hip_runtime.h>
#include <stdint.h>
#include <cstdio>
#include <cmath>
constexpr int DM = 1024, BATCH = 16, SEQ = 2048, DEPTH = 4, M = BATCH * SEQ;
constexpr int PLE = 256;
constexpr int GLA_H = 4, GLA_RANK = 16;
constexpr int GLA_IN = 3088, GLA_NP = 3328;
constexpr int FOX_H = 16, FOX_IN = 4112, FOX_NP = 4352;
constexpr float EPS = 1e-6f;
constexpr float LOG2E = 1.4426950408889634f;
constexpr float C2 = 0.125f * LOG2E;
constexpr int NWAVES = 8;

constexpr size_t MiB = 1u << 20;
constexpr size_t WS_CTL = 0, CTL_ZERO_BYTES = 64 * 1024;
constexpr size_t WS_WGIN = 1 * MiB;
constexpr size_t WS_WFIN = 14 * MiB;
constexpr size_t WS_WOUT = 31 * MiB;
constexpr size_t WS_WGATE = 39 * MiB;
constexpr size_t WS_WPROJ = 47 * MiB;
constexpr size_t WS_SSQA = 49 * MiB;
constexpr size_t WS_SSQB = 51 * MiB;
constexpr size_t WS_AUX = 53 * MiB;
constexpr size_t WS_PB = 57 * MiB;
constexpr size_t WS_HB = 73 * MiB;
constexpr size_t WS_OG = 137 * MiB;
constexpr size_t WS_PROJ = 201 * MiB;
constexpr size_t WS_SG = WS_PROJ;
constexpr size_t WS_DCH = 55 * MiB;
constexpr size_t WS_SSQG = 474 * MiB;
constexpr size_t WS_AF = 482 * MiB;
constexpr size_t WS_GRAN = 498 * MiB, GRAN_BYTES = 4 * MiB;
constexpr size_t WS_END = 502 * MiB;
constexpr int CW_BAR = 1024;

constexpr int RING_OFF = 0, RING_BYTES = 131072;
constexpr int LDSCTL_OFF = RING_BYTES, MISC_OFF = LDSCTL_OFF + 320;
constexpr int RSTD_OFF = RING_BYTES + 512;
constexpr int LDS_BYTES = 163840;
#ifndef ATTN_THRL
#define ATTN_THRL 64
#endif
#ifndef DUP_INPROJ
#define DUP_INPROJ 0
#endif
#ifndef DUP_GLA
#define DUP_GLA 0
#endif
#ifndef DUP_ATTN
#define DUP_ATTN 0
#endif
#ifndef DUP_GATE
#define DUP_GATE 0
#endif
#ifndef DUP_P0
#define DUP_P0 0
#endif
#ifndef DUP_BAR
#define DUP_BAR 0
#endif
#ifndef DUP_OUT0
#define DUP_OUT0 0
#endif
#ifndef DUP_GLAPRE
#define DUP_GLAPRE 0
#endif
#ifndef TPROBE
#define TPROBE 0
#endif
#ifndef PROBE_A
#define PROBE_A 1
#endif
#ifndef PROBE_B
#define PROBE_B 1
#endif
#ifndef DUP_SKINNY
#define DUP_SKINNY 0
#endif
#ifndef ATTN_XCDMAP
#define ATTN_XCDMAP 0
#endif
#ifndef ATTN_SKIP
#define ATTN_SKIP 0
#endif
#ifndef PROJ_NT
#define PROJ_NT 1
#endif
#ifndef ATTN_SM_MAX
#define ATTN_SM_MAX 40.0f
#endif
namespace pg8 {
#define PG8_LAS __attribute__((address_space(3)))
typedef unsigned short bf16_t;
typedef short bf16x8 __attribute__((ext_vector_type(8)));
typedef float f32x4 __attribute__((ext_vector_type(4)));
typedef unsigned u32x4 __attribute__((ext_vector_type(4)));
constexpr int BM = 256, BK = 64, HALF = 128, HTB = HALF * BK * 2  , STAGE_BYTES = 8 * HTB, NXCD = 8, WGM = 4;

__host__ __device__ __forceinline__ int lds_byte(int r, int c) { const int st = (r >> 4) * 2 + (c >> 5), rr = r & 15, cc = c & 31, ob = rr * 64 + cc * 2; return st * 1024 + (ob ^ (((ob >> 9) & 1) << 5)); }
__host__ __device__ __forceinline__ void stage_rc(int b, int& R, int& C) { const int st = b / 1024, sb = b % 1024, swz = sb ^ (((sb >> 9) & 1) << 5); R = (st >> 1) * 16 + swz / 64; C = (st & 1) * 32 + (swz % 64) / 2; }
__host__ __device__ __forceinline__ int perm32(int rho) { const int n = rho >> 4, i = rho & 15; return 8 * (i >> 2) + 4 * n + (i & 3); }

struct Unit { int pm, pn, idx; };
struct Gemm { const bf16_t* A; const bf16_t* Bt; int M, N, K; };

struct StaticOrder {
    int nM, nN, nwg, G, c;
    __host__ __device__ void init(int M, int N, int G_, int c_) { nM = M / BM; nN = N / BM; nwg = nM * nN; G = G_; c = c_; }
    __host__ __device__ bool next(int i, Unit& u) const {
        const long L = (long)i * G + c; if (L >= nwg) return false;
        int wgid = (int)L; { const int q = nwg / NXCD, r = nwg % NXCD, xcd = wgid % NXCD, off = wgid / NXCD; wgid = (xcd < r ? xcd * (q + 1) : r * (q + 1) + (xcd - r) * q) + off; }
        if (nN == 12 && nM == 128 && G == 256) { const int xcd = (int)(L % NXCD), off = (int)(L / NXCD);
            if (off < 128) { const int w = off & 31; u.pm = xcd * 16 + (off >> 5) * 4 + (w & 3); u.pn = w >> 2; }
            else { const int o2 = off - 128, w = o2 & 31; u.pm = xcd * 16 + (o2 >> 5) * 8 + (w & 7); u.pn = 8 + (w >> 3); }
            u.idx = i; return true; }
        const int nig = WGM * nN, gid = wgid / nig, fm = gid * WGM, gsz = (nM - fm) < WGM ? (nM - fm) : WGM;
        u.pm = fm + ((wgid % nig) % gsz); u.pn = (wgid % nig) / gsz; u.idx = i; return true;
    }
    __device__ __forceinline__ void a_ready(const Unit&) const {}
    __device__ __forceinline__ void done(const Unit&) const {}
};
typedef float f32x2c_t __attribute__((ext_vector_type(2))); typedef __bf16 bf16x2c_t __attribute__((ext_vector_type(2)));
__device__ __forceinline__ unsigned cvt_pk_bf16(float lo, float hi) { f32x2c_t v = {lo, hi}; bf16x2c_t b = __builtin_convertvector(v, bf16x2c_t); return __builtin_bit_cast(unsigned, b); }
typedef float f32x2 __attribute__((ext_vector_type(2)));
typedef unsigned u32x2 __attribute__((ext_vector_type(2)));
__device__ __forceinline__ float sigmoid_f(float x) { return __builtin_amdgcn_rcpf(1.f + __builtin_amdgcn_exp2f(-1.4426950408889634f * x)); }
__device__ __forceinline__ float logsigmoid_f(float x) { return fminf(x, 0.f) - log1pf(__expf(-fabsf(x))); }
__device__ __forceinline__ void lane_rstd(const float* ssq, int row0, int fq, float (&rs)[2][4]) {
#pragma unroll
    for (int ai = 0; ai < 2; ++ai)
#pragma unroll
        for (int m = 0; m < 4; ++m) {
            const f32x4 v = *(const f32x4*)(ssq + (size_t)(row0 + ai * HALF + m * 16) * 16 + 4 * fq);
            float s = (v[0] + v[1]) + (v[2] + v[3]); s += __shfl_xor(s, 16); s += __shfl_xor(s, 32);
            rs[ai][m] = rsqrtf(s * (1.0f / 1024.0f) + 1e-6f);
        }
}
__device__ __forceinline__ void lane_rstd_lds(const PG8_LAS float* rt, int idx, int rloc, float (&rs)[2][4]) {
#pragma unroll
    for (int ai = 0; ai < 2; ++ai)
#pragma unroll
        for (int m = 0; m < 4; ++m) rs[ai][m] = rt[idx * 256 + rloc + ai * HALF + m * 16];
}
__device__ __forceinline__ u32x4 pack8(const f32x4 a, const f32x4 b) { u32x4 w; w.x = cvt_pk_bf16(a[0], a[1]); w.y = cvt_pk_bf16(a[2], a[3]); w.z = cvt_pk_bf16(b[0], b[1]); w.w = cvt_pk_bf16(b[2], b[3]); return w; }

__device__ __forceinline__ float rows4_sum(float q) {
    { auto rr = __builtin_amdgcn_permlane16_swap(__float_as_uint(q), __float_as_uint(q), false, false); q = __uint_as_float(rr[0]) + __uint_as_float(rr[1]); }
    { auto rr = __builtin_amdgcn_permlane32_swap(__float_as_uint(q), __float_as_uint(q), false, false); q = __uint_as_float(rr[0]) + __uint_as_float(rr[1]); }
    return q; }
__device__ __forceinline__ void swap8(const u32x4 a, const u32x4 b, u32x4& xa, u32x4& xb) {
#pragma unroll
    for (int e = 0; e < 4; ++e) {
        xb[e] = (unsigned)__builtin_amdgcn_update_dpp((int)b[e], (int)a[e], 0x128, 0xf, 0x3, false);
        xa[e] = (unsigned)__builtin_amdgcn_update_dpp((int)a[e], (int)b[e], 0x128, 0xf, 0xC, false); } }
__device__ __forceinline__ u32x4 ror8(const u32x4 v) { u32x4 r;
#pragma unroll
    for (int d = 0; d < 4; ++d) r[d] = (unsigned)__builtin_amdgcn_update_dpp(0, (int)v[d], 0x128, 0xf, 0xf, true);
    return r; }
template <bool NT = false>
__device__ __forceinline__ void store_pair(bf16_t* base, int pitch, int rowb, int colw, int fr, const u32x4 p0, const u32x4 p1) {
    const bool hi8 = (fr & 8) != 0; u32x4 dA, dB; swap8(p0, p1, dA, dB);
    bf16_t* pa = base + (size_t)(rowb + (fr & 7)) * pitch + colw + (hi8 ? 32 : 0);
    if constexpr (NT) { __builtin_nontemporal_store(dA, (u32x4*)pa); __builtin_nontemporal_store(dB, (u32x4*)(pa + (size_t)8 * pitch)); }
    else { *(u32x4*)pa = dA; *(u32x4*)(pa + (size_t)8 * pitch) = dB; } }
__device__ __forceinline__ void load_raw(const bf16_t* base, int pitch, int rowb, int colw, int fr, u32x4& LA, u32x4& LB) {
    const bool hi8 = (fr & 8) != 0; const bf16_t* pa = base + (size_t)(rowb + (fr & 7)) * pitch + colw + (hi8 ? 32 : 0);
    LA = *(const u32x4*)pa; LB = *(const u32x4*)(pa + (size_t)8 * pitch); }
__device__ __forceinline__ void unswap(int fr, const u32x4 LA, const u32x4 LB, u32x4& p0, u32x4& p1) {
    (void)fr; swap8(LA, LB, p0, p1); }

struct EpiGlaIn {
    static constexpr bool PERM = true, AFTER_DRAIN = false;
    const PG8_LAS float* rt; bf16_t* proj; float* aux;
    __device__ __forceinline__ void operator()(const f32x4 (&acc)[2][2][4][2], const Unit& u, int wr, int wc, int fr, int fq) const {
        asm volatile("" : "+v"(fr), "+v"(fq));
        const int rowb0 = u.pm * BM + wr * 64, colw = u.pn * BM + 64 * wc + 8 * fq; float rs[2][4]; lane_rstd_lds(rt, u.idx, wr * 64 + fr, rs);
#pragma unroll
        for (int ai = 0; ai < 2; ++ai)
#pragma unroll
            for (int m = 0; m < 4; ++m) { const float s = rs[ai][m];
                store_pair<PROJ_NT != 0>(proj, 3328, rowb0 + ai * HALF + m * 16, colw, fr, pack8(acc[ai][0][m][0] * s, acc[ai][0][m][1] * s), pack8(acc[ai][1][m][0] * s, acc[ai][1][m][1] * s)); }
    }
};
struct EpiFoxIn {
    static constexpr bool PERM = true, AFTER_DRAIN = false;
    const PG8_LAS float* rt; bf16_t* proj; float* aux; const float* bf; const float* qg; const float* kg;
    __device__ __forceinline__ void operator()(const f32x4 (&acc)[2][2][4][2], const Unit& u, int wr, int wc, int fr, int fq) const {
        asm volatile("" : "+v"(fr), "+v"(fq));
        const int rowb0 = u.pm * BM + wr * 64, colw = u.pn * BM + 64 * wc + 8 * fq; float rs[2][4]; lane_rstd_lds(rt, u.idx, wr * 64 + fr, rs);
        if (u.pn < 8) {
            const bool isq = u.pn < 4; const float* gsrc = isq ? qg : kg; const float gmul = isq ? (0.125f * 1.4426950408889634f) : 1.0f;
            f32x4 gv[2][2];
#pragma unroll
            for (int bj = 0; bj < 2; ++bj)
#pragma unroll
                for (int n = 0; n < 2; ++n) gv[bj][n] = *(const f32x4*)(gsrc + 32 * bj + 8 * fq + 4 * n) * gmul;
#pragma unroll
            for (int ai = 0; ai < 2; ++ai)
#pragma unroll
                for (int m = 0; m < 4; ++m) { const float s = rs[ai][m]; f32x4 v[2][2]; float q = 0.f;
#pragma unroll
                    for (int bj = 0; bj < 2; ++bj)
#pragma unroll
                        for (int n = 0; n < 2; ++n) { v[bj][n] = acc[ai][bj][m][n] * s; q += (v[bj][n][0] * v[bj][n][0] + v[bj][n][1] * v[bj][n][1]) + (v[bj][n][2] * v[bj][n][2] + v[bj][n][3] * v[bj][n][3]); }
                    q = rows4_sum(q);
                    const float hr = rsqrtf(q * (1.0f / 64.0f) + 1e-6f);
                    store_pair<PROJ_NT != 0>(proj, 4352, rowb0 + ai * HALF + m * 16, colw, fr, pack8(v[0][0] * hr * gv[0][0], v[0][1] * hr * gv[0][1]), pack8(v[1][0] * hr * gv[1][0], v[1][1] * hr * gv[1][1])); }
        } else {
#pragma unroll
            for (int ai = 0; ai < 2; ++ai)
#pragma unroll
                for (int m = 0; m < 4; ++m) { const float s = rs[ai][m];
                    store_pair<PROJ_NT != 0>(proj, 4352, rowb0 + ai * HALF + m * 16, colw, fr, pack8(acc[ai][0][m][0] * s, acc[ai][0][m][1] * s), pack8(acc[ai][1][m][0] * s, acc[ai][1][m][1] * s)); }
        }
    }
};
__device__ __forceinline__ void unpack8(const u32x4 g, f32x4& g0, f32x4& g1) {
    g0[0] = __uint_as_float(g.x << 16); g0[1] = __uint_as_float(g.x & 0xffff0000u); g0[2] = __uint_as_float(g.y << 16); g0[3] = __uint_as_float(g.y & 0xffff0000u);
    g1[0] = __uint_as_float(g.z << 16); g1[1] = __uint_as_float(g.z & 0xffff0000u); g1[2] = __uint_as_float(g.w << 16); g1[3] = __uint_as_float(g.w & 0xffff0000u);
}
__device__ __forceinline__ void store_h_rows(bf16_t* hb, float* ssq, int rowb, int colw, int slot, int fr, int fq, const f32x4 (&v)[2][2]) {
    float q = 0.f;
#pragma unroll
    for (int bj = 0; bj < 2; ++bj)
#pragma unroll
        for (int n = 0; n < 2; ++n) q += (v[bj][n][0] * v[bj][n][0] + v[bj][n][1] * v[bj][n][1]) + (v[bj][n][2] * v[bj][n][2] + v[bj][n][3] * v[bj][n][3]);
    store_pair(hb, 1024, rowb, colw, fr, pack8(v[0][0], v[0][1]), pack8(v[1][0], v[1][1]));
    q = rows4_sum(q);
    if (fq == 0) ssq[(size_t)(rowb + fr) * 16 + slot] = q;
}
template <bool X32> struct EpiOut {
    static constexpr bool PERM = true, AFTER_DRAIN = false;
    const float* x; bf16_t* hb; float* ssq;
    __device__ __forceinline__ void operator()(const f32x4 (&acc)[2][2][4][2], const Unit& u, int wr, int wc, int fr, int fq) const {
        asm volatile("" : "+v"(fr), "+v"(fq));
        const int rowb0 = u.pm * BM + wr * 64, colw = u.pn * BM + 64 * wc + 8 * fq, slot = u.pn * 4 + wc;
#pragma unroll
        for (int ai = 0; ai < 2; ++ai) {
            if constexpr (X32) {
                f32x4 pre[4][2][2];
#pragma unroll
                for (int m = 0; m < 4; ++m)
#pragma unroll
                    for (int bj = 0; bj < 2; ++bj) { const size_t o = (size_t)(rowb0 + ai * HALF + m * 16 + fr) * 1024 + colw + 32 * bj; pre[m][bj][0] = *(const f32x4*)(x + o); pre[m][bj][1] = *(const f32x4*)(x + o + 4); }
#pragma unroll
                for (int m = 0; m < 4; ++m) { f32x4 v[2][2];
#pragma unroll
                    for (int bj = 0; bj < 2; ++bj) { v[bj][0] = pre[m][bj][0] + acc[ai][bj][m][0]; v[bj][1] = pre[m][bj][1] + acc[ai][bj][m][1]; }
                    store_h_rows(hb, ssq, rowb0 + ai * HALF + m * 16, colw, slot, fr, fq, v); }
            } else {
                u32x4 la[4], lb[4];
#pragma unroll
                for (int m = 0; m < 4; ++m) load_raw(hb, 1024, rowb0 + ai * HALF + m * 16, colw, fr, la[m], lb[m]);
#pragma unroll
                for (int m = 0; m < 4; ++m) { u32x4 q0, q1; unswap(fr, la[m], lb[m], q0, q1); f32x4 v[2][2], h0, h1;
                    unpack8(q0, h0, h1); v[0][0] = h0 + acc[ai][0][m][0]; v[0][1] = h1 + acc[ai][0][m][1];
                    unpack8(q1, h0, h1); v[1][0] = h0 + acc[ai][1][m][0]; v[1][1] = h1 + acc[ai][1][m][1];
                    store_h_rows(hb, ssq, rowb0 + ai * HALF + m * 16, colw, slot, fr, fq, v); }
            }
            asm volatile("" ::: "memory");
        }
    }
};
struct EpiP {
    static constexpr bool PERM = true, AFTER_DRAIN = false;
    bf16_t* pp;
    __device__ __forceinline__ void operator()(const f32x4 (&acc)[2][2][4][2], const Unit& u, int wr, int wc, int fr, int fq) const {
        asm volatile("" : "+v"(fr), "+v"(fq));
        const int rowb0 = u.pm * BM + wr * 64, colw = u.pn * BM + 64 * wc + 8 * fq;
#pragma unroll
        for (int ai = 0; ai < 2; ++ai)
#pragma unroll
            for (int m = 0; m < 4; ++m) store_pair(pp, 1024, rowb0 + ai * HALF + m * 16, colw, fr, pack8(acc[ai][0][m][0], acc[ai][0][m][1]), pack8(acc[ai][1][m][0], acc[ai][1][m][1]));
    }
};
struct EpiGateFinal {
    static constexpr bool PERM = true, AFTER_DRAIN = false;
    unsigned char* ws; const bf16_t* hin; bf16_t* hout; const PG8_LAS float* rt; size_t off_pp, off_ssq_out;
    __device__ __forceinline__ void operator()(const f32x4 (&acc)[2][2][4][2], const Unit& u, int wr, int wc, int fr, int fq) const {
        asm volatile("" : "+v"(fr), "+v"(fq));
        const bf16_t* pp = (const bf16_t*)(ws + off_pp); float* ssq_out = (float*)(ws + off_ssq_out);
        const int rowb0 = u.pm * BM + wr * 64, colw = u.pn * BM + 64 * wc + 8 * fq, slot = u.pn * 4 + wc; float rs[2][4]; lane_rstd_lds(rt, u.idx, wr * 64 + fr, rs);
        u32x4 L[2][8];
#define GF_LOAD(q, buf) do { _Pragma("unroll") for (int mm_ = 0; mm_ < 2; ++mm_) { const int rowb_ = rowb0 + ((q) >> 1) * HALF + (2 * ((q) & 1) + mm_) * 16; \
            const bf16_t* ph_ = hin + (size_t)(rowb_ + (fr & 7)) * 1024 + colw + ((fr & 8) ? 32 : 0); const bf16_t* pg_ = pp + (size_t)(rowb_ + (fr & 7)) * 1024 + colw + ((fr & 8) ? 32 : 0); \
            asm volatile("global_load_dwordx4 %0, %4, off\n\tglobal_load_dwordx4 %1, %5, off\n\tglobal_load_dwordx4 %2, %6, off\n\tglobal_load_dwordx4 %3, %7, off" \
                : "=&v"(L[buf][4 * mm_]), "=&v"(L[buf][4 * mm_ + 1]), "=&v"(L[buf][4 * mm_ + 2]), "=&v"(L[buf][4 * mm_ + 3]) : "v"(ph_), "v"(ph_ + 8 * 1024), "v"(pg_), "v"(pg_ + 8 * 1024) : "memory"); } } while (0)
#define GF_WAIT(n, buf) asm volatile("s_waitcnt vmcnt(" #n ")" : "+v"(L[buf][0]), "+v"(L[buf][1]), "+v"(L[buf][2]), "+v"(L[buf][3]), "+v"(L[buf][4]), "+v"(L[buf][5]), "+v"(L[buf][6]), "+v"(L[buf][7]) :: "memory")
        GF_LOAD(0, 0);
#pragma unroll
        for (int q = 0; q < 4; ++q) { const int ai = q >> 1, mh = q & 1, buf = q & 1;
            if (q == 0) GF_WAIT(0, 0); else if (buf == 0) GF_WAIT(4, 0); else GF_WAIT(4, 1);
            if (q < 3) { if (buf == 0) GF_LOAD(q + 1, 1); else GF_LOAD(q + 1, 0); }
#pragma unroll
            for (int mm = 0; mm < 2; ++mm) { const int m = 2 * mh + mm; const float s = rs[ai][m] * -1.4426950408889634f; f32x4 v[2][2]; u32x4 hq[2], pq[2];
                unswap(fr, L[buf][4 * mm], L[buf][4 * mm + 1], hq[0], hq[1]); unswap(fr, L[buf][4 * mm + 2], L[buf][4 * mm + 3], pq[0], pq[1]);
#pragma unroll
                for (int bj = 0; bj < 2; ++bj) { f32x4 h0, h1, p0, p1; unpack8(hq[bj], h0, h1); unpack8(pq[bj], p0, p1);
                    f32x4 a = acc[ai][bj][m][0] * s, b = acc[ai][bj][m][1] * s;
#pragma unroll
                    for (int i = 0; i < 4; ++i) { a[i] = __builtin_amdgcn_rcpf(1.f + __builtin_amdgcn_exp2f(a[i])); b[i] = __builtin_amdgcn_rcpf(1.f + __builtin_amdgcn_exp2f(b[i])); }
                    v[bj][0] = h0 + p0 * a; v[bj][1] = h1 + p1 * b; }
                store_h_rows(hout, ssq_out, rowb0 + ai * HALF + m * 16, colw, slot, fr, fq, v); }
            asm volatile("" ::: "memory");
        }
#undef GF_LOAD
#undef GF_WAIT
    }
};
template <class Epi, class Sched, bool ALIGN_EPI = false, bool SP2 = false>
__device__ __forceinline__ void gemm_phase(PG8_LAS unsigned char* lds, const Gemm g, const Sched& S, const Epi& E, const int wid  ) {
    int lane_; asm volatile("v_mbcnt_lo_u32_b32 %0, -1, 0\n\tv_mbcnt_hi_u32_b32 %0, -1, %0" : "=v"(lane_));
    const int lane = lane_, tid = wid * 64 + lane, wr = wid >> 2, wc = wid & 3, fr = lane & 15, fq = lane >> 4;
    const int K = g.K, nt = K / BK;
    unsigned voffA[2], voffB[2];
#pragma unroll
    for (int i = 0; i < 2; ++i) { int R, C; stage_rc(tid * 16 + i * 8192, R, C); const int Rb = Epi::PERM ? ((R & ~31) + perm32(R & 31)) : R;
        voffA[i] = (unsigned)(R * K + C) * 2u; voffB[i] = (unsigned)(Rb * K + C) * 2u; }
    const size_t kstep = (size_t)(BK * 2);
    const size_t hstep = (size_t)HALF * K * 2;
    const size_t tstep = 2 * hstep;
    const unsigned ldsw = (unsigned)wid * 1024u;
    const int aoff = lds_byte(wr * 64 + fr, fq * 8), boff = lds_byte(wc * 32 + fr, fq * 8);
#define PG8_SA(b, h) (((b) * 2 + (h)) * HTB)
#define PG8_SB(b, h) ((4 + (b) * 2 + (h)) * HTB)
#define PG8_STAGE(bufoff, gbase, voff) do { _Pragma("unroll") for (int _i = 0; _i < 2; ++_i) \
        __builtin_amdgcn_global_load_lds((const unsigned*)((const char*)(gbase) + (voff)[_i]), (PG8_LAS unsigned*)(lds + (bufoff) + ldsw + _i * 8192), 16, 0, 0); } while (0)
#define PG8_LDA(dst, b, h) do { _Pragma("unroll") for (int m = 0; m < 4; ++m) _Pragma("unroll") for (int k = 0; k < 2; ++k) dst[m][k] = *(const PG8_LAS bf16x8*)(lds + PG8_SA(b, h) + aoff + m * 2048 + k * 1024); } while (0)
#define PG8_LDB(dst, b, h) do { _Pragma("unroll") for (int n = 0; n < 2; ++n) _Pragma("unroll") for (int k = 0; k < 2; ++k) dst[n][k] = *(const PG8_LAS bf16x8*)(lds + PG8_SB(b, h) + boff + n * 2048 + k * 1024); } while (0)
#define PG8_MMA(ai, bj, At, Bt) do { __builtin_amdgcn_s_setprio(1); _Pragma("unroll") for (int m = 0; m < 4; ++m) _Pragma("unroll") for (int n = 0; n < 2; ++n) _Pragma("unroll") for (int k = 0; k < 2; ++k) \
        acc[ai][bj][m][n] = __builtin_amdgcn_mfma_f32_16x16x32_bf16(Bt[n][k], At[m][k], acc[ai][bj][m][n], 0, 0, 0); __builtin_amdgcn_s_setprio(0); } while (0)
#define PG8_WAIT_V(n) asm volatile("s_waitcnt vmcnt(" #n ")" ::: "memory")
#define PG8_WAIT_L(n) asm volatile("s_waitcnt lgkmcnt(" #n ")" ::: "memory")
#define PG8_BAR __builtin_amdgcn_s_barrier()
#define PG8_SCHED __builtin_amdgcn_sched_barrier(0)
    Unit cur, nxt; int ui = 0;
    if (!S.next(0, cur)) return;
    f32x4 acc[2][2][4][2];
#pragma unroll
    for (int a = 0; a < 2; ++a)
#pragma unroll
        for (int b = 0; b < 2; ++b)
#pragma unroll
            for (int m = 0; m < 4; ++m)
#pragma unroll
                for (int n = 0; n < 2; ++n) acc[a][b][m][n] = (f32x4){0.f, 0.f, 0.f, 0.f};
    bf16x8 At[4][2], B0[2][2], B1[2][2];
    const char* cA = (const char*)g.A + (size_t)cur.pm * tstep; const char* cB = (const char*)g.Bt + (size_t)cur.pn * tstep;
    S.a_ready(cur);
    if constexpr (SP2) {
        PG8_STAGE(PG8_SB(0, 0), cB, voffB); PG8_STAGE(PG8_SB(0, 1), cB + hstep, voffB); PG8_STAGE(PG8_SA(0, 0), cA, voffA); PG8_STAGE(PG8_SA(0, 1), cA + hstep, voffA);
        if (wr == 1) PG8_BAR;
        PG8_WAIT_V(2); PG8_BAR;
        PG8_STAGE(PG8_SB(1, 0), cB + kstep, voffB); PG8_STAGE(PG8_SA(1, 0), cA + kstep, voffA); PG8_STAGE(PG8_SB(1, 1), cB + hstep + kstep, voffB);
        PG8_WAIT_V(6); PG8_BAR;
    } else {
        PG8_STAGE(PG8_SB(0, 0), cB, voffB); PG8_STAGE(PG8_SA(0, 0), cA, voffA); PG8_STAGE(PG8_SB(0, 1), cB + hstep, voffB); PG8_STAGE(PG8_SA(0, 1), cA + hstep, voffA);
        if (wr == 1) PG8_BAR;
        PG8_WAIT_V(4); PG8_BAR;
        PG8_STAGE(PG8_SB(1, 0), cB + kstep, voffB); PG8_STAGE(PG8_SA(1, 0), cA + kstep, voffA); PG8_STAGE(PG8_SB(1, 1), cB + hstep + kstep, voffB);
        PG8_WAIT_V(6); PG8_BAR;
    }
    for (;;) {
        const bool has_next = S.next(ui + 1, nxt);
        const char* nA = has_next ? (const char*)g.A + (size_t)nxt.pm * tstep : cA; const char* nB = has_next ? (const char*)g.Bt + (size_t)nxt.pn * tstep : cB;
        for (int t = 0; t < nt; t += 2) {
            const bool last = (t == nt - 2);
            const char* a1 = cA + (size_t)(t + 1) * kstep;
            const char* a2 = last ? nA : cA + (size_t)(t + 2) * kstep; const char* b2 = last ? nB : cB + (size_t)(t + 2) * kstep;
            const char* a3 = a2 + kstep; const char* b3 = b2 + kstep;
            if (last && has_next) S.a_ready(nxt);
            if constexpr (SP2) {
            PG8_LDB(B0, 0, 0); PG8_LDB(B1, 0, 1); PG8_SCHED; PG8_LDA(At, 0, 0); PG8_STAGE(PG8_SA(1, 1), a1 + hstep, voffA);
            PG8_WAIT_V(8); PG8_WAIT_L(0); PG8_BAR; PG8_MMA(0, 0, At, B0); PG8_MMA(0, 1, At, B1); PG8_BAR; PG8_SCHED;
            PG8_LDA(At, 0, 1); PG8_STAGE(PG8_SB(0, 0), b2, voffB); PG8_STAGE(PG8_SB(0, 1), b2 + hstep, voffB); PG8_STAGE(PG8_SA(0, 0), a2, voffA);
            PG8_WAIT_V(8); PG8_WAIT_L(0); PG8_BAR; PG8_MMA(1, 0, At, B0); PG8_MMA(1, 1, At, B1); PG8_BAR; PG8_SCHED;
            PG8_LDB(B0, 1, 0); PG8_LDB(B1, 1, 1); PG8_SCHED; PG8_LDA(At, 1, 0); PG8_STAGE(PG8_SA(0, 1), a2 + hstep, voffA);
            PG8_WAIT_V(8); PG8_WAIT_L(0); PG8_BAR; PG8_MMA(0, 0, At, B0); PG8_MMA(0, 1, At, B1); PG8_BAR; PG8_SCHED;
            PG8_LDA(At, 1, 1); PG8_STAGE(PG8_SB(1, 0), b3, voffB); PG8_STAGE(PG8_SB(1, 1), b3 + hstep, voffB); PG8_STAGE(PG8_SA(1, 0), a3, voffA);
            PG8_WAIT_V(8); PG8_WAIT_L(0); PG8_BAR; PG8_MMA(1, 0, At, B0); PG8_MMA(1, 1, At, B1); PG8_BAR; PG8_SCHED;
            } else {
            PG8_LDB(B0, 0, 0); PG8_SCHED; PG8_LDA(At, 0, 0); PG8_STAGE(PG8_SA(1, 1), a1 + hstep, voffA);
            PG8_WAIT_L(8); PG8_BAR; PG8_WAIT_L(0); PG8_MMA(0, 0, At, B0); PG8_BAR; PG8_SCHED;
            PG8_LDB(B1, 0, 1); PG8_STAGE(PG8_SB(0, 0), b2, voffB);
            PG8_BAR; PG8_WAIT_L(0); PG8_MMA(0, 1, At, B1); PG8_BAR;
            PG8_LDA(At, 0, 1); PG8_STAGE(PG8_SA(0, 0), a2, voffA);
            PG8_BAR; PG8_WAIT_L(0); PG8_MMA(1, 0, At, B0); PG8_BAR; PG8_SCHED;
            PG8_STAGE(PG8_SB(0, 1), b2 + hstep, voffB);
            PG8_WAIT_V(6); PG8_BAR; PG8_MMA(1, 1, At, B1); PG8_BAR;
            PG8_LDB(B0, 1, 0); PG8_SCHED; PG8_LDA(At, 1, 0); PG8_STAGE(PG8_SA(0, 1), a2 + hstep, voffA);
            PG8_WAIT_L(8); PG8_BAR; PG8_WAIT_L(0); PG8_MMA(0, 0, At, B0); PG8_BAR; PG8_SCHED;
            PG8_LDB(B1, 1, 1); PG8_STAGE(PG8_SB(1, 0), b3, voffB);
            PG8_BAR; PG8_WAIT_L(0); PG8_MMA(0, 1, At, B1); PG8_BAR;
            PG8_LDA(At, 1, 1); PG8_STAGE(PG8_SA(1, 0), a3, voffA);
            PG8_BAR; PG8_WAIT_L(0); PG8_MMA(1, 0, At, B0); PG8_BAR; PG8_SCHED;
            PG8_STAGE(PG8_SB(1, 1), b3 + hstep, voffB);
            PG8_WAIT_V(6); PG8_BAR; PG8_MMA(1, 1, At, B1); PG8_BAR;
            }
        }
        if constexpr (ALIGN_EPI) { if (wr == 0) PG8_BAR; }
        if constexpr (!Epi::AFTER_DRAIN) { E(acc, cur, wr, wc, fr, fq); S.done(cur); }
        if (!has_next) break;
#pragma unroll
        for (int a = 0; a < 2; ++a)
#pragma unroll
            for (int b = 0; b < 2; ++b)
#pragma unroll
                for (int m = 0; m < 4; ++m)
#pragma unroll
                    for (int n = 0; n < 2; ++n) acc[a][b][m][n] = (f32x4){0.f, 0.f, 0.f, 0.f};
        cur = nxt; cA = nA; cB = nB; ++ui;
        if constexpr (ALIGN_EPI) { if (wr == 1) PG8_BAR; }
    }
    PG8_WAIT_V(0);
    if constexpr (!ALIGN_EPI) { if (wr == 0) PG8_BAR; }
    PG8_BAR;
    if constexpr (Epi::AFTER_DRAIN) { E.fused(acc, cur, wr, wc, fr, fq, lds, wid, lane); S.done(cur); }
#undef PG8_SA
#undef PG8_SB
#undef PG8_STAGE
#undef PG8_LDA
#undef PG8_LDB
#undef PG8_MMA
#undef PG8_WAIT_V
#undef PG8_WAIT_L
#undef PG8_BAR
#undef PG8_SCHED
}
}
#define GAS __attribute__((address_space(1)))
#define LAS __attribute__((address_space(3)))
typedef unsigned short bf16;
typedef unsigned v4u __attribute__((ext_vector_type(4)));
typedef float f32x4 __attribute__((ext_vector_type(4)));
typedef short bf16x8 __attribute__((ext_vector_type(8)));
typedef GAS unsigned gu32;
typedef GAS unsigned long long gu64;
#define RLX_AGENT __ATOMIC_RELAXED, __HIP_MEMORY_SCOPE_AGENT
#define LDS_WAIT() asm volatile("s_waitcnt lgkmcnt(0)" ::: "memory")
#define VM_WAIT() asm volatile("s_waitcnt vmcnt(0)" ::: "memory")
__device__ __forceinline__ unsigned long long rt() { return __builtin_amdgcn_s_memrealtime(); }
__device__ __forceinline__ unsigned f2bf(float f) { unsigned u = __builtin_bit_cast(unsigned, f); return (u + 0x7fffu + ((u >> 16) & 1u)) >> 16; }
__device__ __forceinline__ unsigned pk2(float lo, float hi) { return f2bf(lo) | (f2bf(hi) << 16); }
#define XB_TMO      128
#define XB_XCNT(j)  (256  + 64 * (j))
#define XB_XSUB(j)  (1280 + 64 * (j))
#define XB_XGEN(j)  (2304 + 64 * (j))
#define XB_TOP      3328
#define XB_TOPGEN   3392
#define XCD_BAR_WORDS 3456
#define XB_SPIN_CAP (1u << 18)

__device__ __forceinline__ unsigned xb_ld(unsigned* p)              { return __hip_atomic_load(p, __ATOMIC_RELAXED, __HIP_MEMORY_SCOPE_AGENT); }
__device__ __forceinline__ unsigned xb_add(unsigned* p, unsigned v) { return __hip_atomic_fetch_add(p, v, __ATOMIC_RELAXED, __HIP_MEMORY_SCOPE_AGENT); }
__device__ __forceinline__ unsigned xb_xcc_id() { return (unsigned)__builtin_amdgcn_s_getreg((3 << 11) | 20) & 0xFu; }
#define XB_SPIN(cond, bar) do { unsigned _sp = 0; while (cond) { __builtin_amdgcn_s_sleep(1); \
    if ((++_sp & 255u) == 0u) { if (xb_ld(&(bar)[XB_TMO])) break; if (_sp > XB_SPIN_CAP) { atomicAdd(&(bar)[XB_TMO], 1u); break; } } } } while (0)

struct XcdBarrier {
    unsigned* bar; unsigned x;
    volatile LAS unsigned* st;
};

__device__ __forceinline__ XcdBarrier xcd_barrier_post(unsigned* bar, volatile LAS unsigned* st) {
    XcdBarrier b; b.bar = bar; b.x = xb_xcc_id(); b.st = st;
    if (threadIdx.x == 0) (void)xb_add(&bar[XB_XCNT(b.x)], 1u);
    return b;
}
__device__ __forceinline__ void xcd_barrier_complete(unsigned* bar, unsigned x, unsigned& nloc, unsigned& nx) {
    const unsigned G = gridDim.x * gridDim.y * gridDim.z;
    unsigned sum, cnt, mine, sp = 0u;
    for (;;) {
        sum = 0u; cnt = 0u; mine = 0u;
#pragma unroll
        for (unsigned j = 0; j < 16; ++j) { const unsigned c = xb_ld(&bar[XB_XCNT(j)]); sum += c; cnt += (c > 0u) ? 1u : 0u; mine = (j == x) ? c : mine; }
        if (sum == G) break;
        __builtin_amdgcn_s_sleep(1);
        if ((++sp & 255u) == 0u) { if (xb_ld(&bar[XB_TMO])) break; if (sp > XB_SPIN_CAP) { atomicAdd(&bar[XB_TMO], 1u); break; } }
    }
    nloc = mine > 0u ? mine : 1u; nx = cnt > 0u ? cnt : 1u;
}

__device__ __forceinline__ void xcd_barrier(const XcdBarrier& b, const int wave_) {
    asm volatile("s_waitcnt vmcnt(0)" ::: "memory");
    __syncthreads();
    int l0_; asm volatile("v_mbcnt_lo_u32_b32 %0, -1, 0\n\tv_mbcnt_hi_u32_b32 %0, -1, %0" : "=v"(l0_));
    if (wave_ == 0 && l0_ == 0) {
        unsigned* bar = b.bar;
        __builtin_amdgcn_s_waitcnt(0);
        unsigned nloc = b.st[0], nx = b.st[1];
        if (nloc == 0u) { xcd_barrier_complete(bar, b.x, nloc, nx); b.st[0] = nloc; b.st[1] = nx; }
        const unsigned old = xb_add(&bar[XB_XSUB(b.x)], 1u);
        const unsigned gen = old / nloc;
        if (old + 1u == (gen + 1u) * nloc) {
            __builtin_amdgcn_fence(__ATOMIC_RELEASE, "agent");
            asm volatile("s_waitcnt vmcnt(0)" ::: "memory");
            const unsigned og = xb_add(&bar[XB_TOP], 1u);
            const unsigned tg = og / nx;
            if (og + 1u == (tg + 1u) * nx) xb_add(&bar[XB_TOPGEN], 1u);
            else XB_SPIN(xb_ld(&bar[XB_TOPGEN]) == tg, bar);
            __builtin_amdgcn_fence(__ATOMIC_ACQUIRE, "agent");
            xb_add(&bar[XB_XGEN(b.x)], 1u);
            asm volatile("s_waitcnt vmcnt(0)" ::: "memory");
        } else {
            XB_SPIN(xb_ld(&bar[XB_XGEN(b.x)]) == gen, bar);
            __builtin_amdgcn_fence(__ATOMIC_ACQUIRE, "agent");
            asm volatile("s_waitcnt vmcnt(0)" ::: "memory");
        }
    }
    __syncthreads();
}
#include <hip/hip_bf16.h>
#include <cmath>
namespace attn_body {
using bf16=__hip_bfloat16;
using bf16x8=__attribute__((ext_vector_type(8)))short;
using s16x4=__attribute__((ext_vector_type(4)))short;
using f32x16=__attribute__((ext_vector_type(16)))float;
using u32x4=__attribute__((ext_vector_type(4)))unsigned;
using u32x2_t=__attribute__((ext_vector_type(2)))unsigned;
constexpr int BATCH=16,NHEAD=16,SEQ=2048,D=64,DM=4352,PO=1024;
constexpr int NW=8,QBLK=32,QB=QBLK*NW,KVBLK=64,NQB=SEQ/QB;
constexpr int ATTN_PITCH=DM, ATTN_UNIT_ROWS=QB;
typedef __attribute__((address_space(3))) const float* lds_fptr; typedef float f32x4a __attribute__((ext_vector_type(4)));
__device__ __forceinline__ int crow(int r,int hi){return (r&3)+8*(r>>2)+4*hi;}
__device__ __forceinline__ int fresh_lane(){ int l; asm volatile("v_mbcnt_lo_u32_b32 %0, -1, 0\n\tv_mbcnt_hi_u32_b32 %0, -1, %0" : "=v"(l)); return l; }
#define SBAR() __builtin_amdgcn_sched_barrier(0)
__device__ __forceinline__ void cmask(f32x16&p0,f32x16&p1,int jb,int qrel,int hi){
  const float NEG=-INFINITY; int kb=64*jb+4*hi;
  #pragma unroll
  for(int r=0;r<16;++r){int kv=kb+(r&3)+8*(r>>2); if(kv>qrel)p0[r]=NEG; if(kv+32>qrel)p1[r]=NEG;}
}

constexpr int NSLOT=3, SLOTB=8192;
constexpr int LDS_K=0, LDS_V=NSLOT*SLOTB, QST_HI=131584  , RING_SET=2*NSLOT*SLOTB  , LDS_WS=2*RING_SET, LDS_BYTES=LDS_WS+NW*64*4+SEQ*4+SEQ*8+4096;
constexpr int SEAM_C2F=LDS_WS+NW*64*4  , SEAM_C2S=SEAM_C2F+SEQ*4  , QST_W7=SEAM_C2S+SEQ*8;
constexpr float C2=0.125f*1.4426950408889634f;
__device__ __forceinline__ void glds16(const void*gsrc,unsigned lds_dst){unsigned keep;
  asm volatile("s_mov_b32 %0, m0\n\ts_mov_b32 m0, %2\n\ts_nop 0\n\tglobal_load_lds_dwordx4 %1, off\n\ts_mov_b32 m0, %0":"=&s"(keep):"v"(gsrc),"s"(lds_dst):"memory");}
__device__ __forceinline__ float max3f(float a,float b,float c){float r;asm("v_max3_f32 %0, %1, %2, %3":"=v"(r):"v"(a),"v"(b),"v"(c));return r;}
__device__ __forceinline__ float max2f(float a,float b){float r;asm("v_max_f32_e32 %0, %1, %2":"=v"(r):"v"(a),"v"(b));return r;}
__device__ __forceinline__ float fadd_s(float a,float b){float r;asm("v_add_f32_e32 %0, %1, %2":"=v"(r):"v"(a),"v"(b));return r;}
__device__ __forceinline__ float fsub_s(float a,float b){float r;asm("v_sub_f32_e32 %0, %1, %2":"=v"(r):"v"(a),"v"(b));return r;}
typedef float f32x2_t __attribute__((ext_vector_type(2))); typedef __bf16 bf16x2_t __attribute__((ext_vector_type(2)));
__device__ __forceinline__ unsigned cvtpk_s(float lo,float hi){f32x2_t v={lo,hi};bf16x2_t b=__builtin_convertvector(v,bf16x2_t);return __builtin_bit_cast(unsigned,b);}
#define WAIT_BAR(N) asm volatile("s_waitcnt vmcnt(" #N ") lgkmcnt(0)\n\ts_barrier":::"memory")

__device__ __forceinline__ void qkt(f32x16&p0,f32x16&p1,const char*Kslot,const bf16x8*qr,const f32x16&negm0,const f32x16&negm1,int r32,int hi){
  const char*kb=Kslot+hi*1024+r32*16;
  #pragma unroll
  for(int d0=0;d0<4;++d0){
    const bf16x8 b0=*reinterpret_cast<const bf16x8*>(kb+d0*2048);
    const bf16x8 b1=*reinterpret_cast<const bf16x8*>(kb+d0*2048+512);
    if(d0==0){p0=__builtin_amdgcn_mfma_f32_32x32x16_bf16(b0,qr[0],negm0,0,0,0);p1=__builtin_amdgcn_mfma_f32_32x32x16_bf16(b1,qr[0],negm1,0,0,0);}
    else{p0=__builtin_amdgcn_mfma_f32_32x32x16_bf16(b0,qr[d0],p0,0,0,0);p1=__builtin_amdgcn_mfma_f32_32x32x16_bf16(b1,qr[d0],p1,0,0,0);}}
}
typedef __attribute__((address_space(3))) const char* lds_cptr;
typedef short v4i16_t __attribute__((ext_vector_type(4)));
__device__ __forceinline__ void kload8(bf16x8*kf,lds_cptr kp){
  kf[0]=*(const __attribute__((address_space(3))) bf16x8*)(kp);      kf[1]=*(const __attribute__((address_space(3))) bf16x8*)(kp+512);
  kf[2]=*(const __attribute__((address_space(3))) bf16x8*)(kp+2048); kf[3]=*(const __attribute__((address_space(3))) bf16x8*)(kp+2560);
  kf[4]=*(const __attribute__((address_space(3))) bf16x8*)(kp+4096); kf[5]=*(const __attribute__((address_space(3))) bf16x8*)(kp+4608);
  kf[6]=*(const __attribute__((address_space(3))) bf16x8*)(kp+6144); kf[7]=*(const __attribute__((address_space(3))) bf16x8*)(kp+6656);
}
__device__ __forceinline__ void kload2(bf16x8*kf,lds_cptr kp,int j){ kf[2*j]=*(const __attribute__((address_space(3))) bf16x8*)(kp+j*2048); kf[2*j+1]=*(const __attribute__((address_space(3))) bf16x8*)(kp+j*2048+512); }
__device__ __forceinline__ s16x4 vtr(lds_cptr p){ return __builtin_bit_cast(s16x4,__builtin_amdgcn_ds_read_tr16_b64_v4i16((__attribute__((address_space(3))) v4i16_t*)p)); }
__device__ __forceinline__ float rowmax(const f32x16&p0,const f32x16&p1){
  float a=max3f(p0[0],p0[1],p1[0]),b=max3f(p0[2],p0[3],p1[1]);a=max3f(a,p1[2],p1[3]);
  #pragma unroll
  for(int r=4;r<16;r+=4){a=max3f(a,p0[r],p0[r+1]);b=max3f(b,p0[r+2],p0[r+3]);a=max3f(a,p1[r],p1[r+1]);b=max3f(b,p1[r+2],p1[r+3]);}
  const float m=max2f(a,b);
  auto rr=__builtin_amdgcn_permlane32_swap(__float_as_uint(m),__float_as_uint(m),false,false);
  return max2f(__uint_as_float(rr[0]),__uint_as_float(rr[1]));
}
__device__ __forceinline__ void pv(f32x16*o,int vb,bf16x8 pa0,bf16x8 pa1,bf16x8 pa2,bf16x8 pa3){
  #pragma unroll
  for(int d0=0;d0<2;++d0){s16x4 lo[4],hi[4];
    #pragma unroll
    for(int ks=0;ks<4;++ks){
      asm volatile("ds_read_b64_tr_b16 %0,%1 offset:%c2":"=&v"(lo[ks]):"v"(vb),"i"(d0*4096+ks*1024):"memory");
      asm volatile("ds_read_b64_tr_b16 %0,%1 offset:%c2":"=&v"(hi[ks]):"v"(vb),"i"(d0*4096+ks*1024+512):"memory");}
    asm volatile("s_waitcnt lgkmcnt(0)":::"memory");SBAR();
    #define PK(k) (bf16x8){lo[k][0],lo[k][1],lo[k][2],lo[k][3],hi[k][0],hi[k][1],hi[k][2],hi[k][3]}
    o[d0]=__builtin_amdgcn_mfma_f32_32x32x16_bf16(pa0,PK(0),o[d0],0,0,0);
    o[d0]=__builtin_amdgcn_mfma_f32_32x32x16_bf16(pa1,PK(1),o[d0],0,0,0);
    o[d0]=__builtin_amdgcn_mfma_f32_32x32x16_bf16(pa2,PK(2),o[d0],0,0,0);
    o[d0]=__builtin_amdgcn_mfma_f32_32x32x16_bf16(pa3,PK(3),o[d0],0,0,0);
    #undef PK
  }
}

#ifndef ATTN_STORE16
#define ATTN_STORE16(p,v) (*(u32x4*)(p)=(v))
#endif
template<int THRL,bool SM> __device__ __forceinline__ void attn_unit(int b,int h,int qb,const bf16*PR,bf16*O,char*shm,const lds_fptr c2l,const int wid,const float tskip,const int rb,const bool pre,const int nb,const int nh,const int nqb,const float*cumn,const unsigned c2n_lds){
  const int qst_off=(wid<7)?(QST_HI+wid*4096):QST_W7;
  char*shmr=shm+rb;
  const bf16*Q=PR; const bf16*K=PR+1024; const bf16*V=PR+2048; const bf16*Gt=PR+3072;
  int lane_; asm volatile("v_mbcnt_lo_u32_b32 %0, -1, 0\n\tv_mbcnt_hi_u32_b32 %0, -1, %0" : "=v"(lane_)); const int lane=lane_,r32=lane&31,hi=lane>>5;
  const long rowbase=(long)b*SEQ; const int q0=qb*QB;
  const bf16*Qw=Q+(rowbase+q0+wid*QBLK)*DM+h*D;
  const bf16*Kh=K+rowbase*DM+h*D,*Vh=V+rowbase*DM+h*D;
  const unsigned lds0=(unsigned)(uintptr_t)shmr;
  float*wsf=(float*)(shm+LDS_WS)+wid*64;
  const bf16*ksrc=Kh+(long)lane*DM+wid*8;
  const bf16*vsrc=Vh+(long)(16*(wid&3)+(lane>>2))*DM+(wid>>2)*32+(lane&3)*8;
  const unsigned kdst=lds0+LDS_K+wid*1024, vdst=lds0+LDS_V+wid*1024;
  #define DMA_K(t,slot) glds16(ksrc+(long)(t)*KVBLK*DM,(unsigned)__builtin_amdgcn_readfirstlane(kdst+(slot)))
  #define DMA_V(t,slot) glds16(vsrc+(long)(t)*KVBLK*DM,(unsigned)__builtin_amdgcn_readfirstlane(vdst+(slot)))
  const char*Kbase=shmr+LDS_K; bf16x8 kf[8];
  const lds_cptr shm3=(lds_cptr)shmr; const lds_cptr kp0=shm3+LDS_K+hi*1024+r32*16; const lds_cptr vp0=shm3+LDS_V+((lane>>4)&1)*32+(lane&3)*8+(4*hi+((lane&15)>>2))*64;
  const int NT=(q0+QB)/KVBLK;
#if ATTN_SKIP
  int t0; { const float cq0_=c2l[q0]; const float ce_=(lane<NT)?c2l[KVBLK*lane+KVBLK-1]:0.f; const unsigned long long m_=__ballot((lane<NT)&&((lane>=NT-4)||(cq0_-ce_>=-tskip)));
    t0=(int)__builtin_ctzll(m_|(1ull<<(NT-4))); t0&=~1; t0=__builtin_amdgcn_readfirstlane(t0); }
#else
  const int t0=0; (void)tskip;
#endif
  if(!pre){DMA_K(t0,0);DMA_V(t0,0);DMA_K(t0+1,SLOTB);}
  bf16x8 qr[4];
  if(!pre){
  #pragma unroll
  for(int d0=0;d0<4;++d0)qr[d0]=*reinterpret_cast<const bf16x8*>(&Qw[(long)r32*DM+d0*16+hi*8]); }
  typedef __attribute__((address_space(3))) const u32x2_t* lds_u2ptr;
  const lds_u2ptr cbl=(lds_u2ptr)((lds_cptr)shm+SEAM_C2S)+r32;
  const bf16x8 bneg=(hi==0)?(bf16x8){(short)0xBF80,(short)0xBF80,(short)0xBF80,0,0,0,0,0}:(bf16x8){0,0,0,0,0,0,0,0};
  #define BIASOP(a) __builtin_bit_cast(bf16x8,(u32x4){(a)[0],(a)[1],0u,0u})
  #define BIASM(t,half) __builtin_amdgcn_mfma_f32_32x32x16_bf16(BIASOP(cbl[(t)*KVBLK+32*(half)]),bneg,negm,0,0,0)
  #define CMASK(P0,P1,t) do{int jb_=(t)-(NT-4); if(jb_>=0){ const int L2_=fresh_lane(); cmask(P0,P1,jb_,wid*QBLK+(L2_&31),L2_>>5);} }while(0)
  bool resc=false;
  #define START(P0,P1) do{ resc=false; if constexpr(!SM){ const float rm=rowmax(P0,P1); \
    { const float dl=rm; mhat=fadd_s(mhat,dl); \
      _Pragma("unroll") for(int r=0;r<16;++r){P0[r]=fsub_s(P0[r],dl);P1[r]=fsub_s(P1[r],dl);} \
      _Pragma("unroll") for(int r=0;r<16;++r)negm[r]=-mhat; asm volatile("":"+v"(negm)); } } \
    _Pragma("unroll") for(int r=0;r<16;++r)P0[r]=__builtin_amdgcn_exp2f(P0[r]); }while(0)
  #define RESC() do{ if(resc){ asm volatile("s_waitcnt lgkmcnt(0)":::"memory"); \
      const int h3_=fresh_lane()>>5; _Pragma("unroll") for(int d_=0;d_<2;++d_) _Pragma("unroll") for(int r=0;r<16;++r)o[d_][r]*=wsf[crow(r,h3_)]; } }while(0)
  f32x16 pA0,pA1,pB0,pB1;
  int sl_prev=0,sl_cur=0,sl_next=SLOTB;
  #define ROT() do{sl_prev=sl_cur;sl_cur=sl_next;sl_next=(sl_next==(NSLOT-1)*SLOTB)?0:sl_next+SLOTB;}while(0)
  if(!pre){ DMA_K(t0+2,2*SLOTB);
    WAIT_BAR(3); }
  else { WAIT_BAR(4);
    const lds_cptr qs_=(lds_cptr)shm+qst_off+r32*128+hi*16;
    #pragma unroll
    for(int d0=0;d0<4;++d0)qr[d0]=*(const __attribute__((address_space(3))) bf16x8*)(qs_+d0*32); }
  {
    const int T5_=fresh_lane()+64*wid; const f32x4a c4_=*(const __attribute__((address_space(3))) f32x4a*)((lds_cptr)shm+SEAM_C2F+16*T5_); u32x4 s0_,s1_;
    #pragma unroll
    for(int e_=0;e_<4;++e_){ const float c_=c4_[e_]; const unsigned h_=cvtpk_s(c_,0.f)&0xffffu; const float r1_=c_-__uint_as_float(h_<<16);
      const unsigned m_=cvtpk_s(r1_,0.f)&0xffffu; const float r2_=r1_-__uint_as_float(m_<<16); const unsigned l_=cvtpk_s(r2_,0.f)&0xffffu;
      if(e_<2){s0_[2*e_]=h_|(m_<<16);s0_[2*e_+1]=l_;}else{s1_[2*(e_-2)]=h_|(m_<<16);s1_[2*(e_-2)+1]=l_;} }
    __attribute__((address_space(3))) u32x4*sp_=(__attribute__((address_space(3))) u32x4*)((lds_cptr)shm+SEAM_C2S+32*T5_); sp_[0]=s0_; sp_[1]=s1_;
    asm volatile("s_waitcnt lgkmcnt(0)\n\ts_barrier":::"memory"); }
  const float cq2=c2l[q0+wid*QBLK+r32];
  float mhat=-cq2,l_reg=0.f;f32x16 o[2];o[0]=f32x16{};o[1]=f32x16{};f32x16 negm;
  const float bnd=(tskip-40.f)*0.505f+0.25f;
  _Pragma("unroll") for(int r=0;r<16;++r)negm[r]=SM?(cq2-bnd):cq2; asm volatile("":"+v"(negm));
  { const f32x16 n0_=BIASM(t0,0),n1_=BIASM(t0,1); qkt(pA0,pA1,Kbase,qr,n0_,n1_,r32,hi); } asm volatile("s_nop 15\n\ts_nop 7":"+v"(pA0),"+v"(pA1));CMASK(pA0,pA1,t0);
  START(pA0,pA1);
  _Pragma("unroll") for(int r=0;r<16;++r)pA1[r]=__builtin_amdgcn_exp2f(pA1[r]);
  WAIT_BAR(0);
  DMA_K(t0+3,0);DMA_V(t0+1,SLOTB);
  ROT();
  kload8(kf,kp0+sl_cur);
  WAIT_BAR(2);
  s16x4 vlo[8],vhi[8]; u32x4 pw0,pw1,pw2,pw3;
  #define PKW(P,B) cvtpk_s(P[B],P[B+1])
  #define PAF(k) __builtin_bit_cast(bf16x8,pw##k)
  #define VFR(i) (bf16x8){vlo[i][0],vlo[i][1],vlo[i][2],vlo[i][3],vhi[i][0],vhi[i][1],vhi[i][2],vhi[i][3]}
  #define PIN(x) asm volatile("":"+v"(x))
  #define MX3(a,b,c) __builtin_fmaxf(__builtin_fmaxf((a),(b)),(c))
  #define GAPA(MF,A0,A1,A2,A3,W0,W1,PW) do{ MF; sacc+=A0; sacc+=A1; sacc+=A2; sacc+=A3; PIN(sacc); W0; W1; PIN(PW); SBAR(); }while(0)
  #define EX(v) __builtin_amdgcn_exp2f(v)
  #define GAPB(MF,X,B) do{ MF; X[B]=EX(X[B]); X[B+1]=EX(X[B+1]); X[B+2]=EX(X[B+2]); X[B+3]=EX(X[B+3]); PIN(X); SBAR(); }while(0)
  #define VRD(i) do{ vlo[i]=vtr(vp_+(((i)>>2)*4096+((i)&3)*1024)); vhi[i]=vtr(vp_+(((i)>>2)*4096+((i)&3)*1024+512)); }while(0)
  #define KRD(G,j) do{ if(G){ kload2(kf,kp0+sl_next,j); SBAR(); } }while(0)
  #define STEP(C0,C1,P0,P1,t,GK,GV,GL) do{ SBAR(); \
    const lds_cptr vp_=vp0+sl_prev; \
    VRD(0); SBAR(); float sacc=(P0[0]+P0[1]); \
    C0=__builtin_amdgcn_mfma_f32_32x32x16_bf16(BIASOP(cbA),bneg,negm,0,0,0); C1=__builtin_amdgcn_mfma_f32_32x32x16_bf16(BIASOP(cbB),bneg,negm,0,0,0); cbA=cbl[((t)+1)*KVBLK]; cbB=cbl[((t)+1)*KVBLK+32]; SBAR(); \
    GAPA(C0=__builtin_amdgcn_mfma_f32_32x32x16_bf16(kf[0],qr[0],C0,0,0,0), P0[2],P0[3],P0[4],P0[5],     pw0[0]=PKW(P0,0), pw0[1]=PKW(P0,2), pw0); \
    VRD(4); SBAR(); GAPA(C1=__builtin_amdgcn_mfma_f32_32x32x16_bf16(kf[1],qr[0],C1,0,0,0), P0[6],P0[7],P0[8],P0[9],     pw0[2]=PKW(P0,4), pw0[3]=PKW(P0,6), pw0); \
    VRD(1); SBAR(); GAPA(C0=__builtin_amdgcn_mfma_f32_32x32x16_bf16(kf[2],qr[1],C0,0,0,0),   P0[10],P0[11],P0[12],P0[13], pw1[0]=PKW(P0,8), pw1[1]=PKW(P0,10), pw1); \
    VRD(5); SBAR(); GAPA(C1=__builtin_amdgcn_mfma_f32_32x32x16_bf16(kf[3],qr[1],C1,0,0,0),   P0[14],P0[15],P1[0],P1[1],   pw1[2]=PKW(P0,12),pw1[3]=PKW(P0,14), pw1); \
    VRD(2); SBAR(); GAPA(C0=__builtin_amdgcn_mfma_f32_32x32x16_bf16(kf[4],qr[2],C0,0,0,0),   P1[2],P1[3],P1[4],P1[5],     pw2[0]=PKW(P1,0), pw2[1]=PKW(P1,2), pw2); \
    VRD(6); SBAR(); GAPA(C1=__builtin_amdgcn_mfma_f32_32x32x16_bf16(kf[5],qr[2],C1,0,0,0),   P1[6],P1[7],P1[8],P1[9],     pw2[2]=PKW(P1,4), pw2[3]=PKW(P1,6), pw2); \
    VRD(3); SBAR(); GAPA(C0=__builtin_amdgcn_mfma_f32_32x32x16_bf16(kf[6],qr[3],C0,0,0,0),   P1[10],P1[11],P1[12],P1[13], pw3[0]=PKW(P1,8), pw3[1]=PKW(P1,10), pw3); \
    VRD(7); SBAR(); GAPA(C1=__builtin_amdgcn_mfma_f32_32x32x16_bf16(kf[7],qr[3],C1,0,0,0),   P1[14],P1[15],0.f,0.f,       pw3[2]=PKW(P1,12),pw3[3]=PKW(P1,14), pw3); \
    l_reg+=sacc; \
    if(GK){DMA_K((t)+3,sl_cur);} if(GV){DMA_V((t)+1,sl_next);} \
    CMASK(C0,C1,t); \
    if constexpr(!SM){ float a=MX3(C0[0],C0[1],C1[0]),b=MX3(C0[2],C0[3],C1[1]); a=MX3(a,C1[2],C1[3]); \
      _Pragma("unroll") for(int r=4;r<16;r+=4){a=MX3(a,C0[r],C0[r+1]);b=MX3(b,C0[r+2],C0[r+3]);a=MX3(a,C1[r],C1[r+1]);b=MX3(b,C1[r+2],C1[r+3]);} \
      float rm=__builtin_fmaxf(a,b); { auto rr=__builtin_amdgcn_permlane32_swap(__float_as_uint(rm),__float_as_uint(rm),false,false); rm=__builtin_fmaxf(__uint_as_float(rr[0]),__uint_as_float(rr[1])); } \
      resc=false; \
      if(__builtin_expect(__any(rm>(float)THRL),0)){ const float dl=__builtin_fmaxf(rm,0.f); mhat+=dl; \
        _Pragma("unroll") for(int r=0;r<16;++r){C0[r]-=dl;C1[r]-=dl;} \
        _Pragma("unroll") for(int r=0;r<16;++r)negm[r]=-mhat; asm volatile("":"+v"(negm)); \
        const float f=__builtin_amdgcn_exp2f(-dl); l_reg*=f; { const int L3_=fresh_lane(); if((L3_>>5)==0)wsf[L3_&31]=f; } resc=true; } } \
    SBAR(); \
    GAPB(o[0]=__builtin_amdgcn_mfma_f32_32x32x16_bf16(PAF(0),VFR(0),o[0],0,0,0), C0,0); \
    GAPB(o[1]=__builtin_amdgcn_mfma_f32_32x32x16_bf16(PAF(0),VFR(4),o[1],0,0,0), C0,4); \
    KRD(GL,0); GAPB(o[0]=__builtin_amdgcn_mfma_f32_32x32x16_bf16(PAF(1),VFR(1),o[0],0,0,0), C0,8); \
    KRD(GL,1); GAPB(o[1]=__builtin_amdgcn_mfma_f32_32x32x16_bf16(PAF(1),VFR(5),o[1],0,0,0), C0,12); \
    KRD(GL,2); GAPB(o[0]=__builtin_amdgcn_mfma_f32_32x32x16_bf16(PAF(2),VFR(2),o[0],0,0,0), C1,0); \
    KRD(GL,3); GAPB(o[1]=__builtin_amdgcn_mfma_f32_32x32x16_bf16(PAF(2),VFR(6),o[1],0,0,0), C1,4); \
    GAPB(o[0]=__builtin_amdgcn_mfma_f32_32x32x16_bf16(PAF(3),VFR(3),o[0],0,0,0), C1,8); \
    GAPB(o[1]=__builtin_amdgcn_mfma_f32_32x32x16_bf16(PAF(3),VFR(7),o[1],0,0,0), C1,12); \
    }while(0)
  u32x2_t cbA=cbl[(t0+1)*KVBLK],cbB=cbl[(t0+1)*KVBLK+32];
  int t=t0+1;
  #undef CMASK
  #define CMASK(P0,P1,t) do{}while(0)
  for(;t+5<NT;t+=2){
    STEP(pB0,pB1,pA0,pA1,t,true,true,true);     WAIT_BAR(2); RESC(); ROT();
    STEP(pA0,pA1,pB0,pB1,t+1,true,true,true);   WAIT_BAR(2); RESC(); ROT();
  }
  #undef CMASK
  #define CMASK(P0,P1,t) do{int jb_=(t)-(NT-4); if(jb_>=0){ const int L2_=fresh_lane(); cmask(P0,P1,jb_,wid*QBLK+(L2_&31),L2_>>5);} }while(0)
  #define ENDW(tt) do{ if((tt)+3<NT){WAIT_BAR(2);} else if((tt)+2<NT){WAIT_BAR(1);} else {WAIT_BAR(0);} }while(0)
  for(;t+1<NT;t+=2){
    STEP(pB0,pB1,pA0,pA1,t,(t+3<NT),(t+1<NT),(t+1<NT));       ENDW(t);   RESC(); ROT();
    STEP(pA0,pA1,pB0,pB1,t+1,(t+4<NT),(t+2<NT),(t+2<NT));     ENDW(t+1); RESC(); ROT();
  }
  if(nb>=0){ const int L5_=fresh_lane();
    const bf16*ksn=K+((long)nb*SEQ+L5_)*DM+nh*D+wid*8; const bf16*vsn=V+((long)nb*SEQ+16*(wid&3)+(L5_>>2))*DM+nh*D+(wid>>2)*32+(L5_&3)*8;
    const unsigned l0n=(unsigned)(uintptr_t)(shm+(RING_SET-rb)), kdn=l0n+LDS_K+wid*1024, vdn=l0n+LDS_V+wid*1024;
    glds16(ksn,(unsigned)__builtin_amdgcn_readfirstlane(kdn)); glds16(vsn,(unsigned)__builtin_amdgcn_readfirstlane(vdn));
    glds16(ksn+(long)KVBLK*DM,(unsigned)__builtin_amdgcn_readfirstlane(kdn+SLOTB)); glds16(ksn+2L*KVBLK*DM,(unsigned)__builtin_amdgcn_readfirstlane(kdn+2*SLOTB));
    glds16(cumn+4*(wid*64+L5_),(unsigned)__builtin_amdgcn_readfirstlane(c2n_lds+wid*1024));
    const bf16*qsn=Q+((long)nb*SEQ+nqb*QB+wid*QBLK+(L5_>>3))*DM+nh*D+(L5_&7)*8; const unsigned qdn=(unsigned)(uintptr_t)(shm+qst_off);
    #pragma unroll
    for(int j=0;j<4;++j)glds16(qsn+(long)(8*j)*DM,(unsigned)__builtin_amdgcn_readfirstlane(qdn+j*1024)); }
  STEP(pB0,pB1,pA0,pA1,NT-1,false,false,false); RESC();
  { float sacc=pB0[0]+pB0[1]; _Pragma("unroll") for(int r=2;r<16;++r)sacc+=pB0[r]; _Pragma("unroll") for(int r=0;r<16;++r)sacc+=pB1[r]; l_reg+=sacc;
    pw0=(u32x4){PKW(pB0,0),PKW(pB0,2),PKW(pB0,4),PKW(pB0,6)};pw1=(u32x4){PKW(pB0,8),PKW(pB0,10),PKW(pB0,12),PKW(pB0,14)};pw2=(u32x4){PKW(pB1,0),PKW(pB1,2),PKW(pB1,4),PKW(pB1,6)};pw3=(u32x4){PKW(pB1,8),PKW(pB1,10),PKW(pB1,12),PKW(pB1,14)};
    SBAR(); { const int L4_=fresh_lane(); const int vb1_=(int)(lds0+LDS_V)+((L4_>>4)&1)*32+(L4_&3)*8+(4*(L4_>>5)+((L4_&15)>>2))*64; pv(o,vb1_+sl_cur,PAF(0),PAF(1),PAF(2),PAF(3)); } }
  #undef PKW
  #undef PAF
  #undef VFR
  #undef PIN
  #undef MX3
  #undef GAPA
  #undef GAPB
  #undef EX
  #undef VRD
  #undef KRD
  #undef STEP
  #undef ENDW
  int eL; asm volatile("v_mbcnt_lo_u32_b32 %0, -1, 0\n\tv_mbcnt_hi_u32_b32 %0, -1, %0" : "=v"(eL)); const int eR=eL&31,eH=eL>>5;
  const bf16*Gw=Gt+(rowbase+q0+wid*QBLK)*DM+h*D; u32x4 ggv[4];
  #pragma unroll
  for(int i=0;i<4;++i)ggv[i]=*(const u32x4*)(Gw+(long)(i*8+(eL>>3))*DM+(eL&7)*8);
  {auto rr=__builtin_amdgcn_permlane32_swap(__float_as_uint(l_reg),__float_as_uint(l_reg),false,false);l_reg=__uint_as_float(rr[0])+__uint_as_float(rr[1]);}
  if(eH==0)wsf[32+eR]=l_reg;asm volatile("s_waitcnt lgkmcnt(0)":::"memory");
  float rli[16];
  #pragma unroll
  for(int r=0;r<16;++r)rli[r]=__builtin_amdgcn_rcpf(wsf[32+crow(r,eH)]);
  bf16*Ow=O+(rowbase+q0+wid*QBLK)*PO+h*D;
  asm volatile("s_waitcnt lgkmcnt(0)\n\ts_barrier":::"memory");
  { bf16*stg=(bf16*)(shmr)+wid*2048;
    #pragma unroll
    for(int r=0;r<16;++r){const int orow=crow(r,eH);
      #pragma unroll
      for(int d0=0;d0<2;++d0)stg[orow*64+d0*32+eR]=__float2bfloat16(o[d0][r]*rli[r]);}
    asm volatile("s_waitcnt lgkmcnt(0)":::"memory");
    #pragma unroll
    for(int i=0;i<4;++i){const int row=i*8+(eL>>3),ch=eL&7; const u32x4 v=*(const u32x4*)(stg+row*64+ch*8); const u32x4 gg=ggv[i]; u32x4 w;
      #pragma unroll
      for(int e=0;e<4;++e){ const float o0=__uint_as_float(v[e]<<16),o1=__uint_as_float(v[e]&0xffff0000u),g0=__uint_as_float(gg[e]<<16),g1=__uint_as_float(gg[e]&0xffff0000u);
        const float s0=g0*__builtin_amdgcn_rcpf(1.f+__builtin_amdgcn_exp2f(-1.4426950408889634f*g0)),s1=g1*__builtin_amdgcn_rcpf(1.f+__builtin_amdgcn_exp2f(-1.4426950408889634f*g1)); w[e]=cvtpk_s(o0*s0,o1*s1);}
      ATTN_STORE16(Ow+(long)row*PO+ch*8,w);} }
  asm volatile("s_waitcnt lgkmcnt(0)\n\ts_barrier":::"memory");
  #undef DMA_K
  #undef DMA_V
  #undef CMASK
  #undef START
  #undef RESC
  #undef ROT
  #undef BIASM
  #undef BIASOP
}
constexpr int ATTN_LDS_BYTES=LDS_BYTES;
struct AttnTensors { const bf16* PR; bf16* O; const float* cum; const float* tsk; };
struct AttnUnit { int bh; int qb; };
constexpr int C2_OFF=2048, SCAN_OFF=0;
constexpr int ATTN_LDS_TOTAL=LDS_BYTES;
__device__ __forceinline__ void build_c2(const float*logf,int b,int h,char*shm,int wid){
  int lane_; asm volatile("v_mbcnt_lo_u32_b32 %0, -1, 0\n\tv_mbcnt_hi_u32_b32 %0, -1, %0" : "=v"(lane_)); const int lane=lane_,tid=wid*64+lane;
  float*tot=(float*)(shm+SCAN_OFF); float*c2=(float*)(shm+C2_OFF);
  float l4[4]; { float run=0.f;
    #pragma unroll
    for(int i=0;i<4;++i){ run+=logf[((long)b*SEQ+4*tid+i)*16+h]; l4[i]=run; } tot[tid]=run; }
  __syncthreads();
  if(wid==0){ float run=0.f; float e[8];
    #pragma unroll
    for(int i=0;i<8;++i){ e[i]=run; run+=tot[8*lane+i]; }
    float inc=run;
    #pragma unroll
    for(int o=1;o<64;o<<=1){ const float y=__builtin_bit_cast(float,__builtin_amdgcn_ds_bpermute((lane-o)<<2,__builtin_bit_cast(int,inc))); if(lane>=o)inc+=y; }
    const float excl=inc-run;
    #pragma unroll
    for(int i=0;i<8;++i)tot[8*lane+i]=excl+e[i]; }
  __syncthreads();
  { const float off=tot[tid];
    #pragma unroll
    for(int i=0;i<4;++i)c2[4*tid+i]=(off+l4[i])*1.4426950408889634f; }
  __syncthreads();
}
__device__ __forceinline__ void c2_phase(const float*logf,const float*qg,const float*kg,float*cum,float*tsk,char*lds,int G,int c,int wid){
  int lane_; asm volatile("v_mbcnt_lo_u32_b32 %0, -1, 0\n\tv_mbcnt_hi_u32_b32 %0, -1, %0" : "=v"(lane_)); const int tid=wid*64+lane_;
  for(int bh=c;bh<BATCH*NHEAD;bh+=G){ build_c2(logf,bh/NHEAD,bh%NHEAD,lds,wid);
    *(f32x4a*)(cum+(long)bh*SEQ+4*tid)=*(const f32x4a*)((const float*)(lds+C2_OFF)+4*tid); __syncthreads(); }
  if(wid==0){ float a=fabsf(qg[lane_]),k=fabsf(kg[lane_]);
    #pragma unroll
    for(int o=1;o<64;o<<=1){ a=fmaxf(a,__builtin_bit_cast(float,__builtin_amdgcn_ds_bpermute((lane_^o)<<2,__builtin_bit_cast(int,a)))); k=fmaxf(k,__builtin_bit_cast(float,__builtin_amdgcn_ds_bpermute((lane_^o)<<2,__builtin_bit_cast(int,k)))); }
    if(lane_==0)*tsk=40.f+2.f*64.f*a*k*C2; }
}
__device__ __forceinline__ void load_c2(const float*cum,int bh,char*lds,int wid,int dst_off){
  int lane_; asm volatile("v_mbcnt_lo_u32_b32 %0, -1, 0\n\tv_mbcnt_hi_u32_b32 %0, -1, %0" : "=v"(lane_)); const int tid=wid*64+lane_;
  *(f32x4a*)((float*)(lds+dst_off)+4*tid)=*(const f32x4a*)(cum+(long)bh*SEQ+4*tid); __syncthreads();
}
template<int THRL,bool SM> __device__ __forceinline__ void attn_phase_t(char*lds,const AttnTensors&T,int G,int c,int wid,const float tskip){
  if(G==256){ const int x=c&7,li=c>>3,g4=li>>3,u=li&7,gid=8*g4+x;
    for(int r=0;r<8;++r){ const int b=8*(gid>>4)+r,h=(gid+r)&15,qb=(u+r)&7; const int par=r&1;
      if(r==0)load_c2(T.cum,b*NHEAD+h,lds,wid,SEAM_C2F);
      const int nb=(r<7)?8*(gid>>4)+r+1:-1,nh=(gid+r+1)&15;
      attn_unit<THRL,SM>(b,h,qb,T.PR,T.O,lds,(lds_fptr)(lds+SEAM_C2F),wid,tskip,par*RING_SET,r>0,nb,nh,(u+r+1)&7,T.cum+(long)((nb<0?0:nb)*NHEAD+nh)*SEQ,(unsigned)(uintptr_t)(lds+SEAM_C2F)); }
    return; }
  for(int it=c;it<BATCH*NHEAD*NQB;it+=G){ const int bh=it%(BATCH*NHEAD),qb=it/(BATCH*NHEAD);
    load_c2(T.cum,bh,lds,wid,SEAM_C2F);
    attn_unit<THRL,SM>(bh/NHEAD,bh%NHEAD,qb,T.PR,T.O,lds,(lds_fptr)(lds+SEAM_C2F),wid,tskip,0,false,-1,0,0,T.cum,0u); }
}
template<int THRL=8> __device__ __forceinline__ void attn_phase(char*lds,const AttnTensors&T,int G,int c,int wid){
  const float tskip=*T.tsk;
  if((tskip-40.f)*0.5f<=ATTN_SM_MAX) attn_phase_t<THRL,true>(lds,T,G,c,wid,tskip); else attn_phase_t<THRL,false>(lds,T,G,c,wid,tskip);
}
#undef SBAR
#undef WAIT_BAR
}
namespace gla {
typedef unsigned short bf16;
typedef short bf16x8 __attribute__((ext_vector_type(8)));
typedef float f32x4 __attribute__((ext_vector_type(4)));
typedef unsigned u32x2 __attribute__((ext_vector_type(2)));
typedef unsigned u32x4 __attribute__((ext_vector_type(4)));
#define GLA_LAS __attribute__((address_space(3)))
constexpr int SEQ_ = 2048, PITCH = 3328;
struct Bufs { const bf16* PROJ; const float* AUX; bf16* QIF; bf16* KDF; bf16* AF; unsigned long long* GRAN; float* DCH; bf16* OG; unsigned tag; const float* wa2; const float* ba; const float* ogain; };
__device__ __forceinline__ int lane_v() { int l; asm volatile("v_mbcnt_lo_u32_b32 %0, -1, 0\n\tv_mbcnt_hi_u32_b32 %0, -1, %0" : "=v"(l)); return l; }
__device__ __forceinline__ float b2f(bf16 b) { return __uint_as_float((unsigned)b << 16); }
typedef float f32x2g __attribute__((ext_vector_type(2))); typedef __bf16 bf16x2g __attribute__((ext_vector_type(2)));
__device__ __forceinline__ unsigned pk(float lo, float hi) { f32x2g v = {lo, hi}; bf16x2g b = __builtin_convertvector(v, bf16x2g); return __builtin_bit_cast(unsigned, b); }
__device__ __forceinline__ float logsig(float z) { return fminf(z, 0.f) - 0.6931471805599453f * __builtin_amdgcn_logf(1.f + __builtin_amdgcn_exp2f(-1.4426950408889634f * fabsf(z))); }
__device__ __forceinline__ float exp_f(float x) { return __builtin_amdgcn_exp2f(1.4426950408889634f * x); }
#define GLA_ROR(x, n) __builtin_bit_cast(float, __builtin_amdgcn_update_dpp(0, __builtin_bit_cast(int, x), 0x120 + (n), 0xf, 0xf, true))
__device__ __forceinline__ float row16_sum(float x) { x += GLA_ROR(x, 8); x += GLA_ROR(x, 4); x += GLA_ROR(x, 2); x += GLA_ROR(x, 1); return x; }
__device__ __forceinline__ float silu_f(float x) { return x * __builtin_amdgcn_rcpf(1.f + __builtin_amdgcn_exp2f(-1.4426950408889634f * x)); }

__device__ __forceinline__ void pre_phase(const Bufs& B, GLA_LAS unsigned char* lds, const int wave) {
    const int lane = lane_v(), tid = wave * 64 + lane, d = tid & 127, tq = wave >> 1, g = lane >> 4, fr = lane & 15;
    GLA_LAS bf16* qs = (GLA_LAS bf16*)lds;
    GLA_LAS bf16* ks = qs + 8192;
    GLA_LAS float* tot = (GLA_LAS float*)(lds + 32768);
    GLA_LAS float* als = (GLA_LAS float*)(lds + 34816);
    f32x4 als_n = {0.f, 0.f, 0.f, 0.f}; bf16 qn[16], kn[16];
#define GLA_PRELOAD(it_) do { const int bh_ = (it_) & 63, n_ = (it_) >> 6, b_ = bh_ >> 2, h_ = bh_ & 3; const size_t r0_ = (size_t)b_ * SEQ_ + n_ * 64; \
        if (tid < 256) als_n = *(const f32x4*)(B.AUX + r0_ * 16 + 4 * tid); \
        _Pragma("unroll") for (int tt_ = 0; tt_ < 16; ++tt_) { const size_t row_ = r0_ + tq * 16 + tt_; qn[tt_] = B.PROJ[row_ * PITCH + h_ * 128 + d]; kn[tt_] = B.PROJ[row_ * PITCH + 512 + h_ * 128 + d]; } } while (0)
    if ((int)blockIdx.x < 2048) GLA_PRELOAD((int)blockIdx.x);
    for (int it = blockIdx.x; it < 2048; it += gridDim.x) {
        const int bh = it & 63, n = it >> 6, b = bh >> 2, h = bh & 3; const size_t cid = (size_t)bh * 32 + n;
        float w2[16];
#pragma unroll
        for (int r = 0; r < 16; ++r) w2[r] = B.wa2[(size_t)r * 512 + h * 128 + d];
        const float bav = B.ba[h * 128 + d];
        if (tid < 256) *(GLA_LAS f32x4*)(als + 4 * tid) = als_n;
        bf16 qc[16], kc[16];
#pragma unroll
        for (int tt = 0; tt < 16; ++tt) { qc[tt] = qn[tt]; kc[tt] = kn[tt]; }
        asm volatile("s_waitcnt lgkmcnt(0)\n\ts_barrier" ::: "memory");
        if (it + (int)gridDim.x < 2048) GLA_PRELOAD(it + (int)gridDim.x);
        float la[16]; float run = 0.f;
#pragma unroll
        for (int tt = 0; tt < 16; ++tt) { const GLA_LAS f32x4* ar = (const GLA_LAS f32x4*)(als + (tq * 16 + tt) * 16); float z = bav;
#pragma unroll
            for (int r4 = 0; r4 < 4; ++r4) { const f32x4 a4 = ar[r4]; z += a4[0] * w2[4 * r4] + a4[1] * w2[4 * r4 + 1] + a4[2] * w2[4 * r4 + 2] + a4[3] * w2[4 * r4 + 3]; }
            run += logsig(z) * 0.0625f; la[tt] = run; }
        tot[tq * 128 + d] = run;
        asm volatile("s_waitcnt lgkmcnt(0)\n\ts_barrier" ::: "memory");
        float off = 0.f, total = 0.f;
#pragma unroll
        for (int q4 = 0; q4 < 4; ++q4) { const float v = tot[q4 * 128 + d]; if (q4 < tq) off += v; total += v; }
        const float dch = exp_f(total);
        unsigned kd[8];
#pragma unroll
        for (int tt = 0; tt < 16; tt += 2) { float kdv[2];
#pragma unroll
            for (int u = 0; u < 2; ++u) { const int t = tq * 16 + tt + u; const float cum = off + la[tt + u];
                const float e1 = exp_f(cum), e2 = exp_f(-cum);
                const float qv = b2f(qc[tt + u]), kv = b2f(kc[tt + u]);
                const float ki = kv * e2; kdv[u] = ki * dch;
                const int a = t * 128 + (((d >> 3) ^ (t & 15)) * 8) + (d & 7);
                qs[a] = (bf16)(pk(qv * e1, 0.f) & 0xffffu); ks[a] = (bf16)(pk(ki, 0.f) & 0xffffu); }
            kd[tt >> 1] = pk(kdv[0], kdv[1]); }
        { const int ksb = tq >> 1, g0 = 2 * (tq & 1); bf16* base = B.KDF + cid * 8192 + (size_t)((d >> 4) * 2 + ksb) * 512;
          *(u32x4*)(base + ((d & 15) + 16 * g0) * 8) = (u32x4){kd[0], kd[1], kd[2], kd[3]};
          *(u32x4*)(base + ((d & 15) + 16 * (g0 + 1)) * 8) = (u32x4){kd[4], kd[5], kd[6], kd[7]}; }
        if (tq == 0) B.DCH[cid * 128 + d] = dch;
        asm volatile("s_waitcnt lgkmcnt(0)\n\ts_barrier" ::: "memory");
#pragma unroll
        for (int u = 0; u < 2; ++u) { const int tile = 2 * wave + u, a = tile >> 2, b2 = tile & 3; f32x4 acc = {0.f, 0.f, 0.f, 0.f};
            const int ra = 16 * a + fr, rb = 16 * b2 + fr;
#pragma unroll
            for (int k2 = 0; k2 < 4; ++k2) { const int c = 4 * k2 + g;
                const bf16x8 af = *(const GLA_LAS bf16x8*)(ks + ra * 128 + ((c ^ (ra & 15)) * 8));
                const bf16x8 bf_ = *(const GLA_LAS bf16x8*)(qs + rb * 128 + ((c ^ (rb & 15)) * 8));
                acc = __builtin_amdgcn_mfma_f32_16x16x32_bf16(af, bf_, acc, 0, 0, 0); }
            const int t = 16 * b2 + fr; float m[4];
#pragma unroll
            for (int r = 0; r < 4; ++r) { const int tp = 16 * a + 4 * g + r; m[r] = (tp <= t) ? acc[r] : 0.f; }
            const int lp = fr + 16 * (2 * (a & 1) + (g >> 1));
            *(u32x2*)(B.AF + cid * 4096 + (size_t)(b2 * 2 + (a >> 1)) * 512 + lp * 8 + 4 * (g & 1)) = (u32x2){pk(m[0], m[1]), pk(m[2], m[3])}; }
#pragma unroll
        for (int u = 0; u < 2; ++u) { const int e = tid + 512 * u, bq = e >> 6, l = e & 63, i = bq >> 2, k2 = bq & 3, t = 16 * i + (l & 15), gg = l >> 4;
            const int d0 = 32 * k2 + 4 * gg, c0 = d0 >> 3, sub = d0 & 7;
            const u32x2 p0 = *(const GLA_LAS u32x2*)(qs + t * 128 + ((c0 ^ (t & 15)) * 8) + sub);
            const u32x2 p1 = *(const GLA_LAS u32x2*)(qs + t * 128 + (((c0 + 2) ^ (t & 15)) * 8) + sub);
            *(u32x4*)(B.QIF + cid * 8192 + (size_t)bq * 512 + l * 8) = (u32x4){p0.x, p0.y, p1.x, p1.y}; }
        asm volatile("s_waitcnt lgkmcnt(0)\n\ts_barrier" ::: "memory");
    }
#undef GLA_PRELOAD
}

typedef short s16x4 __attribute__((ext_vector_type(4)));
__device__ __forceinline__ s16x4 vtr(const GLA_LAS unsigned char* p) { return __builtin_bit_cast(s16x4, __builtin_amdgcn_ds_read_tr16_b64_v4i16((GLA_LAS s16x4*)p)); }
__device__ __forceinline__ void glds16(const void* gsrc, unsigned lds_dst) { unsigned keep;
    asm volatile("s_mov_b32 %0, m0\n\ts_mov_b32 m0, %2\n\ts_nop 0\n\tglobal_load_lds_dwordx4 %1, off\n\ts_mov_b32 m0, %0" : "=&s"(keep) : "v"(gsrc), "s"(lds_dst) : "memory"); }
constexpr int CORE_BUF = 50176, OBUF_OFF = 2 * CORE_BUF, OBUF1_OFF = 139776, OST = 68;
#define GLA_QP(x, ctl) __builtin_bit_cast(float, __builtin_amdgcn_update_dpp(0, __builtin_bit_cast(int, x), ctl, 0xf, 0xf, true))
__device__ __forceinline__ void core_phase(const Bufs& B, GLA_LAS unsigned char* lds, const int wave) {
    const int lane = lane_v(), tid = wave * 64 + lane, j = lane & 15, g = lane >> 4, jt = wave & 3, th = wave >> 2;
    const int er = tid >> 3, ec = tid & 7;
    const unsigned lds0 = (unsigned)(size_t)lds;
    GLA_LAS float* obuf0 = (GLA_LAS float*)(lds + OBUF_OFF); GLA_LAS float* obuf1 = (GLA_LAS float*)(lds + OBUF1_OFF);
    for (int it = blockIdx.x; it < 256; it += gridDim.x) {
        const int s = (it >> 3) & 3, bh = (it & 7) + 8 * (it >> 5), b = bh >> 2, h = bh & 3;
        const int ecol = h * 256 + s * 64 + 8 * ec;
        f32x4 gn0 = *(const f32x4*)(B.ogain + s * 64 + 8 * ec), gn1 = *(const f32x4*)(B.ogain + s * 64 + 8 * ec + 4);
        f32x4 S[8];
#pragma unroll
        for (int dt = 0; dt < 8; ++dt) S[dt] = (f32x4){0.f, 0.f, 0.f, 0.f};
#define GLA_STAGE(c) do { const size_t cid_ = (size_t)bh * 32 + (c); const unsigned dst_ = lds0 + ((c) & 1) * CORE_BUF + wave * 1024; \
            glds16(B.KDF + cid_ * 8192 + (size_t)wave * 512 + lane * 8,        (unsigned)__builtin_amdgcn_readfirstlane(dst_)); \
            glds16(B.KDF + cid_ * 8192 + (size_t)(wave + 8) * 512 + lane * 8,  (unsigned)__builtin_amdgcn_readfirstlane(dst_ + 8192)); \
            glds16(B.QIF + cid_ * 8192 + (size_t)wave * 512 + lane * 8,        (unsigned)__builtin_amdgcn_readfirstlane(dst_ + 16384)); \
            glds16(B.QIF + cid_ * 8192 + (size_t)(wave + 8) * 512 + lane * 8,  (unsigned)__builtin_amdgcn_readfirstlane(dst_ + 24576)); \
            glds16(B.AF + cid_ * 4096 + (size_t)wave * 512 + lane * 8,         (unsigned)__builtin_amdgcn_readfirstlane(dst_ + 32768)); \
            glds16(B.PROJ + ((size_t)b * SEQ_ + (c) * 64 + 8 * wave + (lane >> 3)) * PITCH + 1024 + h * 256 + s * 64 + 8 * (lane & 7), (unsigned)__builtin_amdgcn_readfirstlane(dst_ + 40960)); \
            if (wave == 7) glds16((const unsigned char*)(B.DCH + cid_ * 128) + lane * 16, (unsigned)__builtin_amdgcn_readfirstlane(lds0 + ((c) & 1) * CORE_BUF + 49152)); } while (0)
#define GLA_REGLOAD(c, GR) do { const size_t rowb_ = (size_t)b * SEQ_ + (c) * 64; \
            GR = *(const u32x4*)(B.PROJ + (rowb_ + er) * PITCH + 2048 + ecol); } while (0)
#define GLA_EPI_A(c, GV, VAL, QOWN) do { const GLA_LAS float* ob_ = ((c) & 1) ? obuf1 : obuf0; const f32x4 o0_ = *(const GLA_LAS f32x4*)(ob_ + er * OST + 8 * ec), o1_ = *(const GLA_LAS f32x4*)(ob_ + er * OST + 8 * ec + 4); float q_ = 0.f; \
            _Pragma("unroll") for (int e_ = 0; e_ < 4; ++e_) { const float ga_ = __uint_as_float(GV[e_] << 16), gb_ = __uint_as_float(GV[e_] & 0xffff0000u); \
                const float oa_ = (e_ < 2) ? o0_[2 * e_] : o1_[2 * e_ - 4], ob_ = (e_ < 2) ? o0_[2 * e_ + 1] : o1_[2 * e_ - 3]; \
                const float na_ = (e_ < 2) ? gn0[2 * e_] : gn1[2 * e_ - 4], nb_ = (e_ < 2) ? gn0[2 * e_ + 1] : gn1[2 * e_ - 3]; \
                q_ += oa_ * oa_ + ob_ * ob_; VAL[2 * e_] = oa_ * na_ * silu_f(ga_); VAL[2 * e_ + 1] = ob_ * nb_ * silu_f(gb_); } \
            q_ += GLA_QP(q_, 0xB1); q_ += GLA_QP(q_, 0x4E); q_ += GLA_QP(q_, 0x141);     \
            QOWN = q_; \
            if (ec == 0) __hip_atomic_store(B.GRAN + (((size_t)bh * 32 + (c)) * 4 + s) * 64 + er, ((unsigned long long)B.tag << 32) | (unsigned long long)__float_as_uint(q_), __ATOMIC_RELAXED, __HIP_MEMORY_SCOPE_AGENT); } while (0)
#define GLA_GLOAD(c, XG) do { unsigned long long* gp_ = B.GRAN + ((size_t)bh * 32 + (c)) * 256 + er; \
            _Pragma("unroll") for (int p_ = 0; p_ < 3; ++p_) XG[p_] = __hip_atomic_load(gp_ + ((s + 1 + p_) & 3) * 64, __ATOMIC_RELAXED, __HIP_MEMORY_SCOPE_AGENT); } while (0)
#define GLA_EPI_B(c, VAL, QOWN, XG) do { const size_t row_ = (size_t)b * SEQ_ + (c) * 64 + er; unsigned sp_ = 0; \
            while (!__all(((unsigned)(XG[0] >> 32) == B.tag) & ((unsigned)(XG[1] >> 32) == B.tag) & ((unsigned)(XG[2] >> 32) == B.tag)) && ++sp_ < (1u << 22)) { __builtin_amdgcn_s_sleep(1); GLA_GLOAD(c, XG); } \
            const float tot_ = QOWN + __uint_as_float((unsigned)XG[0]) + __uint_as_float((unsigned)XG[1]) + __uint_as_float((unsigned)XG[2]); \
            const float rstd_ = rsqrtf(tot_ * (1.f / 256.f) + 1e-6f); u32x4 w_; \
            _Pragma("unroll") for (int e_ = 0; e_ < 4; ++e_) w_[e_] = pk(VAL[2 * e_] * rstd_, VAL[2 * e_ + 1] * rstd_); \
            *(u32x4*)(B.OG + row_ * 1024 + ecol) = w_; } while (0)
        u32x4 gr;
        asm volatile("s_waitcnt lgkmcnt(0)\n\ts_barrier" ::: "memory");
        GLA_STAGE(0); GLA_REGLOAD(0, gr);
        u32x4 gprev = gr; float valp[8], qp = 0.f;
        for (int n = 0; n < 32; ++n) {
            asm volatile("s_waitcnt vmcnt(1) lgkmcnt(0)\n\ts_barrier" ::: "memory");
            const u32x4 gcur = gr;
            if (n + 1 < 32) { GLA_STAGE(n + 1); GLA_REGLOAD(n + 1, gr); }
            unsigned long long xg[3] = {0ull, 0ull, 0ull}; if (n > 1) GLA_GLOAD(n - 2, xg);
            float valn[8], qn = 0.f;
            if (n > 0) GLA_EPI_A(n - 1, gprev, valn, qn);
            gprev = gcur;
            const GLA_LAS unsigned char* buf = lds + (n & 1) * CORE_BUF + lane * 16;
            const GLA_LAS unsigned char* vb = lds + (n & 1) * CORE_BUF + 40960 + (8 * g + ((lane & 15) >> 2)) * 128 + (16 * jt + 4 * (lane & 3)) * 2;
            const s16x4 t00 = vtr(vb), t01 = vtr(vb + 512), t10 = vtr(vb + 4096), t11 = vtr(vb + 4096 + 512);
            const bf16x8 vf0 = (bf16x8){t00[0], t00[1], t00[2], t00[3], t01[0], t01[1], t01[2], t01[3]}, vf1 = (bf16x8){t10[0], t10[1], t10[2], t10[3], t11[0], t11[1], t11[2], t11[3]};
            u32x4 sb[4];
#pragma unroll
            for (int k2 = 0; k2 < 4; ++k2) sb[k2] = (u32x4){pk(S[2 * k2][0], S[2 * k2][1]), pk(S[2 * k2][2], S[2 * k2][3]), pk(S[2 * k2 + 1][0], S[2 * k2 + 1][1]), pk(S[2 * k2 + 1][2], S[2 * k2 + 1][3])};
#pragma unroll
            for (int dt = 0; dt < 8; ++dt) { S[dt] = S[dt] * *(const GLA_LAS f32x4*)(lds + (n & 1) * CORE_BUF + 49152 + (16 * dt + 4 * g) * 4);
                { const bf16x8 kd = *(const GLA_LAS bf16x8*)(buf + (dt * 2) * 1024); S[dt] = __builtin_amdgcn_mfma_f32_16x16x32_bf16(kd, vf0, S[dt], 0, 0, 0); }
                { const bf16x8 kd = *(const GLA_LAS bf16x8*)(buf + (dt * 2 + 1) * 1024); S[dt] = __builtin_amdgcn_mfma_f32_16x16x32_bf16(kd, vf1, S[dt], 0, 0, 0); } }
            f32x4 ov[2];
#pragma unroll
            for (int i = 0; i < 2; ++i) { const int ti = 2 * th + i; f32x4 o = {0.f, 0.f, 0.f, 0.f};
#pragma unroll
                for (int k2 = 0; k2 < 4; ++k2) { const bf16x8 qf = *(const GLA_LAS bf16x8*)(buf + 16384 + (ti * 4 + k2) * 1024); o = __builtin_amdgcn_mfma_f32_16x16x32_bf16(qf, __builtin_bit_cast(bf16x8, sb[k2]), o, 0, 0, 0); }
                { const bf16x8 a0 = *(const GLA_LAS bf16x8*)(buf + 32768 + (ti * 2) * 1024); o = __builtin_amdgcn_mfma_f32_16x16x32_bf16(a0, vf0, o, 0, 0, 0); }
                if (th == 1) { const bf16x8 a1 = *(const GLA_LAS bf16x8*)(buf + 32768 + (ti * 2 + 1) * 1024); o = __builtin_amdgcn_mfma_f32_16x16x32_bf16(a1, vf1, o, 0, 0, 0); }
                ov[i] = o; }
            { GLA_LAS float* obw = (n & 1) ? obuf1 : obuf0;
#pragma unroll
              for (int i = 0; i < 2; ++i)
#pragma unroll
                for (int r = 0; r < 4; ++r) obw[(16 * (2 * th + i) + 4 * g + r) * OST + 16 * jt + j] = ov[i][r]; }
            if (n > 1) GLA_EPI_B(n - 2, valp, qp, xg);
#pragma unroll
            for (int e = 0; e < 8; ++e) valp[e] = valn[e];
            qp = qn;
        }
        asm volatile("s_waitcnt vmcnt(0) lgkmcnt(0)\n\ts_barrier" ::: "memory");
        { float valn[8], qn = 0.f; unsigned long long xg[3]; GLA_EPI_A(31, gprev, valn, qn); GLA_GLOAD(30, xg); GLA_EPI_B(30, valp, qp, xg); GLA_GLOAD(31, xg); GLA_EPI_B(31, valn, qn, xg); }
#undef GLA_STAGE
#undef GLA_REGLOAD
#undef GLA_EPI_A
#undef GLA_EPI_B
#undef GLA_GLOAD
    }
    asm volatile("s_waitcnt vmcnt(0) lgkmcnt(0)\n\ts_barrier" ::: "memory");
}

#undef GLA_LAS
}
__device__ __forceinline__ int lane_id_v() { int l; asm volatile("v_mbcnt_lo_u32_b32 %0, -1, 0\n\tv_mbcnt_hi_u32_b32 %0, -1, %0" : "=v"(l)); return l; }
__device__ __forceinline__ float wave_sum(float v) {
#pragma unroll
    for (int o = 1; o < 64; o <<= 1) v += __shfl_xor(v, o);
    return v;
}
__device__ __forceinline__ void p0_item(const float* W, int K, int N, bf16* WT, int k0, int n0, int drow0, const float* rs, float cs, LAS float* scr, int lane) {
    const int n = n0 + (lane & 31);
    float wv[32];
#pragma unroll
    for (int i = 0; i < 32; ++i) { const int kk = 2 * i + (lane >> 5); wv[i] = (n < N) ? W[(size_t)(k0 + kk) * N + n] : 0.f; }
    float rv = 1.f; if (rs) rv = rs[k0 + (lane & 63)];
#pragma unroll
    for (int i = 0; i < 32; ++i) { const int kk = 2 * i + (lane >> 5); const float r = __shfl(rv, kk); scr[kk * 33 + (lane & 31)] = wv[i] * cs * r; }
    LDS_WAIT(); asm volatile("" ::: "memory");
    const int c = lane & 7;
#pragma unroll
    for (int j = 0; j < 4; ++j) { const int nn = (lane >> 3) + 8 * j; const LAS float* s = scr + (8 * c) * 33 + nn;
        v4u o; o.x = pk2(s[0 * 33], s[1 * 33]); o.y = pk2(s[2 * 33], s[3 * 33]); o.z = pk2(s[4 * 33], s[5 * 33]); o.w = pk2(s[6 * 33], s[7 * 33]);
        *(GAS v4u*)(WT + (size_t)(drow0 + nn) * K + k0 + 8 * c) = o; }
    LDS_WAIT(); asm volatile("" ::: "memory");
}
__device__ __forceinline__ int perm_row(int n0, int limit) {
    if (n0 >= limit) return n0;
    const int tile = n0 >> 8, w = n0 & 255, wc = w >> 6, bj = (w & 63) >> 5;
    return tile * 256 + 128 * bj + 32 * wc;
}
struct P0Ptrs { const float *x, *norm_mixer, *gla_w_in, *gla_w_out, *fox_w_in, *fox_w_out, *ple_proj, *ple_gate, *ple_norm; bf16 *WGIN, *WFIN, *WOUT, *WGATE, *WPROJ, *HB; float* SSQA; unsigned char* GRAN; };
__device__ __forceinline__ void p0_prologue(const P0Ptrs& P, LAS unsigned char* lds, int wave) {
    const int lane = lane_id_v(), gw = blockIdx.x * NWAVES + wave, NGW = gridDim.x * NWAVES;
    LAS float* scr = (LAS float*)(lds + RING_OFF + wave * 16384);
    constexpr int I_GIN = 16 * (GLA_NP / 32), I_FIN = 16 * (FOX_NP / 32), I_SQ = 16 * 32, I_PR = 4 * 32;
    constexpr int NITEMS = 2 * I_GIN + 2 * I_FIN + 4 * I_SQ + 4 * I_SQ + 4 * I_PR;
    for (int it = gw; it < NITEMS; it += NGW) {
        int r = it;
        if (r < 2 * I_GIN) { const int j = r / I_GIN; r -= j * I_GIN; const int nb = r % (GLA_NP / 32), kb = r / (GLA_NP / 32), n0 = nb * 32;
            p0_item(P.gla_w_in + (size_t)j * DM * GLA_IN, DM, GLA_IN, P.WGIN + (size_t)j * GLA_NP * DM, kb * 64, n0, perm_row(n0, 3072), P.norm_mixer + (size_t)(2 * j) * DM, n0 < 512 ? 0.08838834764831845f : 1.f, scr, lane); continue; }
        r -= 2 * I_GIN;
        if (r < 2 * I_FIN) { const int j = r / I_FIN; r -= j * I_FIN; const int nb = r % (FOX_NP / 32), kb = r / (FOX_NP / 32), n0 = nb * 32;
            p0_item(P.fox_w_in + (size_t)j * DM * FOX_IN, DM, FOX_IN, P.WFIN + (size_t)j * FOX_NP * DM, kb * 64, n0, perm_row(n0, 4096), P.norm_mixer + (size_t)(2 * j + 1) * DM, 1.f, scr, lane); continue; }
        r -= 2 * I_FIN;
        if (r < 4 * I_SQ) { const int i = r / I_SQ; r -= i * I_SQ; const int nb = r % 32, kb = r / 32;
            const float* src = (i & 1) ? P.fox_w_out + (size_t)(i >> 1) * DM * DM : P.gla_w_out + (size_t)(i >> 1) * DM * DM;
            p0_item(src, DM, DM, P.WOUT + (size_t)i * DM * DM, kb * 64, nb * 32, perm_row(nb * 32, DM), nullptr, 1.f, scr, lane); continue; }
        r -= 4 * I_SQ;
        if (r < 4 * I_SQ) { const int i = r / I_SQ; r -= i * I_SQ; const int nb = r % 32, kb = r / 32;
            p0_item(P.ple_gate + (size_t)i * DM * DM, DM, DM, P.WGATE + (size_t)i * DM * DM, kb * 64, nb * 32, perm_row(nb * 32, DM), P.ple_norm + (size_t)i * DM, 1.f, scr, lane); continue; }
        r -= 4 * I_SQ;
        { const int i = r / I_PR; r -= i * I_PR; const int nb = r % 32, kb = r / 32;
            p0_item(P.ple_proj + (size_t)i * PLE * DM, PLE, DM, P.WPROJ + (size_t)i * DM * PLE, kb * 64, nb * 32, perm_row(nb * 32, DM), nullptr, 1.f, scr, lane); }
    }
    for (int m0 = gw * 4; m0 < M; m0 += NGW * 4) {
        f32x4 v[4][4];
#pragma unroll
        for (int r = 0; r < 4; ++r) { const GAS f32x4* xr = (const GAS f32x4*)(P.x + (size_t)(m0 + r) * DM) + lane;
#pragma unroll
            for (int j = 0; j < 4; ++j) v[r][j] = xr[64 * j]; }
#pragma unroll
        for (int r = 0; r < 4; ++r) { float s = 0.f;
#pragma unroll
            for (int j = 0; j < 4; ++j) s += (v[r][j].x * v[r][j].x + v[r][j].y * v[r][j].y) + (v[r][j].z * v[r][j].z + v[r][j].w * v[r][j].w);
            s = wave_sum(s);
            GAS unsigned long long* o8 = (GAS unsigned long long*)(P.HB + (size_t)(m0 + r) * DM) + lane;
#pragma unroll
            for (int j = 0; j < 4; ++j) o8[64 * j] = (unsigned long long)pk2(v[r][j].x, v[r][j].y) | ((unsigned long long)pk2(v[r][j].z, v[r][j].w) << 32);
            if (lane < 16) P.SSQA[(size_t)(m0 + r) * 16 + lane] = (lane == 0) ? s : 0.f; }
    }
    { GAS v4u* gz = (GAS v4u*)P.GRAN; v4u z; z.x = 0u; z.y = 0u; z.z = 0u; z.w = 0u;
      for (size_t e = (size_t)gw * 64 + lane; e < GRAN_BYTES / 16; e += (size_t)NGW * 64) gz[e] = z; }
}
__device__ __forceinline__ void cvt_p_phase(const float* p, bf16* PB, int wave) {
    const int gtid = (blockIdx.x * NWAVES + wave) * 64 + lane_id_v(), NT = gridDim.x * NWAVES * 64;
    for (size_t i0 = (size_t)gtid; i0 < (size_t)M * PLE / 8; i0 += (size_t)NT * 8) {
        f32x4 a[8], b[8];
#pragma unroll
        for (int k = 0; k < 8; ++k) { const size_t i = i0 + (size_t)k * NT; if (i < (size_t)M * PLE / 8) { a[k] = *(const GAS f32x4*)(p + i * 8); b[k] = *(const GAS f32x4*)(p + i * 8 + 4); } }
#pragma unroll
        for (int k = 0; k < 8; ++k) { const size_t i = i0 + (size_t)k * NT; if (i < (size_t)M * PLE / 8) {
            v4u o; o.x = pk2(a[k].x, a[k].y); o.y = pk2(a[k].z, a[k].w); o.z = pk2(b[k].x, b[k].y); o.w = pk2(b[k].z, b[k].w);
            *(GAS v4u*)(PB + i * 8) = o; } }
    }
}
__device__ __forceinline__ void final_phase(float* out, const bf16* HB, const float* SSQA, const float* final_norm, int wave, const float pscale, const float padd) {
    const int lane = lane_id_v(), gw = blockIdx.x * NWAVES + wave, NGW = gridDim.x * NWAVES;
    f32x4 gn[2][2];
#pragma unroll
    for (int j = 0; j < 2; ++j) { const GAS f32x4* gr = (const GAS f32x4*)(final_norm + 8 * lane + 512 * j); gn[j][0] = gr[0]; gn[j][1] = gr[1]; }
    for (int m0 = gw * 4; m0 < M; m0 += NGW * 4) {
        float sq[4]; v4u hv[4][2];
#pragma unroll
        for (int r = 0; r < 4; ++r) { sq[r] = SSQA[(size_t)(m0 + r) * 16 + (lane & 15)];
#pragma unroll
            for (int j = 0; j < 2; ++j) hv[r][j] = *(const GAS v4u*)(HB + (size_t)(m0 + r) * DM + 8 * lane + 512 * j); }
#pragma unroll
        for (int r = 0; r < 4; ++r) { float s = sq[r];
            s += __builtin_bit_cast(float, __builtin_amdgcn_update_dpp(0, __builtin_bit_cast(int, s), 0x128, 0xf, 0xf, true));
            s += __builtin_bit_cast(float, __builtin_amdgcn_update_dpp(0, __builtin_bit_cast(int, s), 0x124, 0xf, 0xf, true));
            s += __builtin_bit_cast(float, __builtin_amdgcn_update_dpp(0, __builtin_bit_cast(int, s), 0x122, 0xf, 0xf, true));
            s += __builtin_bit_cast(float, __builtin_amdgcn_update_dpp(0, __builtin_bit_cast(int, s), 0x121, 0xf, 0xf, true));
            const float rstd = rsqrtf(s * (1.f / DM) + EPS) * pscale; const int m = m0 + r;
#pragma unroll
            for (int j = 0; j < 2; ++j) { const v4u h = hv[r][j]; GAS f32x4* o = (GAS f32x4*)(out + (size_t)m * DM + 8 * lane + 512 * j);
                f32x4 a, b2; a.x = __uint_as_float(h.x << 16); a.y = __uint_as_float(h.x & 0xffff0000u); a.z = __uint_as_float(h.y << 16); a.w = __uint_as_float(h.y & 0xffff0000u);
                b2.x = __uint_as_float(h.z << 16); b2.y = __uint_as_float(h.z & 0xffff0000u); b2.z = __uint_as_float(h.w << 16); b2.w = __uint_as_float(h.w & 0xffff0000u);
                f32x4 r0 = a * rstd * gn[j][0], r1 = b2 * rstd * gn[j][1]; if (m == 0 && j == 0 && lane == 0) r0.x += padd;
                o[0] = r0; o[1] = r1; } }
    }
}
__device__ __forceinline__ float bf2f(bf16 b) { return __uint_as_float((unsigned)b << 16); }
__device__ __forceinline__ float sigm(float x) { return 1.f / (1.f + __expf(-x)); }
__device__ __forceinline__ float logsigm(float x) { return fminf(x, 0.f) - log1pf(__expf(-fabsf(x))); }

struct Args { const float* in[17]; float* out; unsigned char* ws; int ph_lo, ph_hi; };
typedef const __attribute__((address_space(4))) Args* KArgs;
#define KARGS() ({ KArgs a_ = (KArgs)__builtin_amdgcn_kernarg_segment_ptr(); asm volatile("" : "+s"(a_)); a_; })
#if TPROBE
#define STAMP() do { if (blockIdx.x == 0 && wave == 0) { if (lane_id_v() == 0) ((volatile LAS unsigned long long*)(lds + LDSCTL_OFF))[sidx] = __builtin_amdgcn_s_memrealtime(); } ++sidx; } while (0)
#else
#define STAMP() do {} while (0)
#endif
#define GRID_BAR() do { XcdBarrier b2_ = bar; asm volatile("" : "+s"(b2_.x), "+s"(b2_.bar)); xcd_barrier(b2_, wave); STAMP(); } while (0)
template <bool LOGF> __device__ __forceinline__ void skinny16_phase(const bf16* HB, const bf16* W16, const float* ssq, const float* bias, float* aux, const int wave, LAS unsigned char* lds) {
    const int lane = lane_id_v(), fr = lane & 15, fq = lane >> 4, tid = wave * 64 + lane;
    constexpr int WP = 2064;
    v4u wst[4];
#pragma unroll
    for (int i = 0; i < 4; ++i) wst[i] = ((const GAS v4u*)W16)[tid + NWAVES * 64 * i];
    const int tile0 = blockIdx.x * NWAVES + wave, tstride = gridDim.x * NWAVES;
    bf16x8 a[32];
    if (tile0 < M / 16) { const bf16* ap = HB + (size_t)(tile0 * 16 + fr) * DM + 8 * fq;
#pragma unroll
        for (int j = 0; j < 32; ++j) a[j] = *(const GAS bf16x8*)(ap + 32 * j); }
#pragma unroll
    for (int i = 0; i < 4; ++i) { const int p = tid + NWAVES * 64 * i; *(LAS v4u*)(lds + (p >> 7) * WP + (p & 127) * 16) = wst[i]; }
    asm volatile("s_waitcnt lgkmcnt(0)\n\ts_barrier" ::: "memory");
    const LAS unsigned char* bl = lds + fr * WP + fq * 16;
    auto finish = [&](int tile, f32x4 acc0, f32x4 acc1) {
        const int row = tile * 16 + fr;
        const GAS f32x4* sp = (const GAS f32x4*)(ssq + (size_t)row * 16); const f32x4 s0 = sp[0], s1 = sp[1], s2 = sp[2], s3 = sp[3];
        const float ss = ((s0.x + s0.y) + (s0.z + s0.w)) + ((s1.x + s1.y) + (s1.z + s1.w)) + ((s2.x + s2.y) + (s2.z + s2.w)) + ((s3.x + s3.y) + (s3.z + s3.w));
        const float rstd = rsqrtf(ss * (1.f / DM) + EPS);
        f32x4 v = (acc0 + acc1) * rstd;
        if constexpr (LOGF) { const f32x4 bv = *(const GAS f32x4*)(bias + 4 * fq); v = v + bv;
#pragma unroll
            for (int i = 0; i < 4; ++i) v[i] = logsigm(v[i]); }
        *(GAS f32x4*)(aux + (size_t)row * 16 + 4 * fq) = v; };
    if (tile0 < M / 16) {
        f32x4 acc0 = {0.f, 0.f, 0.f, 0.f}, acc1 = {0.f, 0.f, 0.f, 0.f};
#pragma unroll
        for (int j = 0; j < 32; j += 2) {
            const bf16x8 b0 = *(const LAS bf16x8*)(bl + 64 * j), b1 = *(const LAS bf16x8*)(bl + 64 * j + 64);
            acc0 = __builtin_amdgcn_mfma_f32_16x16x32_bf16(b0, a[j], acc0, 0, 0, 0); acc1 = __builtin_amdgcn_mfma_f32_16x16x32_bf16(b1, a[j + 1], acc1, 0, 0, 0); }
        finish(tile0, acc0, acc1); }
    for (int tile = tile0 + tstride; tile < M / 16; tile += tstride) {
        const bf16* ap = HB + (size_t)(tile * 16 + fr) * DM + 8 * fq;
        f32x4 acc0 = {0.f, 0.f, 0.f, 0.f}, acc1 = {0.f, 0.f, 0.f, 0.f};
#pragma unroll 4
        for (int j = 0; j < 32; j += 2) {
            const bf16x8 a0 = *(const GAS bf16x8*)(ap + 32 * j), a1 = *(const GAS bf16x8*)(ap + 32 * j + 32);
            const bf16x8 b0 = *(const LAS bf16x8*)(bl + 64 * j), b1 = *(const LAS bf16x8*)(bl + 64 * j + 64);
            acc0 = __builtin_amdgcn_mfma_f32_16x16x32_bf16(b0, a0, acc0, 0, 0, 0); acc1 = __builtin_amdgcn_mfma_f32_16x16x32_bf16(b1, a1, acc1, 0, 0, 0); }
        finish(tile, acc0, acc1); }
}
template <class Sched> __device__ __forceinline__ void rstd_table(const Sched& S, const float* ssq, LAS unsigned char* lds, const int wave) {
    LAS float* rt = (LAS float*)(lds + RSTD_OFF); const int tid = wave * 64 + lane_id_v();
#pragma unroll 1
    for (int e = tid; e < 8 * 256; e += NWAVES * 64) { pg8::Unit uu; if (!S.next(e >> 8, uu)) break;
        const GAS f32x4* sp = (const GAS f32x4*)(ssq + (size_t)(uu.pm * 256 + (e & 255)) * 16); const f32x4 a = sp[0], b = sp[1], c = sp[2], q = sp[3];
        rt[e] = rsqrtf((((a.x + a.y) + (a.z + a.w)) + ((b.x + b.y) + (b.z + b.w)) + ((c.x + c.y) + (c.z + c.w)) + ((q.x + q.y) + (q.z + q.w))) * (1.f / DM) + EPS); }
    __syncthreads();
}
template <int i> __device__ __forceinline__ void layer_body(LAS unsigned char* lds, const XcdBarrier& bar, const int wave, const int G, const int lo, const int hi, int& sidx) {
    constexpr int j = i >> 1;
#define IN(k) (lo <= (k) && (k) < hi)
#define HBC ((i & 1) ? (bf16*)((unsigned char*)A->out + 64 * MiB) : (bf16*)(ws + WS_HB))
#define HBN ((i & 1) ? (bf16*)(ws + WS_HB) : (bf16*)((unsigned char*)A->out + 64 * MiB))
        if constexpr ((i & 1) == 0) {
            if (IN(1 + 5 * i)) { KArgs A = KARGS(); unsigned char* ws = A->ws;
              skinny16_phase<false>(HBC, (const bf16*)(ws + WS_WGIN) + (size_t)j * GLA_NP * DM + (size_t)3072 * DM, (const float*)(ws + WS_SSQA), nullptr, (float*)(ws + WS_AUX), wave, lds + RING_OFF);
              cvt_p_phase(A->in[1] + (size_t)i * M * PLE, (bf16*)(ws + WS_PB), wave);
#if DUP_SKINNY
              skinny16_phase<false>(HBC, (const bf16*)(ws + WS_WGIN) + (size_t)j * GLA_NP * DM + (size_t)3072 * DM, (const float*)(ws + WS_SSQA), nullptr, (float*)(ws + WS_AUX), wave, lds + RING_OFF);
              cvt_p_phase(A->in[1] + (size_t)i * M * PLE, (bf16*)(ws + WS_PB), wave);
#endif
              pg8::Gemm g{HBC, (bf16*)(ws + WS_WGIN) + (size_t)j * GLA_NP * DM, M, 3072, DM}; pg8::StaticOrder S; S.init(M, 3072, G, (int)blockIdx.x);
              rstd_table(S, (const float*)(ws + WS_SSQA), lds, wave);
              pg8::EpiGlaIn E{(const LAS float*)(lds + RSTD_OFF), (bf16*)(ws + WS_PROJ), (float*)(ws + WS_AUX)};
              pg8::gemm_phase<pg8::EpiGlaIn, pg8::StaticOrder, true, true>(lds + RING_OFF, g, S, E, wave); }
#if DUP_INPROJ
            if (IN(1 + 5 * i)) { KArgs A = KARGS(); unsigned char* ws = A->ws;
              skinny16_phase<false>(HBC, (const bf16*)(ws + WS_WGIN) + (size_t)j * GLA_NP * DM + (size_t)3072 * DM, (const float*)(ws + WS_SSQA), nullptr, (float*)(ws + WS_AUX), wave, lds + RING_OFF);
              cvt_p_phase(A->in[1] + (size_t)i * M * PLE, (bf16*)(ws + WS_PB), wave);
#if DUP_SKINNY
              skinny16_phase<false>(HBC, (const bf16*)(ws + WS_WGIN) + (size_t)j * GLA_NP * DM + (size_t)3072 * DM, (const float*)(ws + WS_SSQA), nullptr, (float*)(ws + WS_AUX), wave, lds + RING_OFF);
              cvt_p_phase(A->in[1] + (size_t)i * M * PLE, (bf16*)(ws + WS_PB), wave);
#endif
              pg8::Gemm g{HBC, (bf16*)(ws + WS_WGIN) + (size_t)j * GLA_NP * DM, M, 3072, DM}; pg8::StaticOrder S; S.init(M, 3072, G, (int)blockIdx.x);
              rstd_table(S, (const float*)(ws + WS_SSQA), lds, wave);
              pg8::EpiGlaIn E{(const LAS float*)(lds + RSTD_OFF), (bf16*)(ws + WS_PROJ), (float*)(ws + WS_AUX)};
              pg8::gemm_phase<pg8::EpiGlaIn, pg8::StaticOrder, true, true>(lds + RING_OFF, g, S, E, wave); }
#endif
            GRID_BAR();
#define GLA_BUFS() unsigned char* os_ = (unsigned char*)A->out;     \
            gla::Bufs GB{(const gla::bf16*)(ws + WS_PROJ), (const float*)(ws + WS_AUX), (gla::bf16*)os_, (gla::bf16*)(os_ + 32 * MiB), (gla::bf16*)(ws + WS_AF), (unsigned long long*)(ws + WS_GRAN), (float*)(ws + WS_DCH), (gla::bf16*)(ws + WS_OG), (unsigned)(j + 1), \
                A->in[4] + (size_t)j * GLA_RANK * 512, A->in[5] + (size_t)j * 512, A->in[6] + (size_t)j * 256}
#if DUP_GLAPRE
            if (IN(2 + 5 * i)) { KArgs A = KARGS(); unsigned char* ws = A->ws; GLA_BUFS(); gla::pre_phase(GB, lds + RING_OFF, wave); }
#endif
            if (IN(2 + 5 * i)) { KArgs A = KARGS(); unsigned char* ws = A->ws; GLA_BUFS(); gla::pre_phase(GB, lds + RING_OFF, wave); }
            GRID_BAR();
            if (IN(2 + 5 * i)) { KArgs A = KARGS(); unsigned char* ws = A->ws; GLA_BUFS(); gla::core_phase(GB, lds + RING_OFF, wave); }
#if DUP_GLA
            GRID_BAR();
            if (IN(2 + 5 * i)) { KArgs A = KARGS(); unsigned char* ws = A->ws; GLA_BUFS(); gla::pre_phase(GB, lds + RING_OFF, wave); }
            GRID_BAR();
            if (IN(2 + 5 * i)) { KArgs A = KARGS(); unsigned char* ws = A->ws; GLA_BUFS(); gla::core_phase(GB, lds + RING_OFF, wave); }
#endif
        } else {
            if (IN(1 + 5 * i)) { KArgs A = KARGS(); unsigned char* ws = A->ws;
              skinny16_phase<true>(HBC, (const bf16*)(ws + WS_WFIN) + (size_t)j * FOX_NP * DM + (size_t)4096 * DM, (const float*)(ws + WS_SSQA), A->in[9] + (size_t)j * FOX_H, (float*)(ws + WS_AUX), wave, lds + RING_OFF);
              cvt_p_phase(A->in[1] + (size_t)i * M * PLE, (bf16*)(ws + WS_PB), wave);
#if DUP_SKINNY
              skinny16_phase<true>(HBC, (const bf16*)(ws + WS_WFIN) + (size_t)j * FOX_NP * DM + (size_t)4096 * DM, (const float*)(ws + WS_SSQA), A->in[9] + (size_t)j * FOX_H, (float*)(ws + WS_AUX), wave, lds + RING_OFF);
              cvt_p_phase(A->in[1] + (size_t)i * M * PLE, (bf16*)(ws + WS_PB), wave);
#endif
              pg8::Gemm g{HBC, (bf16*)(ws + WS_WFIN) + (size_t)j * FOX_NP * DM, M, 4096, DM}; pg8::StaticOrder S; S.init(M, 4096, G, (int)blockIdx.x);
              rstd_table(S, (const float*)(ws + WS_SSQA), lds, wave);
              pg8::EpiFoxIn E{(const LAS float*)(lds + RSTD_OFF), (bf16*)(ws + WS_PROJ), (float*)(ws + WS_AUX), A->in[9] + (size_t)j * FOX_H, A->in[10] + (size_t)j * 64, A->in[11] + (size_t)j * 64};
              pg8::gemm_phase<pg8::EpiFoxIn, pg8::StaticOrder, true, true>(lds + RING_OFF, g, S, E, wave); }
#if DUP_INPROJ
            if (IN(1 + 5 * i)) { KArgs A = KARGS(); unsigned char* ws = A->ws;
              skinny16_phase<true>(HBC, (const bf16*)(ws + WS_WFIN) + (size_t)j * FOX_NP * DM + (size_t)4096 * DM, (const float*)(ws + WS_SSQA), A->in[9] + (size_t)j * FOX_H, (float*)(ws + WS_AUX), wave, lds + RING_OFF);
              cvt_p_phase(A->in[1] + (size_t)i * M * PLE, (bf16*)(ws + WS_PB), wave);
#if DUP_SKINNY
              skinny16_phase<true>(HBC, (const bf16*)(ws + WS_WFIN) + (size_t)j * FOX_NP * DM + (size_t)4096 * DM, (const float*)(ws + WS_SSQA), A->in[9] + (size_t)j * FOX_H, (float*)(ws + WS_AUX), wave, lds + RING_OFF);
              cvt_p_phase(A->in[1] + (size_t)i * M * PLE, (bf16*)(ws + WS_PB), wave);
#endif
              pg8::Gemm g{HBC, (bf16*)(ws + WS_WFIN) + (size_t)j * FOX_NP * DM, M, 4096, DM}; pg8::StaticOrder S; S.init(M, 4096, G, (int)blockIdx.x);
              rstd_table(S, (const float*)(ws + WS_SSQA), lds, wave);
              pg8::EpiFoxIn E{(const LAS float*)(lds + RSTD_OFF), (bf16*)(ws + WS_PROJ), (float*)(ws + WS_AUX), A->in[9] + (size_t)j * FOX_H, A->in[10] + (size_t)j * 64, A->in[11] + (size_t)j * 64};
              pg8::gemm_phase<pg8::EpiFoxIn, pg8::StaticOrder, true, true>(lds + RING_OFF, g, S, E, wave); }
#endif
            GRID_BAR();
            if (IN(2 + 5 * i)) { KArgs A = KARGS(); unsigned char* ws = A->ws;
              attn_body::c2_phase((const float*)(ws + WS_AUX), A->in[10] + (size_t)j * 64, A->in[11] + (size_t)j * 64, (float*)(ws + WS_DCH), (float*)(ws + WS_CTL) + 8, (char*)lds + RING_OFF, G, (int)blockIdx.x, wave); }
            GRID_BAR();
            if (IN(2 + 5 * i)) { KArgs A = KARGS(); unsigned char* ws = A->ws;
              const attn_body::bf16* PR = (const attn_body::bf16*)(ws + WS_PROJ);
              const attn_body::AttnTensors AT{PR, (attn_body::bf16*)(ws + WS_OG), (const float*)(ws + WS_DCH), (const float*)(ws + WS_CTL) + 8};
              static_assert(attn_body::ATTN_LDS_TOTAL <= RING_BYTES, "attention LDS");
              attn_body::attn_phase<ATTN_THRL>((char*)lds + RING_OFF, AT, G, (int)blockIdx.x, wave); }
#if DUP_ATTN
            if (IN(2 + 5 * i)) { KArgs A = KARGS(); unsigned char* ws = A->ws;
              const attn_body::bf16* PR = (const attn_body::bf16*)(ws + WS_PROJ);
              const attn_body::AttnTensors AT{PR, (attn_body::bf16*)(ws + WS_OG), (const float*)(ws + WS_DCH), (const float*)(ws + WS_CTL) + 8};
              static_assert(attn_body::ATTN_LDS_TOTAL <= RING_BYTES, "attention LDS");
              attn_body::attn_phase<ATTN_THRL>((char*)lds + RING_OFF, AT, G, (int)blockIdx.x, wave); }
#endif
        }
        GRID_BAR();
        if (IN(3 + 5 * i)) { KArgs A = KARGS(); unsigned char* ws = A->ws;
          pg8::Gemm g{(bf16*)(ws + WS_OG), (bf16*)(ws + WS_WOUT) + (size_t)i * DM * DM, M, DM, DM}; pg8::StaticOrder S; S.init(M, DM, G, (int)blockIdx.x);
          pg8::EpiOut<i == 0> E{A->in[0], HBC, (float*)(ws + WS_SSQB)};
          pg8::gemm_phase<pg8::EpiOut<i == 0>, pg8::StaticOrder, true, true>(lds + RING_OFF, g, S, E, wave);
          int kq = PLE; asm volatile("" : "+s"(kq));
          pg8::Gemm g2{(bf16*)(ws + WS_PB), (bf16*)(ws + WS_WPROJ) + (size_t)i * DM * PLE, M, DM, kq}; pg8::EpiP E2{(bf16*)(ws + WS_SG)};
          pg8::gemm_phase<pg8::EpiP, pg8::StaticOrder, true, true>(lds + RING_OFF, g2, S, E2, wave); }
        GRID_BAR();
        if (IN(4 + 5 * i)) { KArgs A = KARGS(); unsigned char* ws = A->ws;
          pg8::Gemm g{HBC, (bf16*)(ws + WS_WGATE) + (size_t)i * DM * DM, M, DM, DM}; pg8::StaticOrder S; S.init(M, DM, G, (int)blockIdx.x);
          rstd_table(S, (const float*)(ws + WS_SSQB), lds, wave);
          pg8::EpiGateFinal E{ws, HBC, HBN, (const LAS float*)(lds + RSTD_OFF), WS_SG, WS_SSQA};
          pg8::gemm_phase<pg8::EpiGateFinal, pg8::StaticOrder, true, true>(lds + RING_OFF, g, S, E, wave); }
        GRID_BAR();
}
__global__ void __launch_bounds__(NWAVES * 64, 2) mega_fwd(Args args_unused) {
    extern __shared__ __attribute__((aligned(16))) unsigned char lds_raw[];
    LAS unsigned char* lds = (LAS unsigned char*)lds_raw;
    volatile LAS unsigned* MISC = (volatile LAS unsigned*)(lds + MISC_OFF);
    const int wave = __builtin_amdgcn_readfirstlane((int)threadIdx.x >> 6); const int G = gridDim.x;
    for (int u = threadIdx.x; u < (LDS_BYTES - LDSCTL_OFF) / 4; u += NWAVES * 64) ((LAS unsigned*)(lds + LDSCTL_OFF))[u] = 0u;
    __syncthreads();
    XcdBarrier bar;
    { KArgs A = KARGS(); bar = xcd_barrier_post((unsigned*)(A->ws + WS_CTL) + CW_BAR, MISC + 8); }

    int lo, hi; { KArgs A = KARGS(); lo = A->ph_lo; hi = A->ph_hi; }
    int sidx = 0; STAMP();
    if (IN(0)) { KArgs A = KARGS(); unsigned char* ws = A->ws; P0Ptrs P;
      P.x = A->in[0]; P.norm_mixer = A->in[2]; P.gla_w_in = A->in[3]; P.gla_w_out = A->in[7]; P.fox_w_in = A->in[8]; P.fox_w_out = A->in[12]; P.ple_proj = A->in[13]; P.ple_gate = A->in[14]; P.ple_norm = A->in[15];
      P.WGIN = (bf16*)(ws + WS_WGIN); P.WFIN = (bf16*)(ws + WS_WFIN); P.WOUT = (bf16*)(ws + WS_WOUT); P.WGATE = (bf16*)(ws + WS_WGATE); P.WPROJ = (bf16*)(ws + WS_WPROJ); P.HB = (bf16*)(ws + WS_HB); P.SSQA = (float*)(ws + WS_SSQA); P.GRAN = ws + WS_GRAN;
      p0_prologue(P, lds, wave);
#if DUP_P0
      p0_prologue(P, lds, wave);
#endif
      }
    GRID_BAR();
#if DUP_BAR
    for (int xb = 0; xb < 16; ++xb) GRID_BAR();
#endif
    layer_body<0>(lds, bar, wave, G, lo, hi, sidx);
    layer_body<1>(lds, bar, wave, G, lo, hi, sidx);
    layer_body<2>(lds, bar, wave, G, lo, hi, sidx);
    layer_body<3>(lds, bar, wave, G, lo, hi, sidx);
    float pscale = 1.f, padd = 0.f;
#if TPROBE
    if (blockIdx.x == 0) { volatile LAS unsigned long long* ts = (volatile LAS unsigned long long*)(lds + LDSCTL_OFF);
        const float ua = (float)(ts[PROBE_A] - ts[PROBE_A - 1]) * 0.01f, ub = (float)(ts[PROBE_B] - ts[PROBE_B - 1]) * 0.01f;
        pscale = 1.f + ua * 0.01f; padd = ub; }
#endif
    if (IN(21)) { KArgs A = KARGS(); final_phase(A->out, (const bf16*)(A->ws + WS_HB), (const float*)(A->ws + WS_SSQA), A->in[16], wave, pscale, padd); }
}

static int mega_grid = 0;
static bool mega_setup(int n_in, int out_size, size_t ws_size) {
    if (mega_grid == 0) {
        if (n_in != 17 || out_size != M * DM || ws_size < WS_END) { fprintf(stderr, "kernel_launch: unexpected shapes: n_in %d out %d ws %zu (need %zu); nothing launched\n", n_in, out_size, ws_size, (size_t)WS_END); mega_grid = -1; return false; }
        int dev = 0, cus = 0, per_cu = 0;
        if (hipGetDevice(&dev) != hipSuccess || hipDeviceGetAttribute(&cus, hipDeviceAttributeMultiprocessorCount, dev) != hipSuccess) { mega_grid = -1; return false; }
        if (hipFuncSetAttribute((const void*)mega_fwd, hipFuncAttributeMaxDynamicSharedMemorySize, LDS_BYTES) != hipSuccess) { fprintf(stderr, "kernel_launch: hipFuncSetAttribute failed\n"); mega_grid = -1; return false; }
        if (hipOccupancyMaxActiveBlocksPerMultiprocessor(&per_cu, (const void*)mega_fwd, NWAVES * 64, LDS_BYTES) != hipSuccess || per_cu < 1) { fprintf(stderr, "kernel_launch: occupancy query says %d blocks per CU\n", per_cu); (void)hipGetLastError(); mega_grid = -1; return false; }
        mega_grid = cus;
    }
    return mega_grid > 0;
}
static void mega_launch(void* const* d_in, void* d_out, void* d_ws, hipStream_t stream, int lo, int hi) {
    if (hipMemsetAsync((char*)d_ws + WS_CTL, 0, CTL_ZERO_BYTES, stream) != hipSuccess) { fprintf(stderr, "kernel_launch: memset failed\n"); return; }
    Args a{};
    for (int i = 0; i < 17; ++i) a.in[i] = (const float*)d_in[i];
    a.out = (float*)d_out; a.ws = (unsigned char*)d_ws; a.ph_lo = lo; a.ph_hi = hi;
    void* kargs[] = {&a};
    hipError_t e = hipLaunchCooperativeKernel((const void*)mega_fwd, dim3(mega_grid), dim3(NWAVES * 64), kargs, LDS_BYTES, stream);
    if (e != hipSuccess) fprintf(stderr, "kernel_launch: cooperative launch failed: %s (grid %d)\n", hipGetErrorString(e), mega_grid);
}
extern "C" void kernel_launch(void* const* d_in, const int* in_sizes, int n_in, void* d_out, int out_size, void* d_ws, size_t ws_size, hipStream_t stream) {
    if (!mega_setup(n_in, out_size, ws_size)) return;
    mega_launch(d_in, d_out, d_ws, stream, 0, 22);
}
```
